# Optimizing an MI355X kernel written in HIP

```python
import jax, jax.numpy as jnp
from jax import lax
import numpy as np

D_MODEL = 1024
BATCH = 4
SEQ = 4096
DEPTH = 1

CHUNK = 64
EPS = 1e-6

GDN_HEADS = 4
GDN_DK = 128
GDN_DV = 128
GDN_CONV = 4
MLA_HEADS = 8
MLA_NOPE = 64
MLA_ROPE = 32
MLA_V = 64
MLA_Q_LORA = 384
MLA_KV_LORA = 256
ROPE_THETA = 10000.0
Q_BLOCK = 128
D_MIX = GDN_HEADS * GDN_DV + MLA_HEADS * MLA_V

N_EXPERTS = 32
TOP_K = 4
D_FF = 1024
SWIGLU_LIMIT = 7.0
SWIGLU_ALPHA = 1.702
MOE_BLOCK = 128

IN_SIZES = (GDN_HEADS * GDN_DK,
            GDN_HEADS * GDN_DK,
            GDN_HEADS * GDN_DV,
            GDN_HEADS * GDN_DV,
            GDN_HEADS,
            GDN_HEADS,
            MLA_Q_LORA,
            MLA_KV_LORA,
            MLA_ROPE)
D_IN = 4 * GDN_HEADS * GDN_DK + 2 * GDN_HEADS + MLA_Q_LORA + MLA_KV_LORA + MLA_ROPE

kernel_name = "hybrid_gdn_mla_moe_block"


def _split_points(sizes):
    pts, acc = [], 0
    for s in sizes[:-1]:
        acc += s
        pts.append(acc)
    return pts


def rms_norm(x, w):
    xf = x.astype(jnp.float32)
    y = xf * lax.rsqrt(jnp.mean(xf * xf, axis=-1, keepdims=True) + EPS)
    return (y * w.astype(jnp.float32)).astype(x.dtype)


def l2_norm(x):
    return x * lax.rsqrt(jnp.sum(x * x, axis=-1, keepdims=True) + EPS)


def causal_conv(x, w):
    k = w.shape[0]
    xp = jnp.pad(x, ((0, 0), (k - 1, 0), (0, 0)))
    return lax.conv_general_dilated(xp, w[:, None, :].astype(x.dtype), window_strides=(1,), padding='VALID',
                                    dimension_numbers=('NWC', 'WIO', 'NWC'),
                                    feature_group_count=x.shape[-1])


def chunk_gated_delta_rule(q, k, v, g, beta):
    bsz, s, h, dk = q.shape
    dv = v.shape[-1]
    n = s // CHUNK

    def to_chunks(t):
        t = t.reshape((bsz, n, CHUNK, h) + t.shape[3:])
        return jnp.moveaxis(t, (1, 3), (0, 2))

    q, k, v, g, beta = (to_chunks(t) for t in (q, k, v, g, beta))
    G = jnp.cumsum(g, axis=-1)
    idx = jnp.arange(CHUNK)
    causal = idx[:, None] >= idx[None, :]
    strict = idx[:, None] > idx[None, :]
    decay = jnp.exp(jnp.where(causal, G[..., :, None] - G[..., None, :], -jnp.inf))
    kb = k * beta[..., None]
    a_mat = jnp.where(strict, jnp.einsum('nbhcd,nbhsd->nbhcs', kb, k) * decay, 0.0)
    eye = jnp.eye(CHUNK, dtype=jnp.float32)
    t_mat = lax.linalg.triangular_solve(eye + a_mat, jnp.broadcast_to(eye, a_mat.shape),
                                        left_side=True, lower=True, unit_diagonal=True)
    u = jnp.einsum('nbhcs,nbhsd->nbhcd', t_mat, v * beta[..., None])
    w = jnp.einsum('nbhcs,nbhsd->nbhcd', t_mat, kb * jnp.exp(G)[..., None])
    qk = jnp.einsum('nbhcd,nbhsd->nbhcs', q, k) * decay
    q_dec = q * jnp.exp(G)[..., None]
    k_dec = k * jnp.exp(G[..., -1:] - G)[..., None]
    g_tot = jnp.exp(G[..., -1])

    def step(state, inp):
        u_n, w_n, qk_n, q_n, k_n, gt_n = inp
        v_new = u_n - jnp.einsum('bhcd,bhde->bhce', w_n, state)
        o_n = jnp.einsum('bhcd,bhde->bhce', q_n, state) + jnp.einsum('bhcs,bhse->bhce', qk_n, v_new)
        state = state * gt_n[..., None, None] + jnp.einsum('bhcd,bhce->bhde', k_n, v_new)
        return state, o_n

    s0 = jnp.zeros((bsz, h, dk, dv), jnp.float32)
    _, o = lax.scan(step, s0, (u, w, qk, q_dec, k_dec, g_tot))
    return jnp.moveaxis(o, (0, 2), (1, 3)).reshape(bsz, s, h, dv)


def gated_deltanet(q, k, v, z, a, b, conv_w, a_log, dt_bias, gdn_norm_w):
    bsz, s, _ = q.shape
    qkv = jax.nn.silu(causal_conv(jnp.concatenate([q, k, v], axis=-1), conv_w))
    q, k, v = jnp.split(qkv, [GDN_HEADS * GDN_DK, 2 * GDN_HEADS * GDN_DK], axis=-1)
    q = l2_norm(q.reshape(bsz, s, GDN_HEADS, GDN_DK).astype(jnp.float32)) * (GDN_DK ** -0.5)
    k = l2_norm(k.reshape(bsz, s, GDN_HEADS, GDN_DK).astype(jnp.float32))
    v = v.reshape(bsz, s, GDN_HEADS, GDN_DV).astype(jnp.float32)
    beta = jax.nn.sigmoid(b.astype(jnp.float32))
    g = -jnp.exp(a_log.astype(jnp.float32)) * jax.nn.softplus(a.astype(jnp.float32) + dt_bias.astype(jnp.float32))
    o = chunk_gated_delta_rule(q, k, v, g, beta)
    zf = z.reshape(bsz, s, GDN_HEADS, GDN_DV).astype(jnp.float32)
    o = rms_norm(o, gdn_norm_w) * jax.nn.silu(zf)
    return o.reshape(bsz, s, GDN_HEADS * GDN_DV).astype(z.dtype)


def rope_angles(positions):
    half = MLA_ROPE // 2
    inv_freq = ROPE_THETA ** (-jnp.arange(half, dtype=jnp.float32) / half)
    ang = positions.astype(jnp.float32)[..., None] * inv_freq
    return jnp.cos(ang), jnp.sin(ang)


def apply_rope(x, cos, sin):
    half = x.shape[-1] // 2
    xf = x.astype(jnp.float32)
    x1, x2 = xf[..., :half], xf[..., half:]
    return jnp.concatenate([x1 * cos - x2 * sin, x2 * cos + x1 * sin], axis=-1).astype(x.dtype)


def mla(c_q, c_kv, k_r, positions, q_norm_w, w_uq, kv_norm_w, w_ukv, mla_out_norm_w):
    bsz, s, _ = c_q.shape
    cos, sin = rope_angles(positions)
    q = (rms_norm(c_q, q_norm_w) @ w_uq).reshape(bsz, s, MLA_HEADS, MLA_NOPE + MLA_ROPE)
    q_nope, q_pe = q[..., :MLA_NOPE], q[..., MLA_NOPE:]
    q_pe = apply_rope(q_pe, cos[:, :, None, :], sin[:, :, None, :])
    kv = (rms_norm(c_kv, kv_norm_w) @ w_ukv).reshape(bsz, s, MLA_HEADS, MLA_NOPE + MLA_V)
    k_nope, v = kv[..., :MLA_NOPE], kv[..., MLA_NOPE:]
    k_pe = apply_rope(k_r, cos, sin)[:, :, None, :]
    q = jnp.concatenate([q_nope, q_pe], axis=-1).transpose(0, 2, 1, 3)
    k = jnp.concatenate([k_nope, jnp.broadcast_to(k_pe, (bsz, s, MLA_HEADS, MLA_ROPE))],
                        axis=-1).transpose(0, 2, 1, 3)
    v = v.transpose(0, 2, 1, 3)
    n_qb = s // Q_BLOCK
    q_blocks = jnp.moveaxis(q.reshape(bsz, MLA_HEADS, n_qb, Q_BLOCK, MLA_NOPE + MLA_ROPE), 2, 0)
    k_chunk = jnp.arange(s) // CHUNK
    scale = (MLA_NOPE + MLA_ROPE) ** -0.5

    def attend(args):
        qb, start = args
        sc = jnp.einsum('bhqd,bhkd->bhqk', qb, k).astype(jnp.float32) * scale
        q_chunk = (start + jnp.arange(Q_BLOCK)) // CHUNK
        sc = jnp.where(k_chunk[None, :] <= q_chunk[:, None], sc, -jnp.inf)
        p = jax.nn.softmax(sc, axis=-1)
        return jnp.einsum('bhqk,bhkd->bhqd', p.astype(v.dtype), v)

    o = lax.map(attend, (q_blocks, jnp.arange(n_qb, dtype=jnp.int32) * Q_BLOCK))
    o = jnp.moveaxis(o, 0, 2).reshape(bsz, MLA_HEADS, s, MLA_V).transpose(0, 2, 1, 3)
    return rms_norm(o.reshape(bsz, s, MLA_HEADS * MLA_V), mla_out_norm_w)


def moe_ffn(h, router_w, router_b, w1, b1, w2, b2):
    bsz, s, d = h.shape
    t = bsz * s
    xf = h.reshape(t, d)
    logits = (xf @ router_w + router_b).astype(jnp.float32)
    top_logits, top_idx = lax.top_k(logits, TOP_K)
    gates = jax.nn.softmax(top_logits, axis=-1)
    flat_e = top_idx.reshape(-1)
    order = jnp.argsort(flat_e)
    sorted_e = flat_e[order]
    tok = order // TOP_K
    counts = jnp.bincount(flat_e, length=N_EXPERTS)
    padded = (counts + MOE_BLOCK - 1) // MOE_BLOCK * MOE_BLOCK
    start = jnp.cumsum(counts) - counts
    padded_end = jnp.cumsum(padded)
    padded_start = padded_end - padded
    dest = padded_start[sorted_e] + jnp.arange(t * TOP_K) - start[sorted_e]
    n_pad = t * TOP_K + N_EXPERTS * MOE_BLOCK
    n_blocks = n_pad // MOE_BLOCK
    buf = jnp.zeros((n_pad, d), h.dtype).at[dest].set(xf[tok])
    block_expert = jnp.minimum(jnp.searchsorted(padded_end, jnp.arange(n_blocks) * MOE_BLOCK, side='right'),
                               N_EXPERTS - 1)

    def expert_block(args):
        xb, e = args
        hp = xb @ w1[e] + b1[e]
        x_glu = jnp.minimum(hp[:, ::2], SWIGLU_LIMIT)
        x_lin = jnp.clip(hp[:, 1::2], -SWIGLU_LIMIT, SWIGLU_LIMIT)
        act = x_glu * jax.nn.sigmoid(SWIGLU_ALPHA * x_glu) * (x_lin + 1)
        return act @ w2[e] + b2[e]

    y_blocks = lax.map(expert_block, (buf.reshape(n_blocks, MOE_BLOCK, d), block_expert))
    y_assign = y_blocks.reshape(n_pad, d)[dest] * gates.reshape(-1)[order][:, None].astype(h.dtype)
    y = jnp.zeros((t, d), h.dtype).at[tok].add(y_assign)
    return y.reshape(bsz, s, d)


def setup_inputs(seed: int = 0) -> dict:
    key = jax.random.key(seed)
    ks = jax.random.split(key, 24)
    f32 = jnp.float32

    def nrm(k, shape, scale):
        return jax.random.normal(k, shape, f32) * scale

    def gain(k, shape):
        return 1.0 + 0.02 * jax.random.normal(k, shape, f32)

    offset = jax.random.randint(ks[1], (BATCH,), 0, 4096, dtype=jnp.int32)
    positions = offset[:, None] + jnp.arange(SEQ, dtype=jnp.int32)[None, :]
    return {
        "x": nrm(ks[0], (BATCH, SEQ, D_MODEL), 1.0),
        "positions": positions,
        "norm_mix_w": gain(ks[2], (DEPTH, D_MODEL)),
        "w_in": nrm(ks[3], (DEPTH, D_MODEL, D_IN), D_MODEL ** -0.5),
        "conv_w": nrm(ks[4], (DEPTH, GDN_CONV, 2 * GDN_HEADS * GDN_DK + GDN_HEADS * GDN_DV), 0.5),
        "a_log": jnp.log(jax.random.uniform(ks[5], (DEPTH, GDN_HEADS), f32, 1.0, 16.0)),
        "dt_bias": nrm(ks[6], (DEPTH, GDN_HEADS), 0.1),
        "gdn_norm_w": gain(ks[7], (DEPTH, GDN_DV)),
        "q_norm_w": gain(ks[8], (DEPTH, MLA_Q_LORA)),
        "w_uq": nrm(ks[9], (DEPTH, MLA_Q_LORA, MLA_HEADS * (MLA_NOPE + MLA_ROPE)), MLA_Q_LORA ** -0.5),
        "kv_norm_w": gain(ks[10], (DEPTH, MLA_KV_LORA)),
        "w_ukv": nrm(ks[11], (DEPTH, MLA_KV_LORA, MLA_HEADS * (MLA_NOPE + MLA_V)), MLA_KV_LORA ** -0.5),
        "mla_out_norm_w": gain(ks[12], (DEPTH, MLA_HEADS * MLA_V)),
        "w_out": nrm(ks[13], (DEPTH, D_MIX, D_MODEL), D_MIX ** -0.5),
        "norm_ffn_w": gain(ks[14], (DEPTH, D_MODEL)),
        "router_w": nrm(ks[15], (DEPTH, D_MODEL, N_EXPERTS), D_MODEL ** -0.5),
        "router_b": nrm(ks[16], (DEPTH, N_EXPERTS), 0.01),
        "w1": nrm(ks[17], (DEPTH, N_EXPERTS, D_MODEL, 2 * D_FF), D_MODEL ** -0.5),
        "b1": nrm(ks[18], (DEPTH, N_EXPERTS, 2 * D_FF), 0.01),
        "w2": nrm(ks[19], (DEPTH, N_EXPERTS, D_FF, D_MODEL), D_FF ** -0.5),
        "b2": nrm(ks[20], (DEPTH, N_EXPERTS, D_MODEL), 0.01),
        "norm_final_w": gain(ks[21], (D_MODEL,)),
    }


def reference(x, positions, norm_mix_w, w_in, conv_w, a_log, dt_bias, gdn_norm_w, q_norm_w, w_uq,
              kv_norm_w, w_ukv, mla_out_norm_w, w_out, norm_ffn_w, router_w, router_b, w1, b1, w2, b2,
              norm_final_w):
    split_pts = _split_points(IN_SIZES)
    for l in range(DEPTH):
        h = rms_norm(x, norm_mix_w[l])
        proj = h @ w_in[l]
        q_a, k_a, v_a, z_a, a_a, b_a, c_q, c_kv, k_r = jnp.split(proj, split_pts, axis=-1)
        o_a = gated_deltanet(q_a, k_a, v_a, z_a, a_a, b_a, conv_w[l], a_log[l], dt_bias[l], gdn_norm_w[l])
        o_b = mla(c_q, c_kv, k_r, positions, q_norm_w[l], w_uq[l], kv_norm_w[l], w_ukv[l], mla_out_norm_w[l])
        x = x + jnp.concatenate([o_a, o_b], axis=-1) @ w_out[l]
        x = x + moe_ffn(rms_norm(x, norm_ffn_w[l]), router_w[l], router_b[l], w1[l], b1[l], w2[l], b2[l])
    return rms_norm(x, norm_final_w)
```

```cpp
#include <hip/hip_runtime.h>
#include <cstdio>
#include <cstdint>

#ifndef LEVEL
#define LEVEL 4
#endif

#define LAS __attribute__((address_space(3)))
typedef unsigned short bf16_t;
typedef short bf16x8 __attribute__((ext_vector_type(8)));
typedef float f32x4 __attribute__((ext_vector_type(4)));
typedef float f32x16 __attribute__((ext_vector_type(16)));
typedef unsigned u32x4 __attribute__((ext_vector_type(4)));
typedef unsigned u32x2 __attribute__((ext_vector_type(2)));

constexpr int NB = 4, SEQ = 4096, T = NB * SEQ, D = 1024, DIN = 2728, DINP = 2816;
constexpr int GH = 4, NCH = SEQ / 64;
constexpr int MH = 8, DQK = 96, QL = 384, KVL = 256;
constexpr int NE = 32, DFF = 1024;
constexpr int C_Z = 1536, C_CQ = 2056, C_CKV = 2440, C_KR = 2696;
constexpr float EPS = 1e-6f;
constexpr int NTHREADS = 512, NWAVES = 8;
constexpr int LDS_BYTES = 147456;
constexpr int LDS_MISC = 131072;
constexpr int MOE_MAXROWS = 73728;

constexpr size_t MiB = 1u << 20;
constexpr size_t WS_CTL = 0, CTL_BYTES = 65536;
constexpr size_t WS_WIN = 1 * MiB, WS_WUQ = 7 * MiB, WS_WUKV = 8 * MiB, WS_WOUT = 9 * MiB, WS_W1 = 11 * MiB, WS_W2 = 139 * MiB;
constexpr size_t WS_X1 = 203 * MiB, WS_H = 267 * MiB, WS_AB = 299 * MiB, WS_TAB = 300 * MiB;
constexpr size_t WS_TOKE = 302 * MiB, WS_TOKR = WS_TOKE + 256 * 1024, WS_GATE = WS_TOKR + 256 * 1024, WS_LIST = 303 * MiB;
constexpr size_t WS_R = 306 * MiB;
constexpr size_t WS_PROJ = WS_R, WS_CQN = WS_R + 88 * MiB, WS_CKVN = WS_R + 100 * MiB, WS_Q = WS_R + 108 * MiB, WS_K = WS_R + 132 * MiB, WS_VT = WS_R + 156 * MiB;
constexpr size_t WS_GP = WS_R + 172 * MiB;
constexpr size_t GP_ITEM = 90112, GP_U = 0, GP_W = 32768, GP_QD = 49152, GP_KDT = 65536, GP_QK = 81920;
constexpr size_t WS_GT = WS_R + 260 * MiB, WS_OA = WS_R + 261 * MiB, WS_OB = WS_R + 293 * MiB, WS_OCAT = WS_R + 309 * MiB;
constexpr size_t WS_ACT = WS_R, WS_Y = WS_R + 144 * MiB;
constexpr size_t WS_END = WS_R + 341 * MiB;
constexpr int CW_BAR = 4096, CW_CNT = 8192  , CW_AQ = 8320  ;

struct Params {
    const float* x; const int* pos; const float* norm_mix_w; const float* w_in; const float* conv_w; const float* a_log; const float* dt_bias;
    const float* gdn_norm_w; const float* q_norm_w; const float* w_uq; const float* kv_norm_w; const float* w_ukv; const float* mla_out_norm_w;
    const float* w_out; const float* norm_ffn_w; const float* router_w; const float* router_b; const float* w1; const float* b1; const float* w2;
    const float* b2; const float* norm_final_w; float* out; unsigned char* ws;
};

__device__ __forceinline__ unsigned f2bf(float f) { unsigned u = __builtin_bit_cast(unsigned, f); return (u + 0x7fffu + ((u >> 16) & 1u)) >> 16; }
__device__ __forceinline__ unsigned pk2(float lo, float hi) { return f2bf(lo) | (f2bf(hi) << 16); }
__device__ __forceinline__ float bflo(unsigned u) { return __builtin_bit_cast(float, u << 16); }
__device__ __forceinline__ float bfhi(unsigned u) { return __builtin_bit_cast(float, u & 0xffff0000u); }
__device__ __forceinline__ float bf1(bf16_t b) { return __builtin_bit_cast(float, (unsigned)b << 16); }
__device__ __forceinline__ float wave_sum(float v) {
#pragma unroll
    for (int o = 1; o < 64; o <<= 1) v += __shfl_xor(v, o);
    return v;
}
__device__ __forceinline__ int opaque_tid() { int t = threadIdx.x; asm volatile("" : "+v"(t)); return t; }
__device__ __forceinline__ float sigmoidf_(float x) { return 1.f / (1.f + __expf(-x)); }
__device__ __forceinline__ bf16x8 pack8(f32x4 a, f32x4 b) {
    u32x4 r; r.x = pk2(a.x, a.y); r.y = pk2(a.z, a.w); r.z = pk2(b.x, b.y); r.w = pk2(b.z, b.w);
    return __builtin_bit_cast(bf16x8, r);
}
__device__ __forceinline__ int perm32k(int d) { return (d & ~31) | (((d >> 2) & 3) << 3) | (((d >> 4) & 1) << 2) | (d & 3); }
__device__ __forceinline__ int perm16v(int s) { return (s & ~15) | (((s >> 2) & 1) << 3) | (((s >> 3) & 1) << 2) | (s & 3); }

#define XB_TMO      128
#define XB_XCNT(j)  (256  + 64 * (j))
#define XB_XSUB(j)  (1280 + 64 * (j))
#define XB_XGEN(j)  (2304 + 64 * (j))
#define XB_TOP      3328
#define XB_TOPGEN   3392
#define XCD_BAR_WORDS 3456
#define XB_SPIN_CAP (1u << 18)
__device__ __forceinline__ unsigned xb_ld(unsigned* p)              { return __hip_atomic_load(p, __ATOMIC_RELAXED, __HIP_MEMORY_SCOPE_AGENT); }
__device__ __forceinline__ unsigned xb_add(unsigned* p, unsigned v) { return __hip_atomic_fetch_add(p, v, __ATOMIC_RELAXED, __HIP_MEMORY_SCOPE_AGENT); }
__device__ __forceinline__ unsigned xb_xcc_id() { return (unsigned)__builtin_amdgcn_s_getreg((3 << 11) | 20) & 0xFu; }
#define XB_SPIN(cond, bar) do { unsigned _sp = 0; while (cond) { __builtin_amdgcn_s_sleep(1); \
    if ((++_sp & 255u) == 0u) { if (xb_ld(&(bar)[XB_TMO])) break; if (_sp > XB_SPIN_CAP) { atomicAdd(&(bar)[XB_TMO], 1u); break; } } } } while (0)
struct XcdBarrier { unsigned* bar; unsigned x; volatile LAS unsigned* st; };
__device__ __forceinline__ XcdBarrier xcd_barrier_post(unsigned* bar, volatile LAS unsigned* st) {
    XcdBarrier b; b.bar = bar; b.x = xb_xcc_id(); b.st = st;
    if (threadIdx.x == 0) (void)xb_add(&bar[XB_XCNT(b.x)], 1u);
    return b;
}
__device__ __forceinline__ void xcd_barrier_complete(unsigned* bar, unsigned x, unsigned& nloc, unsigned& nx) {
    const unsigned G = gridDim.x * gridDim.y * gridDim.z;
    unsigned sum, cnt, mine, sp = 0u;
    for (;;) {
        sum = 0u; cnt = 0u; mine = 0u;
#pragma unroll
        for (unsigned j = 0; j < 16; ++j) { const unsigned c = xb_ld(&bar[XB_XCNT(j)]); sum += c; cnt += (c > 0u) ? 1u : 0u; mine = (j == x) ? c : mine; }
        if (sum == G) break;
        __builtin_amdgcn_s_sleep(1);
        if ((++sp & 255u) == 0u) { if (xb_ld(&bar[XB_TMO])) break; if (sp > XB_SPIN_CAP) { atomicAdd(&bar[XB_TMO], 1u); break; } }
    }
    nloc = mine > 0u ? mine : 1u; nx = cnt > 0u ? cnt : 1u;
}
__device__ __forceinline__ void xcd_barrier(const XcdBarrier& b) {
    asm volatile("s_waitcnt vmcnt(0)" ::: "memory");
    __syncthreads();
    if (threadIdx.x == 0) {
        unsigned* bar = b.bar;
        __builtin_amdgcn_s_waitcnt(0);
        unsigned nloc = b.st[0], nx = b.st[1];
        if (nloc == 0u) { xcd_barrier_complete(bar, b.x, nloc, nx); b.st[0] = nloc; b.st[1] = nx; }
        const unsigned old = xb_add(&bar[XB_XSUB(b.x)], 1u);
        const unsigned gen = old / nloc;
        if (old + 1u == (gen + 1u) * nloc) {
            __builtin_amdgcn_fence(__ATOMIC_RELEASE, "agent");
            asm volatile("s_waitcnt vmcnt(0)" ::: "memory");
            const unsigned og = xb_add(&bar[XB_TOP], 1u);
            const unsigned tg = og / nx;
            if (og + 1u == (tg + 1u) * nx) xb_add(&bar[XB_TOPGEN], 1u);
            else XB_SPIN(xb_ld(&bar[XB_TOPGEN]) == tg, bar);
            __builtin_amdgcn_fence(__ATOMIC_ACQUIRE, "agent");
            xb_add(&bar[XB_XGEN(b.x)], 1u);
            asm volatile("s_waitcnt vmcnt(0)" ::: "memory");
        } else {
            XB_SPIN(xb_ld(&bar[XB_XGEN(b.x)]) == gen, bar);
            __builtin_amdgcn_fence(__ATOMIC_ACQUIRE, "agent");
            asm volatile("s_waitcnt vmcnt(0)" ::: "memory");
        }
    }
    __syncthreads();
}

namespace pg8 {
constexpr int BM = 256, BK = 64, HALF = 128, HTB = HALF * BK * 2, NXCD = 8, WGM = 8;
__device__ __forceinline__ int lds_byte(int r, int c) { const int st = (r >> 4) * 2 + (c >> 5), rr = r & 15, cc = c & 31, ob = rr * 64 + cc * 2; return st * 1024 + (ob ^ (((ob >> 9) & 1) << 5)); }
__device__ __forceinline__ void stage_rc(int b, int& R, int& C) { const int st = b / 1024, sb = b % 1024, swz = sb ^ (((sb >> 9) & 1) << 5); R = (st >> 1) * 16 + swz / 64; C = (st & 1) * 32 + (swz % 64) / 2; }
__device__ __forceinline__ int perm32(int rho) { const int n = rho >> 4, i = rho & 15; return 8 * (i >> 2) + 4 * n + (i & 3); }

struct Unit { int pm, pn, e; const char* A; const char* B; };

__device__ __forceinline__ void tile_order(int L, int nM, int nN, int& pm, int& pn) {
    const int nwg = nM * nN; int wgid = L;
    { const int q = nwg / NXCD, r = nwg % NXCD, xcd = wgid % NXCD, off = wgid / NXCD; wgid = (xcd < r ? xcd * (q + 1) : r * (q + 1) + (xcd - r) * q) + off; }
    const int nig = WGM * nN, gid = wgid / nig, fm = gid * WGM, gsz = (nM - fm) < WGM ? (nM - fm) : WGM;
    pm = fm + ((wgid % nig) % gsz); pn = (wgid % nig) / gsz;
}

template <class Epi, class Sched>
__device__ __forceinline__ void gemm_phase(LAS unsigned char* lds, const int K, const Sched& S, const Epi& E) {
    const int tid = opaque_tid(), wid = __builtin_amdgcn_readfirstlane(tid >> 6), lane = tid & 63, wr = wid >> 2, wc = wid & 3, fr = lane & 15, fq = lane >> 4;
    const int nt = K / BK;
    int Rr[2], Cc[2];
    unsigned voffB[2];
#pragma unroll
    for (int i = 0; i < 2; ++i) { stage_rc(tid * 16 + i * 8192, Rr[i], Cc[i]); const int Rb = Epi::PERM ? ((Rr[i] & ~31) + perm32(Rr[i] & 31)) : Rr[i]; voffB[i] = (unsigned)(Rb * K + Cc[i]) * 2u; }
    const size_t kstep = (size_t)(BK * 2);
    const unsigned hstep = (unsigned)HALF * K * 2;
    const unsigned ldsw = (unsigned)wid * 1024u;
    const int aoff = lds_byte(wr * 64 + fr, fq * 8), boff = lds_byte(wc * 32 + fr, fq * 8);
#define PG8_SA(b, h) (((b) * 2 + (h)) * HTB)
#define PG8_SB(b, h) ((4 + (b) * 2 + (h)) * HTB)
#define PG8_STAGE_A(bufoff, base, kb, h, VO) do { _Pragma("unroll") for (int _i = 0; _i < 2; ++_i) \
        __builtin_amdgcn_global_load_lds((const unsigned*)((base) + (kb) + (Sched::GATHER ? 0u : (h) * hstep) + (VO)[Sched::GATHER ? (h) : 0][_i]), (LAS unsigned*)(lds + (bufoff) + ldsw + _i * 8192), 16, 0, 0); } while (0)
#define PG8_STAGE_B(bufoff, base, kb, h) do { _Pragma("unroll") for (int _i = 0; _i < 2; ++_i) \
        __builtin_amdgcn_global_load_lds((const unsigned*)((base) + (kb) + (h) * hstep + voffB[_i]), (LAS unsigned*)(lds + (bufoff) + ldsw + _i * 8192), 16, 0, 0); } while (0)
#define PG8_LDA(dst, b, h) do { _Pragma("unroll") for (int m = 0; m < 4; ++m) _Pragma("unroll") for (int k = 0; k < 2; ++k) dst[m][k] = *(const LAS bf16x8*)(lds + PG8_SA(b, h) + aoff + m * 2048 + k * 1024); } while (0)
#define PG8_LDB(dst, b, h) do { _Pragma("unroll") for (int n = 0; n < 2; ++n) _Pragma("unroll") for (int k = 0; k < 2; ++k) dst[n][k] = *(const LAS bf16x8*)(lds + PG8_SB(b, h) + boff + n * 2048 + k * 1024); } while (0)
#define PG8_MMA(ai, bj, At, Bt) do { __builtin_amdgcn_s_setprio(1); _Pragma("unroll") for (int m = 0; m < 4; ++m) _Pragma("unroll") for (int n = 0; n < 2; ++n) _Pragma("unroll") for (int k = 0; k < 2; ++k) \
        acc[ai][bj][m][n] = __builtin_amdgcn_mfma_f32_16x16x32_bf16(Bt[n][k], At[m][k], acc[ai][bj][m][n], 0, 0, 0); __builtin_amdgcn_s_setprio(0); } while (0)
#define PG8_WAIT_V(n) asm volatile("s_waitcnt vmcnt(" #n ")" ::: "memory")
#define PG8_WAIT_L(n) asm volatile("s_waitcnt lgkmcnt(" #n ")" ::: "memory")
#define PG8_BAR __builtin_amdgcn_s_barrier()
#define PG8_SCHED __builtin_amdgcn_sched_barrier(0)
#define PG8_AOFFS(VO, u) do { _Pragma("unroll") for (int _h = 0; _h < 2; ++_h) _Pragma("unroll") for (int _i = 0; _i < 2; ++_i) { \
        if constexpr (Sched::GATHER) VO[_h][_i] = (unsigned)S.row_src(u, _h * HALF + Rr[_i]) * (unsigned)(K * 2) + (unsigned)(Cc[_i] * 2); \
        else VO[_h][_i] = (unsigned)(Rr[_i] * K + Cc[_i]) * 2u; } } while (0)
    Unit cur, nxt; int ui = 0;
    if (!S.next(0, cur)) return;
    unsigned voc[2][2], von[2][2];
    PG8_AOFFS(voc, cur);
    f32x4 acc[2][2][4][2];
#pragma unroll
    for (int a = 0; a < 2; ++a)
#pragma unroll
        for (int b = 0; b < 2; ++b)
#pragma unroll
            for (int m = 0; m < 4; ++m)
#pragma unroll
                for (int n = 0; n < 2; ++n) acc[a][b][m][n] = (f32x4){0.f, 0.f, 0.f, 0.f};
    bf16x8 At[4][2], B0[2][2], B1[2][2];
    const char* cA = cur.A; const char* cB = cur.B;
    PG8_STAGE_B(PG8_SB(0, 0), cB, 0, 0); PG8_STAGE_A(PG8_SA(0, 0), cA, 0, 0, voc); PG8_STAGE_B(PG8_SB(0, 1), cB, 0, 1); PG8_STAGE_A(PG8_SA(0, 1), cA, 0, 1, voc);
    if (wr == 1) PG8_BAR;
    PG8_WAIT_V(4); PG8_BAR;
    PG8_STAGE_B(PG8_SB(1, 0), cB, kstep, 0); PG8_STAGE_A(PG8_SA(1, 0), cA, kstep, 0, voc); PG8_STAGE_B(PG8_SB(1, 1), cB, kstep, 1);
    PG8_WAIT_V(6); PG8_BAR;
    for (;;) {
        const bool has_next = S.next(ui + 1, nxt);
        if constexpr (Sched::GATHER) {
            if (has_next) { PG8_AOFFS(von, nxt); }
            else {
#pragma unroll
                for (int _h = 0; _h < 2; ++_h)
#pragma unroll
                    for (int _i = 0; _i < 2; ++_i) von[_h][_i] = voc[_h][_i];
            }
        }
        const char* nA = has_next ? nxt.A : cA; const char* nB = has_next ? nxt.B : cB;
        for (int t = 0; t < nt; t += 2) {
            const bool last = (t == nt - 2);
            const size_t k1 = (size_t)(t + 1) * kstep;
            const char* a2 = last ? nA : cA; const char* b2 = last ? nB : cB;
            const size_t k2 = last ? 0 : (size_t)(t + 2) * kstep, k3 = k2 + kstep;
            unsigned vo2[2][2];
#pragma unroll
            for (int _h = 0; _h < 2; ++_h)
#pragma unroll
                for (int _i = 0; _i < 2; ++_i) { if constexpr (Sched::GATHER) vo2[_h][_i] = last ? von[_h][_i] : voc[_h][_i]; else vo2[_h][_i] = voc[_h][_i]; }
            PG8_LDB(B0, 0, 0); PG8_SCHED; PG8_LDA(At, 0, 0); PG8_STAGE_A(PG8_SA(1, 1), cA, k1, 1, voc);
            PG8_WAIT_L(8); PG8_BAR; PG8_WAIT_L(0); PG8_MMA(0, 0, At, B0); PG8_BAR; PG8_SCHED;
            PG8_LDB(B1, 0, 1); PG8_STAGE_B(PG8_SB(0, 0), b2, k2, 0);
            PG8_BAR; PG8_WAIT_L(0); PG8_MMA(0, 1, At, B1); PG8_BAR;
            PG8_LDA(At, 0, 1); PG8_STAGE_A(PG8_SA(0, 0), a2, k2, 0, vo2);
            PG8_BAR; PG8_WAIT_L(0); PG8_MMA(1, 0, At, B0); PG8_BAR; PG8_SCHED;
            PG8_STAGE_B(PG8_SB(0, 1), b2, k2, 1);
            PG8_WAIT_V(6); PG8_BAR; PG8_MMA(1, 1, At, B1); PG8_BAR;
            PG8_LDB(B0, 1, 0); PG8_SCHED; PG8_LDA(At, 1, 0); PG8_STAGE_A(PG8_SA(0, 1), a2, k2, 1, vo2);
            PG8_WAIT_L(8); PG8_BAR; PG8_WAIT_L(0); PG8_MMA(0, 0, At, B0); PG8_BAR; PG8_SCHED;
            PG8_LDB(B1, 1, 1); PG8_STAGE_B(PG8_SB(1, 0), b2, k3, 0);
            PG8_BAR; PG8_WAIT_L(0); PG8_MMA(0, 1, At, B1); PG8_BAR;
            PG8_LDA(At, 1, 1); PG8_STAGE_A(PG8_SA(1, 0), a2, k3, 0, vo2);
            PG8_BAR; PG8_WAIT_L(0); PG8_MMA(1, 0, At, B0); PG8_BAR; PG8_SCHED;
            PG8_STAGE_B(PG8_SB(1, 1), b2, k3, 1);
            PG8_WAIT_V(6); PG8_BAR; PG8_MMA(1, 1, At, B1); PG8_BAR;
        }
        E(acc, cur, wr, wc, fr, fq);
        if (!has_next) break;
#pragma unroll
        for (int a = 0; a < 2; ++a)
#pragma unroll
            for (int b = 0; b < 2; ++b)
#pragma unroll
                for (int m = 0; m < 4; ++m)
#pragma unroll
                    for (int n = 0; n < 2; ++n) acc[a][b][m][n] = (f32x4){0.f, 0.f, 0.f, 0.f};
        cur = nxt; cA = nA; cB = nB; ++ui;
        if constexpr (Sched::GATHER) {
#pragma unroll
            for (int _h = 0; _h < 2; ++_h)
#pragma unroll
                for (int _i = 0; _i < 2; ++_i) voc[_h][_i] = von[_h][_i];
        }
    }
    PG8_WAIT_V(0);
    if (wr == 0) PG8_BAR;
    PG8_BAR;
#undef PG8_SA
#undef PG8_SB
#undef PG8_STAGE_A
#undef PG8_STAGE_B
#undef PG8_LDA
#undef PG8_LDB
#undef PG8_MMA
#undef PG8_WAIT_V
#undef PG8_WAIT_L
#undef PG8_BAR
#undef PG8_SCHED
#undef PG8_AOFFS
}

struct DenseOrder {
    static constexpr bool GATHER = false;
    const char* A; const char* Bt; int nM, nN, K, G, c;
    __device__ __forceinline__ bool next(int i, Unit& u) const {
        const int L = i * G + c; if (L >= nM * nN) return false;
        tile_order(L, nM, nN, u.pm, u.pn); u.e = 0;
        u.A = A + (size_t)u.pm * BM * K * 2; u.B = Bt + (size_t)u.pn * BM * K * 2; return true;
    }
    __device__ __forceinline__ int row_src(const Unit&, int) const { return 0; }
};
}
using pg8::Unit;

struct EpiProj {
    static constexpr bool PERM = true;
    bf16_t* O;
    __device__ __forceinline__ void operator()(const f32x4 (&acc)[2][2][4][2], const Unit& u, int wr, int wc, int fr, int fq) const {
#pragma unroll
        for (int ai = 0; ai < 2; ++ai)
#pragma unroll
            for (int m = 0; m < 4; ++m) { const int row = u.pm * 256 + ai * 128 + wr * 64 + m * 16 + fr;
#pragma unroll
                for (int bj = 0; bj < 2; ++bj) { const int col = u.pn * 256 + bj * 128 + wc * 32 + 8 * fq; const f32x4 v0 = acc[ai][bj][m][0], v1 = acc[ai][bj][m][1];
                    u32x4 o; o.x = pk2(v0.x, v0.y); o.y = pk2(v0.z, v0.w); o.z = pk2(v1.x, v1.y); o.w = pk2(v1.z, v1.w);
                    *(u32x4*)(O + (size_t)row * DINP + col) = o; } }
    }
};
struct EpiQ {
    static constexpr bool PERM = false;
    bf16_t* Q; const float* tab;
    __device__ __forceinline__ void operator()(const f32x4 (&acc)[2][2][4][2], const Unit& u, int wr, int wc, int fr, int fq) const {
        const float sc = 0.10206207261596577f * 1.4426950408889634f;
#pragma unroll
        for (int ai = 0; ai < 2; ++ai)
#pragma unroll
            for (int m = 0; m < 4; ++m) { const int row = u.pm * 256 + ai * 128 + wr * 64 + m * 16 + fr; const int b = row / SEQ, s = row % SEQ;
#pragma unroll
                for (int bj = 0; bj < 2; ++bj) { const int c0 = u.pn * 256 + bj * 128 + wc * 32; const int g32 = c0 >> 5; const int head = c0 / 96;
                    f32x4 v0 = acc[ai][bj][m][0], v1 = acc[ai][bj][m][1];
                    if (g32 % 3 == 2) {
                        const f32x4 cs = *(const f32x4*)(tab + (size_t)row * 32 + 4 * fq), sn = *(const f32x4*)(tab + (size_t)row * 32 + 16 + 4 * fq);
                        const f32x4 r0 = v0 * cs - v1 * sn, r1 = v1 * cs + v0 * sn; v0 = r0; v1 = r1;
                    }
                    v0 = v0 * sc; v1 = v1 * sc;
                    bf16_t* base = Q + ((size_t)(b * MH + head) * SEQ + s) * DQK + (c0 - head * 96) + 4 * fq;
                    u32x2 o0; o0.x = pk2(v0.x, v0.y); o0.y = pk2(v0.z, v0.w); *(u32x2*)(base) = o0;
                    u32x2 o1; o1.x = pk2(v1.x, v1.y); o1.y = pk2(v1.z, v1.w); *(u32x2*)(base + 16) = o1; } }
    }
};
struct EpiKV {
    static constexpr bool PERM = false;
    bf16_t* Kp; bf16_t* VT;
    __device__ __forceinline__ void operator()(const f32x4 (&acc)[2][2][4][2], const Unit& u, int wr, int wc, int fr, int fq) const {
#pragma unroll
        for (int ai = 0; ai < 2; ++ai)
#pragma unroll
            for (int m = 0; m < 4; ++m) { const int row = u.pm * 256 + ai * 128 + wr * 64 + m * 16 + fr; const int b = row / SEQ, s = row % SEQ;
#pragma unroll
                for (int bj = 0; bj < 2; ++bj) { const int c0 = u.pn * 256 + bj * 128 + wc * 32; const int head = c0 >> 7; const int w0 = c0 & 127;
#pragma unroll
                    for (int n = 0; n < 2; ++n) { const f32x4 v = acc[ai][bj][m][n]; const int within = w0 + 16 * n + 4 * fq;
                        if (within < 64) { u32x2 o; o.x = pk2(v.x, v.y); o.y = pk2(v.z, v.w); *(u32x2*)(Kp + ((size_t)(b * MH + head) * SEQ + s) * DQK + within) = o; }
                        else { bf16_t* vb = VT + ((size_t)(b * MH + head) * 64 + (within - 64)) * SEQ + perm16v(s);
                            vb[0] = (bf16_t)f2bf(v.x); vb[SEQ] = (bf16_t)f2bf(v.y); vb[2 * SEQ] = (bf16_t)f2bf(v.z); vb[3 * SEQ] = (bf16_t)f2bf(v.w); } } } }
    }
};
struct EpiX1 {
    static constexpr bool PERM = false;
    const float* x; float* X1;
    __device__ __forceinline__ void operator()(const f32x4 (&acc)[2][2][4][2], const Unit& u, int wr, int wc, int fr, int fq) const {
#pragma unroll
        for (int ai = 0; ai < 2; ++ai)
#pragma unroll
            for (int m = 0; m < 4; ++m) { const int row = u.pm * 256 + ai * 128 + wr * 64 + m * 16 + fr;
#pragma unroll
                for (int bj = 0; bj < 2; ++bj)
#pragma unroll
                    for (int n = 0; n < 2; ++n) { const size_t o = (size_t)row * D + u.pn * 256 + bj * 128 + wc * 32 + 16 * n + 4 * fq;
                        *(f32x4*)(X1 + o) = *(const f32x4*)(x + o) + acc[ai][bj][m][n]; } }
    }
};
struct EpiAct {
    static constexpr bool PERM = true;
    bf16_t* ACT; const float* b1;
    __device__ __forceinline__ void operator()(const f32x4 (&acc)[2][2][4][2], const Unit& u, int wr, int wc, int fr, int fq) const {
        const float* bb = b1 + (size_t)u.e * 2048;
#pragma unroll
        for (int bj = 0; bj < 2; ++bj) { const int col = u.pn * 256 + bj * 128 + wc * 32 + 8 * fq;
            const f32x4 bv0 = *(const f32x4*)(bb + col), bv1 = *(const f32x4*)(bb + col + 4);
#pragma unroll
            for (int ai = 0; ai < 2; ++ai)
#pragma unroll
                for (int m = 0; m < 4; ++m) { const int row = u.pm * 256 + ai * 128 + wr * 64 + m * 16 + fr;
                    const f32x4 v0 = acc[ai][bj][m][0] + bv0, v1 = acc[ai][bj][m][1] + bv1;
                    float g[4] = {v0.x, v0.z, v1.x, v1.z}, l[4] = {v0.y, v0.w, v1.y, v1.w}, a[4];
#pragma unroll
                    for (int i = 0; i < 4; ++i) { const float xg = fminf(g[i], 7.f), xl = fminf(fmaxf(l[i], -7.f), 7.f); a[i] = xg * sigmoidf_(1.702f * xg) * (xl + 1.f); }
                    u32x2 o; o.x = pk2(a[0], a[1]); o.y = pk2(a[2], a[3]);
                    *(u32x2*)(ACT + (size_t)row * DFF + (col >> 1)) = o; } }
    }
};
struct EpiY {
    static constexpr bool PERM = true;
    bf16_t* Y; const float* b2;
    __device__ __forceinline__ void operator()(const f32x4 (&acc)[2][2][4][2], const Unit& u, int wr, int wc, int fr, int fq) const {
        const float* bb = b2 + (size_t)u.e * 1024;
#pragma unroll
        for (int bj = 0; bj < 2; ++bj) { const int col = u.pn * 256 + bj * 128 + wc * 32 + 8 * fq;
            const f32x4 bv0 = *(const f32x4*)(bb + col), bv1 = *(const f32x4*)(bb + col + 4);
#pragma unroll
            for (int ai = 0; ai < 2; ++ai)
#pragma unroll
                for (int m = 0; m < 4; ++m) { const int row = u.pm * 256 + ai * 128 + wr * 64 + m * 16 + fr;
                    const f32x4 v0 = acc[ai][bj][m][0] + bv0, v1 = acc[ai][bj][m][1] + bv1;
                    u32x4 o; o.x = pk2(v0.x, v0.y); o.y = pk2(v0.z, v0.w); o.z = pk2(v1.x, v1.y); o.w = pk2(v1.z, v1.w);
                    *(u32x4*)(Y + (size_t)row * D + col) = o; } }
    }
};

struct MoeOrder1 {
    static constexpr bool GATHER = true;
    const char* H2; const char* W1T; const int* list; const LAS int* tstart; const LAS int* cnt; int G, c;
    __device__ __forceinline__ bool next(int i, Unit& u) const {
        const int L = i * G + c; const int ntile = tstart[NE]; if (L >= ntile * 8) return false;
        u.pm = L >> 3; u.pn = L & 7; int e = 0;
#pragma unroll 1
        for (int j = 1; j < NE; ++j) e = (tstart[j] <= u.pm) ? j : e;
        u.e = e; u.A = H2; u.B = W1T + ((size_t)e * 2048 + (size_t)u.pn * 256) * 1024 * 2; return true;
    }
    __device__ __forceinline__ int row_src(const Unit& u, int r) const {
        const int rank = (u.pm - tstart[u.e]) * 256 + r; return rank < cnt[u.e] ? list[u.e * T + rank] : 0;
    }
};
struct MoeOrder2 {
    static constexpr bool GATHER = false;
    const char* ACT; const char* W2T; const LAS int* tstart; int G, c;
    __device__ __forceinline__ bool next(int i, Unit& u) const {
        const int L = i * G + c; const int ntile = tstart[NE]; if (L >= ntile * 4) return false;
        u.pm = L >> 2; u.pn = L & 3; int e = 0;
#pragma unroll 1
        for (int j = 1; j < NE; ++j) e = (tstart[j] <= u.pm) ? j : e;
        u.e = e; u.A = ACT + (size_t)u.pm * 256 * 1024 * 2; u.B = W2T + ((size_t)e * 1024 + (size_t)u.pn * 256) * 1024 * 2; return true;
    }
    __device__ __forceinline__ int row_src(const Unit&, int) const { return 0; }
};

__device__ __forceinline__ void transpose_item(const float* W, int K, int N, bf16_t* WT, float* scr, int item, int nblk, int lane) {
    const int kb = item / nblk, nb = item % nblk, k0 = 64 * kb, n0 = 32 * nb;
    const int nn = n0 + (lane & 31);
#pragma unroll 8
    for (int i = 0; i < 32; ++i) { const int kk = 2 * i + (lane >> 5); scr[kk * 33 + (lane & 31)] = (nn < N) ? W[(size_t)(k0 + kk) * N + nn] : 0.f; }
    asm volatile("s_waitcnt lgkmcnt(0)" ::: "memory");
    const int c = lane & 7;
#pragma unroll
    for (int j = 0; j < 4; ++j) { const int n = (lane >> 3) + 8 * j; const float* s = scr + (8 * c) * 33 + n;
        u32x4 o; o.x = pk2(s[0 * 33], s[1 * 33]); o.y = pk2(s[2 * 33], s[3 * 33]); o.z = pk2(s[4 * 33], s[5 * 33]); o.w = pk2(s[6 * 33], s[7 * 33]);
        *(u32x4*)(WT + (size_t)(n0 + n) * K + k0 + 8 * c) = o; }
    asm volatile("s_waitcnt lgkmcnt(0)" ::: "memory");
}

__device__ __forceinline__ void phase0(const Params& P, unsigned char* smem) {
    unsigned char* ws = P.ws;
    const int tid_ = opaque_tid(), lane = tid_ & 63, wave = tid_ >> 6, gw = blockIdx.x * NWAVES + wave, ngw = gridDim.x * NWAVES;
    float* scr = (float*)(smem + wave * 8448);
    float* slab = (float*)(smem + 73728);
    for (int i = tid_; i < 1024 * 8; i += NTHREADS) slab[i] = P.w_in[(size_t)(i >> 3) * DIN + 2048 + (i & 7)];
    __syncthreads();
    bf16_t* H = (bf16_t*)(ws + WS_H); float* AB = (float*)(ws + WS_AB);
    for (int row = gw; row < T; row += ngw) {
        const f32x4* xr = (const f32x4*)(P.x + (size_t)row * D) + lane;
        f32x4 v[4]; float ss = 0.f;
#pragma unroll
        for (int j = 0; j < 4; ++j) { v[j] = xr[64 * j]; ss += v[j].x * v[j].x + v[j].y * v[j].y + v[j].z * v[j].z + v[j].w * v[j].w; }
        const float rstd = rsqrtf(wave_sum(ss) * (1.f / D) + EPS);
        float acc[8];
#pragma unroll
        for (int c = 0; c < 8; ++c) acc[c] = 0.f;
#pragma unroll
        for (int j = 0; j < 4; ++j) {
            const f32x4 w = *((const f32x4*)P.norm_mix_w + lane + 64 * j);
            v[j] = v[j] * rstd * w;
            u32x2 o; o.x = pk2(v[j].x, v[j].y); o.y = pk2(v[j].z, v[j].w);
            *((u32x2*)(H + (size_t)row * D) + lane + 64 * j) = o;
#pragma unroll
            for (int i = 0; i < 4; ++i) { const float* sw = slab + (size_t)(4 * lane + 256 * j + i) * 8; const f32x4 w0 = *(const f32x4*)sw, w1 = *(const f32x4*)(sw + 4); const float hv = v[j][i];
                acc[0] += hv * w0.x; acc[1] += hv * w0.y; acc[2] += hv * w0.z; acc[3] += hv * w0.w; acc[4] += hv * w1.x; acc[5] += hv * w1.y; acc[6] += hv * w1.z; acc[7] += hv * w1.w; }
        }
#pragma unroll
        for (int c = 0; c < 8; ++c) acc[c] = wave_sum(acc[c]);
        if (lane == 0) { *(f32x4*)(AB + (size_t)row * 8) = (f32x4){acc[0], acc[1], acc[2], acc[3]}; *(f32x4*)(AB + (size_t)row * 8 + 4) = (f32x4){acc[4], acc[5], acc[6], acc[7]}; }
    }
#if LEVEL >= 2
    constexpr int I_IN = 16 * 88, I_UQ = 6 * 24, I_UKV = 4 * 32, I_OUT = 16 * 32, I_W1 = 16 * 64, I_W2 = 16 * 32;
#if LEVEL >= 4
    constexpr int NIT = I_IN + I_UQ + I_UKV + I_OUT + NE * I_W1 + NE * I_W2;
#else
    constexpr int NIT = I_IN + I_UQ + I_UKV + I_OUT;
#endif
    for (int it = gw; it < NIT; it += ngw) {
        int r = it;
        if (r < I_IN) { transpose_item(P.w_in, D, DIN, (bf16_t*)(ws + WS_WIN), scr, r, 88, lane); continue; } r -= I_IN;
        if (r < I_UQ) { transpose_item(P.w_uq, QL, 768, (bf16_t*)(ws + WS_WUQ), scr, r, 24, lane); continue; } r -= I_UQ;
        if (r < I_UKV) { transpose_item(P.w_ukv, KVL, 1024, (bf16_t*)(ws + WS_WUKV), scr, r, 32, lane); continue; } r -= I_UKV;
        if (r < I_OUT) { transpose_item(P.w_out, D, D, (bf16_t*)(ws + WS_WOUT), scr, r, 32, lane); continue; } r -= I_OUT;
        if (r < NE * I_W1) { const int e = r / I_W1; transpose_item(P.w1 + (size_t)e * D * 2048, D, 2048, (bf16_t*)(ws + WS_W1) + (size_t)e * 2048 * D, scr, r % I_W1, 64, lane); continue; } r -= NE * I_W1;
        { const int e = r / I_W2; transpose_item(P.w2 + (size_t)e * DFF * D, DFF, D, (bf16_t*)(ws + WS_W2) + (size_t)e * D * DFF, scr, r % I_W2, 32, lane); }
    }
#endif
}

__constant__ float c_inv_freq[16] = {1.0f, 0.5623413324356079f, 0.3162277638912201f, 0.17782793939113617f, 0.10000000149011612f, 0.05623413249850273f, 0.03162277489900589f,
    0.017782794311642647f, 0.009999999776482582f, 0.005623413249850273f, 0.003162277629598975f, 0.0017782794311642647f, 0.0010000000474974513f, 0.000562341301701963f,
    0.0003162277571391314f, 0.00017782794020604342f};
__device__ __forceinline__ void phase2a(const Params& P) {
    unsigned char* ws = P.ws;
    const int tid_ = opaque_tid(), lane = tid_ & 63, gw = blockIdx.x * NWAVES + (tid_ >> 6), ngw = gridDim.x * NWAVES;
    const bf16_t* PROJ = (const bf16_t*)(ws + WS_PROJ); bf16_t* CQN = (bf16_t*)(ws + WS_CQN); bf16_t* CKVN = (bf16_t*)(ws + WS_CKVN);
    bf16_t* Kp = (bf16_t*)(ws + WS_K); float* tab = (float*)(ws + WS_TAB);
    for (int row = gw; row < T; row += ngw) {
        const bf16_t* pr = PROJ + (size_t)row * DINP; const int b = row / SEQ, s = row % SEQ;
        {
            unsigned a[3]; float ss = 0.f;
#pragma unroll
            for (int j = 0; j < 3; ++j) { a[j] = *(const unsigned*)(pr + C_CQ + 2 * (lane + 64 * j)); const float lo = bflo(a[j]), hi = bfhi(a[j]); ss += lo * lo + hi * hi; }
            const float rstd = rsqrtf(wave_sum(ss) * (1.f / QL) + EPS);
#pragma unroll
            for (int j = 0; j < 3; ++j) { const int idx = 2 * (lane + 64 * j); *(unsigned*)(CQN + (size_t)row * QL + idx) = pk2(bflo(a[j]) * rstd * P.q_norm_w[idx], bfhi(a[j]) * rstd * P.q_norm_w[idx + 1]); }
        }
        {
            unsigned a[2]; float ss = 0.f;
#pragma unroll
            for (int j = 0; j < 2; ++j) { a[j] = *(const unsigned*)(pr + C_CKV + 2 * (lane + 64 * j)); const float lo = bflo(a[j]), hi = bfhi(a[j]); ss += lo * lo + hi * hi; }
            const float rstd = rsqrtf(wave_sum(ss) * (1.f / KVL) + EPS);
#pragma unroll
            for (int j = 0; j < 2; ++j) { const int idx = 2 * (lane + 64 * j); *(unsigned*)(CKVN + (size_t)row * KVL + idx) = pk2(bflo(a[j]) * rstd * P.kv_norm_w[idx], bfhi(a[j]) * rstd * P.kv_norm_w[idx + 1]); }
        }
        if (lane < 16) {
            const float x1 = bf1(pr[C_KR + lane]), x2 = bf1(pr[C_KR + 16 + lane]);
            const float ang = (float)P.pos[row] * c_inv_freq[lane];
            double tt = (double)ang * 0.15915494309189535; tt -= floor(tt);
            if (tt > 0.5) tt -= 1.0;
            const float ar = (float)(tt * 6.283185307179586);
            const float cs = __cosf(ar), sn = __sinf(ar);
            tab[(size_t)row * 32 + lane] = cs; tab[(size_t)row * 32 + 16 + lane] = sn;
            const bf16_t o1 = (bf16_t)f2bf(x1 * cs - x2 * sn), o2 = (bf16_t)f2bf(x2 * cs + x1 * sn);
#pragma unroll
            for (int h = 0; h < MH; ++h) { bf16_t* kp = Kp + ((size_t)(b * MH + h) * SEQ + s) * DQK + 64; kp[lane] = o1; kp[16 + lane] = o2; }
        }
    }
}

__device__ __forceinline__ float softplusf_(float x) { return fmaxf(x, 0.f) + log1pf(__expf(-fabsf(x))); }
__device__ void gdn_prep_item(const Params& P, unsigned char* smem, int item) {
    unsigned char* ws = P.ws;
    const int tid = opaque_tid(), wave = tid >> 6, lane = tid & 63;
    const int n = item % NCH, hh = (item / NCH) % GH, b = item / (NCH * GH);
    const bf16_t* PROJ = (const bf16_t*)(ws + WS_PROJ); const float* AB = (const float*)(ws + WS_AB);
    unsigned char* gp = ws + WS_GP + (size_t)item * GP_ITEM;
    float* Ug = (float*)(gp + GP_U); bf16_t* Wg = (bf16_t*)(gp + GP_W); bf16_t* QDg = (bf16_t*)(gp + GP_QD); bf16_t* KDTg = (bf16_t*)(gp + GP_KDT); bf16_t* QKg = (bf16_t*)(gp + GP_QK);
    float* qs = (float*)smem; float* ks = qs + 64 * 132; float* vs = ks + 64 * 132; float* Am = vs + 64 * 132;
    float* sbeta = Am + 64 * 68; float* sG = sbeta + 64; float* seG = sG + 64; float* sekd = seG + 64;
    __syncthreads();
    if (tid < 384) {
        const int cp = tid % 192, rg = tid / 192, which = (2 * cp) >> 7, cc = (2 * cp) & 127, gc = which * 512 + hh * 128 + cc;
        float w0[4], w1[4];
#pragma unroll
        for (int j = 0; j < 4; ++j) { w0[j] = P.conv_w[j * 1536 + gc]; w1[j] = P.conv_w[j * 1536 + gc + 1]; }
        float* dst = qs + which * (64 * 132);
        float xa[4] = {0.f, 0.f, 0.f, 0.f}, xb[4] = {0.f, 0.f, 0.f, 0.f};
        for (int rr = -3; rr < 32; ++rr) {
            const int r = 32 * rg + rr, t = 64 * n + r;
            unsigned u = 0u;
            if (t >= 0) u = *(const unsigned*)(PROJ + (size_t)(b * SEQ + t) * DINP + gc);
            xa[0] = xa[1]; xa[1] = xa[2]; xa[2] = xa[3]; xa[3] = bflo(u);
            xb[0] = xb[1]; xb[1] = xb[2]; xb[2] = xb[3]; xb[3] = bfhi(u);
            if (rr >= 0) {
                const float ya = w0[0] * xa[0] + w0[1] * xa[1] + w0[2] * xa[2] + w0[3] * xa[3];
                const float yb = w1[0] * xb[0] + w1[1] * xb[1] + w1[2] * xb[2] + w1[3] * xb[3];
                dst[r * 132 + cc] = ya * sigmoidf_(ya); dst[r * 132 + cc + 1] = yb * sigmoidf_(yb);
            }
        }
    } else if (tid >= 448) {
        const int r = lane; const size_t tok = (size_t)b * SEQ + 64 * n + r;
        const float a = AB[tok * 8 + hh], bb = AB[tok * 8 + 4 + hh];
        const float g = -__expf(P.a_log[hh]) * softplusf_(a + P.dt_bias[hh]);
        float G = g;
#pragma unroll
        for (int o = 1; o < 64; o <<= 1) { const float up = __shfl_up(G, o); if (lane >= o) G += up; }
        const float Gl = __shfl(G, 63);
        sbeta[r] = sigmoidf_(bb); sG[r] = G; seG[r] = __expf(G); sekd[r] = __expf(Gl - G);
        if (lane == 0) ((float*)(ws + WS_GT))[item] = __expf(Gl);
    }
    __syncthreads();
    for (int p = wave; p < 128; p += NWAVES) {
        const int which = p >> 6, r = p & 63; float* row = qs + which * (64 * 132) + r * 132;
        const float a0 = row[2 * lane], a1 = row[2 * lane + 1];
        const float ss = wave_sum(a0 * a0 + a1 * a1);
        const float sc = rsqrtf(ss + EPS) * (which == 0 ? 0.08838834764831845f : 1.f);
        row[2 * lane] = a0 * sc; row[2 * lane + 1] = a1 * sc;
    }
    for (int idx = tid; idx < 6 * 256; idx += NTHREADS) {
        const int u = idx >> 8, w = idx & 255; const int I = (u < 3) ? 0 : (u < 5 ? 1 : 2), J = (u < 3) ? u + 1 : (u < 5 ? u - 1 : 3);
        QKg[(16 * I + (w >> 4)) * 64 + perm32k(16 * J + (w & 15))] = 0;
    }
    __syncthreads();
    for (int job = wave; job < 20; job += NWAVES) {
        const int kind = job / 10, p = job % 10; const int I = (p < 1) ? 0 : (p < 3 ? 1 : (p < 6 ? 2 : 3)); const int J = p - (I * (I + 1)) / 2;
        const float* Ar = (kind ? qs : ks) + (16 * I + (lane & 15)) * 132 + (lane >> 4);
        const float* Br = ks + (16 * J + (lane & 15)) * 132 + (lane >> 4);
        f32x4 acc = {0.f, 0.f, 0.f, 0.f};
#pragma unroll 8
        for (int s = 0; s < 32; ++s) acc = __builtin_amdgcn_mfma_f32_16x16x4f32(Ar[4 * s], Br[4 * s], acc, 0, 0, 0);
        const int j = 16 * J + (lane & 15);
#pragma unroll
        for (int r = 0; r < 4; ++r) { const int i = 16 * I + 4 * (lane >> 4) + r;
            const float dec = (i >= j) ? __expf(sG[i] - sG[j]) : 0.f;
            if (kind == 0) Am[i * 68 + j] = (i > j) ? sbeta[i] * acc[r] * dec : 0.f;
            else QKg[i * 64 + perm32k(j)] = (bf16_t)f2bf((i >= j) ? acc[r] * dec : 0.f); }
    }
    __syncthreads();
    if (tid < 256) {
        const int c = tid; float X[64];
        const LAS float* AmL = (const LAS float*)Am; asm volatile("" : "+v"(AmL));
        const LAS float* scL = (const LAS float*)sbeta; asm volatile("" : "+v"(scL));
        const LAS float* rhsL = (c < 128) ? ((const LAS float*)vs + c) : ((const LAS float*)ks + (c - 128));
        const bool isw = (c >= 128);
#pragma unroll
        for (int i = 0; i < 64; ++i) {
            const float eg = isw ? scL[128 + i] : 1.f;
            float a0 = scL[i] * rhsL[i * 132] * eg, a1 = 0.f, a2 = 0.f, a3 = 0.f;
#pragma unroll
            for (int jb = 0; jb < (i + 3) / 4; ++jb) { const f32x4 av = *(const LAS f32x4*)(AmL + i * 68 + 4 * jb);
                if (4 * jb + 0 < i) a0 -= av.x * X[4 * jb + 0];
                if (4 * jb + 1 < i) a1 -= av.y * X[4 * jb + 1];
                if (4 * jb + 2 < i) a2 -= av.z * X[4 * jb + 2];
                if (4 * jb + 3 < i) a3 -= av.w * X[4 * jb + 3];
                if ((jb & 3) == 3) __builtin_amdgcn_sched_barrier(0); }
            X[i] = (a0 + a1) + (a2 + a3);
            asm volatile("" : "+v"(X[i]));
            __builtin_amdgcn_sched_barrier(0);
        }
        if (c < 128) {
#pragma unroll
            for (int i = 0; i < 64; ++i) Ug[i * 128 + c] = X[i];
        } else { const int pd = perm32k(c - 128);
#pragma unroll
            for (int i = 0; i < 64; ++i) Wg[i * 128 + pd] = (bf16_t)f2bf(-X[i]);
        }
    } else {
        const int t2 = tid - 256;
        for (int idx = t2; idx < 64 * 128; idx += 256) { const int i = idx >> 7, d = idx & 127; QDg[i * 128 + perm32k(d)] = (bf16_t)f2bf(qs[i * 132 + d] * seG[i]); }
        for (int idx = t2; idx < 128 * 64; idx += 256) { const int d = idx >> 6, cc = idx & 63; KDTg[d * 64 + perm32k(cc)] = (bf16_t)f2bf(ks[cc * 132 + d] * sekd[cc]); }
    }
}

__device__ void gdn_scan(const Params& P, unsigned char* smem, int bh) {
    unsigned char* ws = P.ws;
    const int tid = opaque_tid(), wave = tid >> 6, lane = tid & 63, e = lane & 15, g = lane >> 4, e0 = 16 * wave;
    const int b = bh / GH, hh = bh % GH;
    float* OA = (float*)(ws + WS_OA); const float* GT = (const float*)(ws + WS_GT);
    constexpr int BUF = 64512, OW = 0, OQD = 18432, OQK = 36864, OKD = 46080;
    f32x4 S[8];
#pragma unroll
    for (int t = 0; t < 8; ++t) S[t] = (f32x4){0.f, 0.f, 0.f, 0.f};
    u32x4 st[7];
    auto gload = [&](int n) {
        const unsigned char* gp = ws + WS_GP + (size_t)(bh * NCH + n) * GP_ITEM;
#pragma unroll
        for (int k = 0; k < 2; ++k) st[k] = *(const u32x4*)(gp + GP_W + (size_t)(tid + 512 * k) * 16);
#pragma unroll
        for (int k = 0; k < 2; ++k) st[2 + k] = *(const u32x4*)(gp + GP_QD + (size_t)(tid + 512 * k) * 16);
        st[4] = *(const u32x4*)(gp + GP_QK + (size_t)tid * 16);
#pragma unroll
        for (int k = 0; k < 2; ++k) st[5 + k] = *(const u32x4*)(gp + GP_KDT + (size_t)(tid + 512 * k) * 16);
    };
    auto lwrite = [&](int buf) {
        unsigned char* L = smem + buf * BUF;
#pragma unroll
        for (int k = 0; k < 2; ++k) { const int c = tid + 512 * k; *(u32x4*)(L + OW + (c >> 4) * 288 + (c & 15) * 16) = st[k]; }
#pragma unroll
        for (int k = 0; k < 2; ++k) { const int c = tid + 512 * k; *(u32x4*)(L + OQD + (c >> 4) * 288 + (c & 15) * 16) = st[2 + k]; }
        { const int c = tid; *(u32x4*)(L + OQK + (c >> 3) * 144 + (c & 7) * 16) = st[4]; }
#pragma unroll
        for (int k = 0; k < 2; ++k) { const int c = tid + 512 * k; *(u32x4*)(L + OKD + (c >> 3) * 144 + (c & 7) * 16) = st[5 + k]; }
    };
    f32x4 un[4]; float gtn;
    auto uload = [&](int n) {
        const float* Ug = (const float*)(ws + WS_GP + (size_t)(bh * NCH + n) * GP_ITEM + GP_U);
#pragma unroll
        for (int m = 0; m < 4; ++m)
#pragma unroll
            for (int r = 0; r < 4; ++r) un[m][r] = Ug[(16 * m + 4 * g + r) * 128 + e0 + e];
        gtn = GT[bh * NCH + n];
    };
    __syncthreads();
    gload(0); lwrite(0); uload(0);
    __syncthreads();
    for (int n = 0; n < NCH; ++n) {
        f32x4 av[4], ao[4];
#pragma unroll
        for (int m = 0; m < 4; ++m) { av[m] = un[m]; ao[m] = (f32x4){0.f, 0.f, 0.f, 0.f}; }
        const float gt = gtn;
        if (n + 1 < NCH) { gload(n + 1); uload(n + 1); }
        const unsigned char* L = smem + (n & 1) * BUF;
        bf16x8 Sb[4];
#pragma unroll
        for (int s = 0; s < 4; ++s) Sb[s] = pack8(S[2 * s], S[2 * s + 1]);
#pragma unroll
        for (int m = 0; m < 4; ++m)
#pragma unroll
            for (int s = 0; s < 4; ++s) {
                const bf16x8 wf = *(const bf16x8*)(L + OW + (16 * m + e) * 288 + (32 * s + 8 * g) * 2);
                const bf16x8 qf = *(const bf16x8*)(L + OQD + (16 * m + e) * 288 + (32 * s + 8 * g) * 2);
                av[m] = __builtin_amdgcn_mfma_f32_16x16x32_bf16(wf, Sb[s], av[m], 0, 0, 0);
                ao[m] = __builtin_amdgcn_mfma_f32_16x16x32_bf16(qf, Sb[s], ao[m], 0, 0, 0);
            }
        bf16x8 Vb[2];
#pragma unroll
        for (int s = 0; s < 2; ++s) Vb[s] = pack8(av[2 * s], av[2 * s + 1]);
#pragma unroll
        for (int m = 0; m < 4; ++m)
#pragma unroll
            for (int s = 0; s < 2; ++s) {
                const bf16x8 kf = *(const bf16x8*)(L + OQK + (16 * m + e) * 144 + (32 * s + 8 * g) * 2);
                ao[m] = __builtin_amdgcn_mfma_f32_16x16x32_bf16(kf, Vb[s], ao[m], 0, 0, 0);
            }
#pragma unroll
        for (int t = 0; t < 8; ++t) { S[t] = S[t] * gt;
#pragma unroll
            for (int s = 0; s < 2; ++s) {
                const bf16x8 df = *(const bf16x8*)(L + OKD + (16 * t + e) * 144 + (32 * s + 8 * g) * 2);
                S[t] = __builtin_amdgcn_mfma_f32_16x16x32_bf16(df, Vb[s], S[t], 0, 0, 0);
            } }
#pragma unroll
        for (int m = 0; m < 4; ++m)
#pragma unroll
            for (int r = 0; r < 4; ++r) OA[((size_t)b * SEQ + 64 * n + 16 * m + 4 * g + r) * 512 + hh * 128 + e0 + e] = ao[m][r];
        if (n + 1 < NCH) lwrite((n + 1) & 1);
        __syncthreads();
    }
}

__device__ void attn_item(const Params& P, unsigned char* smem, int item) {
    unsigned char* ws = P.ws;
    const int tid = opaque_tid(), wave = tid >> 6, lane = tid & 63, ql = lane & 31, hf = lane >> 5;
    const int qt = 15 - (item >> 5), bh = item & 31;
    const bf16_t* Qg = (const bf16_t*)(ws + WS_Q) + (size_t)bh * SEQ * DQK;
    const unsigned char* Kg = (const unsigned char*)((const bf16_t*)(ws + WS_K) + (size_t)bh * SEQ * DQK);
    const bf16_t* VTg = (const bf16_t*)(ws + WS_VT) + (size_t)bh * 64 * SEQ;
    bf16_t* OB = (bf16_t*)(ws + WS_OB);
    const int q0 = qt * 256 + 32 * wave;
    const int nkt_w = (q0 >> 6) + 1, nkt_b = 4 * qt + 4;
    constexpr int KB_ = 13312, VB_ = 9216, OK0 = 0, OV0 = 2 * KB_;
    bf16x8 qf[6];
#pragma unroll
    for (int ks = 0; ks < 6; ++ks) qf[ks] = *(const bf16x8*)(Qg + (size_t)(q0 + ql) * DQK + 16 * ks + 8 * hf);
    f32x16 o0, o1;
#pragma unroll
    for (int i = 0; i < 16; ++i) { o0[i] = 0.f; o1[i] = 0.f; }
    float mrun = -1e30f, lsum = 0.f;
    u32x4 sk0, sk1, sv;
    auto gload = [&](int kt) {
        const unsigned char* kp = Kg + (size_t)kt * 64 * DQK * 2;
        sk0 = *(const u32x4*)(kp + (size_t)tid * 16);
        if (tid < 256) sk1 = *(const u32x4*)(kp + (size_t)(tid + 512) * 16);
        sv = *(const u32x4*)(VTg + (size_t)(tid >> 3) * SEQ + kt * 64 + (tid & 7) * 8);
    };
    auto lwrite = [&](int buf) {
        { const int c = tid; *(u32x4*)(smem + OK0 + buf * KB_ + (c / 12) * 208 + (c % 12) * 16) = sk0; }
        if (tid < 256) { const int c = tid + 512; *(u32x4*)(smem + OK0 + buf * KB_ + (c / 12) * 208 + (c % 12) * 16) = sk1; }
        *(u32x4*)(smem + OV0 + buf * VB_ + (tid >> 3) * 144 + (tid & 7) * 16) = sv;
    };
    __syncthreads();
    gload(0); lwrite(0);
    __syncthreads();
    for (int kt = 0; kt < nkt_b; ++kt) {
        if (kt + 1 < nkt_b) gload(kt + 1);
        if (kt < nkt_w) {
            const unsigned char* Kl = smem + OK0 + (kt & 1) * KB_; const unsigned char* Vl = smem + OV0 + (kt & 1) * VB_;
            f32x16 s0, s1;
#pragma unroll
            for (int i = 0; i < 16; ++i) { s0[i] = 0.f; s1[i] = 0.f; }
#pragma unroll
            for (int ks = 0; ks < 6; ++ks) {
                const bf16x8 k0 = *(const bf16x8*)(Kl + ql * 208 + (16 * ks + 8 * hf) * 2);
                const bf16x8 k1 = *(const bf16x8*)(Kl + (32 + ql) * 208 + (16 * ks + 8 * hf) * 2);
                s0 = __builtin_amdgcn_mfma_f32_32x32x16_bf16(k0, qf[ks], s0, 0, 0, 0);
                s1 = __builtin_amdgcn_mfma_f32_32x32x16_bf16(k1, qf[ks], s1, 0, 0, 0);
            }
            float mx = s0[0];
#pragma unroll
            for (int i = 1; i < 16; ++i) mx = fmaxf(mx, s0[i]);
#pragma unroll
            for (int i = 0; i < 16; ++i) mx = fmaxf(mx, s1[i]);
            mx = fmaxf(mx, __shfl_xor(mx, 32));
            const float mnew = fmaxf(mrun, mx), alpha = __builtin_amdgcn_exp2f(mrun - mnew);
            mrun = mnew;
            float ps = 0.f;
#pragma unroll
            for (int i = 0; i < 16; ++i) { s0[i] = __builtin_amdgcn_exp2f(s0[i] - mnew); s1[i] = __builtin_amdgcn_exp2f(s1[i] - mnew); ps += s0[i] + s1[i]; }
            lsum = lsum * alpha + ps;
#pragma unroll
            for (int i = 0; i < 16; ++i) { o0[i] *= alpha; o1[i] *= alpha; }
            bf16x8 pb[2][2];
#pragma unroll
            for (int sp = 0; sp < 2; ++sp) {
                pb[0][sp] = pack8((f32x4){s0[8 * sp], s0[8 * sp + 1], s0[8 * sp + 2], s0[8 * sp + 3]}, (f32x4){s0[8 * sp + 4], s0[8 * sp + 5], s0[8 * sp + 6], s0[8 * sp + 7]});
                pb[1][sp] = pack8((f32x4){s1[8 * sp], s1[8 * sp + 1], s1[8 * sp + 2], s1[8 * sp + 3]}, (f32x4){s1[8 * sp + 4], s1[8 * sp + 5], s1[8 * sp + 6], s1[8 * sp + 7]});
            }
#pragma unroll
            for (int u = 0; u < 2; ++u)
#pragma unroll
                for (int sp = 0; sp < 2; ++sp) {
                    const bf16x8 v0 = *(const bf16x8*)(Vl + ql * 144 + (32 * u + 16 * sp + 8 * hf) * 2);
                    const bf16x8 v1 = *(const bf16x8*)(Vl + (32 + ql) * 144 + (32 * u + 16 * sp + 8 * hf) * 2);
                    o0 = __builtin_amdgcn_mfma_f32_32x32x16_bf16(v0, pb[u][sp], o0, 0, 0, 0);
                    o1 = __builtin_amdgcn_mfma_f32_32x32x16_bf16(v1, pb[u][sp], o1, 0, 0, 0);
                }
        }
        if (kt + 1 < nkt_b) lwrite((kt + 1) & 1);
        __syncthreads();
    }
    lsum += __shfl_xor(lsum, 32);
    const float inv = 1.f / lsum;
    const int b = bh >> 3, h = bh & 7;
    bf16_t* orow = OB + ((size_t)b * SEQ + q0 + ql) * 512 + h * 64;
#pragma unroll
    for (int r = 0; r < 16; ++r) { const int dv = (r & 3) + 8 * (r >> 2) + 4 * hf; orow[dv] = (bf16_t)f2bf(o0[r] * inv); orow[32 + dv] = (bf16_t)f2bf(o1[r] * inv); }
}

__device__ __forceinline__ void phase5(const Params& P) {
    unsigned char* ws = P.ws;
    const int tid_ = opaque_tid(), lane = tid_ & 63, gw = blockIdx.x * NWAVES + (tid_ >> 6), ngw = gridDim.x * NWAVES;
    const float* OA = (const float*)(ws + WS_OA); const bf16_t* OB = (const bf16_t*)(ws + WS_OB); const bf16_t* PROJ = (const bf16_t*)(ws + WS_PROJ); bf16_t* OCAT = (bf16_t*)(ws + WS_OCAT);
    for (int row = gw; row < T; row += ngw) {
#if LEVEL >= 3
#pragma unroll
        for (int h = 0; h < GH; ++h) {
            const float a0 = OA[(size_t)row * 512 + h * 128 + 2 * lane], a1 = OA[(size_t)row * 512 + h * 128 + 2 * lane + 1];
            const float rstd = rsqrtf(wave_sum(a0 * a0 + a1 * a1) * (1.f / 128.f) + EPS);
            const unsigned zu = *(const unsigned*)(PROJ + (size_t)row * DINP + C_Z + h * 128 + 2 * lane); const float z0 = bflo(zu), z1 = bfhi(zu);
            *(unsigned*)(OCAT + (size_t)row * D + h * 128 + 2 * lane) = pk2(a0 * rstd * P.gdn_norm_w[2 * lane] * z0 * sigmoidf_(z0), a1 * rstd * P.gdn_norm_w[2 * lane + 1] * z1 * sigmoidf_(z1));
        }
#else
#pragma unroll
        for (int h = 0; h < GH; ++h) *(unsigned*)(OCAT + (size_t)row * D + h * 128 + 2 * lane) = 0u;
#endif
        const u32x4 v = *((const u32x4*)(OB + (size_t)row * 512) + lane);
        float f[8] = {bflo(v.x), bfhi(v.x), bflo(v.y), bfhi(v.y), bflo(v.z), bfhi(v.z), bflo(v.w), bfhi(v.w)};
        float ss = 0.f;
#pragma unroll
        for (int i = 0; i < 8; ++i) ss += f[i] * f[i];
        const float rstd = rsqrtf(wave_sum(ss) * (1.f / 512.f) + EPS);
        const float* w = P.mla_out_norm_w + 8 * lane;
        u32x4 o; o.x = pk2(f[0] * rstd * w[0], f[1] * rstd * w[1]); o.y = pk2(f[2] * rstd * w[2], f[3] * rstd * w[3]); o.z = pk2(f[4] * rstd * w[4], f[5] * rstd * w[5]); o.w = pk2(f[6] * rstd * w[6], f[7] * rstd * w[7]);
        *((u32x4*)(OCAT + (size_t)row * D + 512) + lane) = o;
    }
}

__device__ void phase7(const Params& P, unsigned char* smem) {
    unsigned char* ws = P.ws;
    const int tid = opaque_tid(), wave = tid >> 6, lane = tid & 63;
    float* rw = (float*)smem;
    int* lctl = (int*)(smem + LDS_MISC + 256);
    for (int i = tid; i < 1024 * 8; i += NTHREADS) { const int k = i >> 3, c = i & 7; *(f32x4*)(rw + k * 32 + 4 * (c ^ (k & 7))) = *(const f32x4*)(P.router_w + (size_t)k * 32 + 4 * c); }
    const float* X1 = (const float*)(ws + WS_X1); bf16_t* H2 = (bf16_t*)(ws + WS_H);
    int* tok_e = (int*)(ws + WS_TOKE); int* tok_r = (int*)(ws + WS_TOKR); float* gate = (float*)(ws + WS_GATE); int* list = (int*)(ws + WS_LIST);
    unsigned* cnt = (unsigned*)(ws + WS_CTL) + CW_CNT;
    for (int tg = blockIdx.x; tg < T / 64; tg += gridDim.x) {
    __syncthreads();
    if (tid < 64) lctl[tid] = 0;
    __syncthreads();
    const int tok0 = tg * 64 + wave * 8;
    for (int ti = 0; ti < 8; ++ti) {
        const int row = tok0 + ti;
        float hv[16]; float ss = 0.f;
#pragma unroll
        for (int i = 0; i < 16; ++i) { hv[i] = X1[(size_t)row * D + lane + 64 * i]; ss += hv[i] * hv[i]; }
        const float rstd = rsqrtf(wave_sum(ss) * (1.f / D) + EPS);
        float lg[32];
#pragma unroll
        for (int j = 0; j < 32; ++j) lg[j] = 0.f;
#pragma unroll
        for (int i = 0; i < 16; ++i) { const int k = lane + 64 * i; hv[i] = hv[i] * rstd * P.norm_ffn_w[k];
            H2[(size_t)row * D + k] = (bf16_t)f2bf(hv[i]);
#pragma unroll
            for (int c = 0; c < 8; ++c) { const f32x4 w = *(const f32x4*)(rw + k * 32 + 4 * (c ^ (k & 7)));
                lg[4 * c] += hv[i] * w.x; lg[4 * c + 1] += hv[i] * w.y; lg[4 * c + 2] += hv[i] * w.z; lg[4 * c + 3] += hv[i] * w.w; } }
#pragma unroll
        for (int j = 0; j < 32; ++j) lg[j] = wave_sum(lg[j]) + P.router_b[j];
        int ei[4]; float ev[4];
#pragma unroll
        for (int k = 0; k < 4; ++k) { float best = -3.0e38f; int bi = 0;
#pragma unroll
            for (int j = 0; j < 32; ++j) { const bool taken = (k > 0 && ei[0] == j) || (k > 1 && ei[1] == j) || (k > 2 && ei[2] == j); if (!taken && lg[j] > best) { best = lg[j]; bi = j; } }
            ei[k] = bi; ev[k] = best; }
        float gs = 0.f, gv[4];
#pragma unroll
        for (int k = 0; k < 4; ++k) { gv[k] = __expf(ev[k] - ev[0]); gs += gv[k]; }
        if (lane < 4) {
            const int e = ei[lane == 0 ? 0 : (lane == 1 ? 1 : (lane == 2 ? 2 : 3))]; const float gg = gv[lane == 0 ? 0 : (lane == 1 ? 1 : (lane == 2 ? 2 : 3))] / gs;
            const int lr = atomicAdd(&lctl[e], 1);
            lctl[64 + ((wave * 8 + ti) * 4 + lane) * 2] = e; lctl[64 + ((wave * 8 + ti) * 4 + lane) * 2 + 1] = lr;
            gate[(size_t)row * 4 + lane] = gg;
        }
    }
    __syncthreads();
    if (tid < 32) lctl[32 + tid] = (int)atomicAdd(&cnt[tid], (unsigned)lctl[tid]);
    __syncthreads();
    if (tid < 256) { const int e = lctl[64 + tid * 2], lr = lctl[64 + tid * 2 + 1]; const int row = tg * 64 + (tid >> 2); const int rank = lctl[32 + e] + lr;
        tok_e[(size_t)row * 4 + (tid & 3)] = e; tok_r[(size_t)row * 4 + (tid & 3)] = rank; list[e * T + rank] = row; }
    }
}

__device__ __forceinline__ void moe_tiles(const Params& P, unsigned char* smem) {
    int* tstart = (int*)(smem + LDS_MISC + 256); int* cntl = tstart + 64;
    const unsigned* cnt = (const unsigned*)(P.ws + WS_CTL) + CW_CNT;
    __syncthreads();
    if (threadIdx.x == 0) { int acc = 0; for (int e = 0; e < NE; ++e) { const int c = (int)__hip_atomic_load(&cnt[e], __ATOMIC_RELAXED, __HIP_MEMORY_SCOPE_AGENT); cntl[e] = c; tstart[e] = acc; acc += (c + 255) >> 8; } tstart[NE] = acc; }
    __syncthreads();
}

__device__ __forceinline__ void phase11(const Params& P, unsigned char* smem) {
    unsigned char* ws = P.ws;
    const int tid_ = opaque_tid(), lane = tid_ & 63, gw = blockIdx.x * NWAVES + (tid_ >> 6), ngw = gridDim.x * NWAVES;
#if LEVEL >= 2
    const float* X1 = (const float*)(ws + WS_X1);
#else
    const float* X1 = P.x;
#endif
#if LEVEL >= 4
    const int* tstart = (const int*)(smem + LDS_MISC + 256);
    const int* tok_e = (const int*)(ws + WS_TOKE); const int* tok_r = (const int*)(ws + WS_TOKR); const float* gate = (const float*)(ws + WS_GATE); const bf16_t* Y = (const bf16_t*)(ws + WS_Y);
#endif
    for (int row = gw; row < T; row += ngw) {
        f32x4 v[4];
#pragma unroll
        for (int j = 0; j < 4; ++j) v[j] = *((const f32x4*)(X1 + (size_t)row * D) + lane + 64 * j);
#if LEVEL >= 4
#pragma unroll
        for (int k = 0; k < 4; ++k) { const int e = tok_e[(size_t)row * 4 + k], rk = tok_r[(size_t)row * 4 + k]; const float gg = gate[(size_t)row * 4 + k];
            const bf16_t* yr = Y + (size_t)(tstart[e] * 256 + rk) * D;
#pragma unroll
            for (int j = 0; j < 4; ++j) { const u32x2 yy = *((const u32x2*)yr + lane + 64 * j); v[j].x += gg * bflo(yy.x); v[j].y += gg * bfhi(yy.x); v[j].z += gg * bflo(yy.y); v[j].w += gg * bfhi(yy.y); } }
#endif
        float ss = 0.f;
#pragma unroll
        for (int j = 0; j < 4; ++j) ss += v[j].x * v[j].x + v[j].y * v[j].y + v[j].z * v[j].z + v[j].w * v[j].w;
        const float rstd = rsqrtf(wave_sum(ss) * (1.f / D) + EPS);
#pragma unroll
        for (int j = 0; j < 4; ++j) *((f32x4*)(P.out + (size_t)row * D) + lane + 64 * j) = v[j] * rstd * *((const f32x4*)P.norm_final_w + lane + 64 * j);
    }
}

extern "C" __global__ void __launch_bounds__(NTHREADS) fwd_megakernel(Params P) {
    extern __shared__ __attribute__((aligned(16))) unsigned char smem[];
    LAS unsigned char* lds = (LAS unsigned char*)smem;
    unsigned char* ws = P.ws;
    const int tid = threadIdx.x;
    const int G = gridDim.x, bid = blockIdx.x;
    volatile LAS unsigned* misc = (volatile LAS unsigned*)(lds + LDS_MISC);
    if (tid < 64) misc[tid] = 0u;
    __syncthreads();
    XcdBarrier bar = xcd_barrier_post((unsigned*)(ws + WS_CTL) + CW_BAR, misc);
#define GRID_BAR() xcd_barrier(bar)

    phase0(P, smem);
    GRID_BAR();
#if LEVEL >= 2
    {
        pg8::DenseOrder S{(const char*)(ws + WS_H), (const char*)(ws + WS_WIN), T / 256, DINP / 256, D, G, bid};
        EpiProj E{(bf16_t*)(ws + WS_PROJ)};
        pg8::gemm_phase<EpiProj, pg8::DenseOrder>(lds, D, S, E);
    }
    GRID_BAR();
    phase2a(P);
#if LEVEL >= 3
    for (int item = bid; item < NB * GH * NCH; item += G) gdn_prep_item(P, smem, item);
#endif
    GRID_BAR();
    {
        pg8::DenseOrder S{(const char*)(ws + WS_CQN), (const char*)(ws + WS_WUQ), T / 256, 768 / 256, QL, G, bid};
        EpiQ E{(bf16_t*)(ws + WS_Q), (const float*)(ws + WS_TAB)};
        pg8::gemm_phase<EpiQ, pg8::DenseOrder>(lds, QL, S, E);
        pg8::DenseOrder S2{(const char*)(ws + WS_CKVN), (const char*)(ws + WS_WUKV), T / 256, 1024 / 256, KVL, G, (bid + 64) % G};
        EpiKV E2{(bf16_t*)(ws + WS_K), (bf16_t*)(ws + WS_VT)};
        pg8::gemm_phase<EpiKV, pg8::DenseOrder>(lds, KVL, S2, E2);
    }
    GRID_BAR();
    {
#if LEVEL >= 3
        if (bid < NB * GH) gdn_scan(P, smem, bid);
#endif
        unsigned* aq = (unsigned*)(ws + WS_CTL) + CW_AQ;
        for (;;) {
            __syncthreads();
            if (tid == 0) misc[8] = atomicAdd(aq, 1u);
            __syncthreads();
            const int item = (int)misc[8];
            if (item >= 512) break;
            attn_item(P, smem, item);
        }
    }
    GRID_BAR();
    phase5(P);
    GRID_BAR();
    {
        pg8::DenseOrder S{(const char*)(ws + WS_OCAT), (const char*)(ws + WS_WOUT), T / 256, D / 256, D, G, bid};
        EpiX1 E{P.x, (float*)(ws + WS_X1)};
        pg8::gemm_phase<EpiX1, pg8::DenseOrder>(lds, D, S, E);
    }
    GRID_BAR();
#endif
#if LEVEL >= 4
    phase7(P, smem);
    GRID_BAR();
    moe_tiles(P, smem);
    {
        const LAS int* ts = (const LAS int*)(lds + LDS_MISC + 256);
        MoeOrder1 S{(const char*)(ws + WS_H), (const char*)(ws + WS_W1), (const int*)(ws + WS_LIST), ts, ts + 64, G, bid};
        EpiAct E{(bf16_t*)(ws + WS_ACT), P.b1};
        pg8::gemm_phase<EpiAct, MoeOrder1>(lds, D, S, E);
    }
    GRID_BAR();
    {
        const LAS int* ts = (const LAS int*)(lds + LDS_MISC + 256);
        MoeOrder2 S{(const char*)(ws + WS_ACT), (const char*)(ws + WS_W2), ts, G, bid};
        EpiY E{(bf16_t*)(ws + WS_Y), P.b2};
        pg8::gemm_phase<EpiY, MoeOrder2>(lds, DFF, S, E);
    }
    GRID_BAR();
#endif
    phase11(P, smem);
}

extern "C" void kernel_launch(void* const* d_in, const int* in_sizes, int n_in, void* d_out, int out_size, void* d_ws, size_t ws_size, hipStream_t stream) {
    static int grid = 0;
    if (grid == 0) {
        if (n_in != 22 || in_sizes[0] != T * D || out_size != T * D || ws_size < WS_END) {
            fprintf(stderr, "kernel_launch: unexpected shapes (n_in %d, in0 %d, out %d, ws %zu < %zu)\n", n_in, n_in > 0 ? in_sizes[0] : -1, out_size, ws_size, (size_t)WS_END); grid = -1; return; }
        int dev = 0, cus = 0, per_cu = 0;
        if (hipGetDevice(&dev) != hipSuccess || hipDeviceGetAttribute(&cus, hipDeviceAttributeMultiprocessorCount, dev) != hipSuccess) { grid = -1; return; }
        if (hipFuncSetAttribute((const void*)fwd_megakernel, hipFuncAttributeMaxDynamicSharedMemorySize, LDS_BYTES) != hipSuccess) { fprintf(stderr, "kernel_launch: hipFuncSetAttribute failed\n"); grid = -1; return; }
        if (hipOccupancyMaxActiveBlocksPerMultiprocessor(&per_cu, (const void*)fwd_megakernel, NTHREADS, LDS_BYTES) != hipSuccess || per_cu < 1) { fprintf(stderr, "kernel_launch: occupancy query says %d\n", per_cu); (void)hipGetLastError(); grid = -1; return; }
        grid = cus;
        if (grid != 256) fprintf(stderr, "kernel_launch: note: %d CUs\n", grid);
    }
    if (grid < 0) return;
    (void)hipMemsetAsync((char*)d_ws + WS_CTL, 0, CTL_BYTES, stream);
    Params p{};
    p.x = (const float*)d_in[0]; p.pos = (const int*)d_in[1]; p.norm_mix_w = (const float*)d_in[2]; p.w_in = (const float*)d_in[3]; p.conv_w = (const float*)d_in[4];
    p.a_log = (const float*)d_in[5]; p.dt_bias = (const float*)d_in[6]; p.gdn_norm_w = (const float*)d_in[7]; p.q_norm_w = (const float*)d_in[8]; p.w_uq = (const float*)d_in[9];
    p.kv_norm_w = (const float*)d_in[10]; p.w_ukv = (const float*)d_in[11]; p.mla_out_norm_w = (const float*)d_in[12]; p.w_out = (const float*)d_in[13]; p.norm_ffn_w = (const float*)d_in[14];
    p.router_w = (const float*)d_in[15]; p.router_b = (const float*)d_in[16]; p.w1 = (const float*)d_in[17]; p.b1 = (const float*)d_in[18]; p.w2 = (const float*)d_in[19];
    p.b2 = (const float*)d_in[20]; p.norm_final_w = (const float*)d_in[21]; p.out = (float*)d_out; p.ws = (unsigned char*)d_ws;
    void* args[] = {&p};
    hipError_t e = hipLaunchCooperativeKernel((const void*)fwd_megakernel, dim3(grid), dim3(NTHREADS), args, LDS_BYTES, stream);
    if (e != hipSuccess) fprintf(stderr, "kernel_launch: cooperative launch failed: %s (grid %d)\n", hipGetErrorString(e), grid);
}
```

```cpp
#include <hip/hip_runtime.h>
#include <cstdio>
#include <cstdint>

#ifndef LEVEL
#define LEVEL 4
#endif

#ifndef DUP
#define DUP -1
#endif
#define REP(k) for (int rep_ = 0; rep_ < ((DUP == (k)) ? 2 : 1); ++rep_)
#define LAS __attribute__((address_space(3)))
typedef unsigned short bf16_t;
typedef short bf16x8 __attribute__((ext_vector_type(8)));
typedef float f32x4 __attribute__((ext_vector_type(4)));
typedef float f32x16 __attribute__((ext_vector_type(16)));
typedef unsigned u32x4 __attribute__((ext_vector_type(4)));
typedef unsigned u32x2 __attribute__((ext_vector_type(2)));

constexpr int NB = 4, SEQ = 4096, T = NB * SEQ, D = 1024, DIN = 2728, DINP = 2816;
constexpr int GH = 4, NCH = SEQ / 64;
constexpr int MH = 8, DQK = 96, QL = 384, KVL = 256;
constexpr int NE = 32, DFF = 1024;
constexpr int C_Z = 1536, C_CQ = 2056, C_CKV = 2440, C_KR = 2696;
constexpr float EPS = 1e-6f;
constexpr int NTHREADS = 512, NWAVES = 8;
constexpr int LDS_BYTES = 147456;
constexpr int LDS_MISC = 131072;
constexpr int MOE_MAXROWS = 73728;

constexpr size_t MiB = 1u << 20;
constexpr size_t WS_CTL = 0, CTL_BYTES = 65536;
constexpr size_t WS_WIN = 1 * MiB, WS_WUQ = 7 * MiB, WS_WUKV = 8 * MiB, WS_WOUT = 9 * MiB, WS_W1 = 11 * MiB, WS_W2 = 139 * MiB;
constexpr size_t WS_X1 = 203 * MiB, WS_H = 267 * MiB, WS_AB = 299 * MiB, WS_TAB = 300 * MiB;
constexpr size_t WS_TOKE = 302 * MiB, WS_TOKR = WS_TOKE + 256 * 1024, WS_GATE = WS_TOKR + 256 * 1024, WS_LIST = 303 * MiB;
constexpr size_t WS_R = 306 * MiB;
constexpr size_t WS_PROJ = WS_R, WS_CQN = WS_R + 88 * MiB, WS_CKVN = WS_R + 100 * MiB, WS_Q = WS_R + 108 * MiB, WS_K = WS_R + 132 * MiB, WS_VT = WS_R + 156 * MiB;
constexpr size_t WS_GP = WS_R + 172 * MiB;
constexpr size_t GP_ITEM = 90112, GP_U = 0, GP_W = 32768, GP_QD = 49152, GP_KDT = 65536, GP_QK = 81920;
constexpr size_t WS_GT = WS_R + 260 * MiB, WS_OA = WS_R + 261 * MiB, WS_OB = WS_R + 293 * MiB, WS_OCAT = WS_R + 309 * MiB;
constexpr size_t WS_ACT = WS_R, WS_Y = WS_R + 144 * MiB;
constexpr size_t WS_END = WS_R + 341 * MiB;
constexpr int CW_BAR = 4096, CW_CNT = 8192  , CW_AQ = 8320  ;

struct Params {
    const float* x; const int* pos; const float* norm_mix_w; const float* w_in; const float* conv_w; const float* a_log; const float* dt_bias;
    const float* gdn_norm_w; const float* q_norm_w; const float* w_uq; const float* kv_norm_w; const float* w_ukv; const float* mla_out_norm_w;
    const float* w_out; const float* norm_ffn_w; const float* router_w; const float* router_b; const float* w1; const float* b1; const float* w2;
    const float* b2; const float* norm_final_w; float* out; unsigned char* ws;
};

__device__ __forceinline__ unsigned f2bf(float f) { unsigned u = __builtin_bit_cast(unsigned, f); return (u + 0x7fffu + ((u >> 16) & 1u)) >> 16; }
__device__ __forceinline__ unsigned pk2(float lo, float hi) { return f2bf(lo) | (f2bf(hi) << 16); }
__device__ __forceinline__ float bflo(unsigned u) { return __builtin_bit_cast(float, u << 16); }
__device__ __forceinline__ float bfhi(unsigned u) { return __builtin_bit_cast(float, u & 0xffff0000u); }
__device__ __forceinline__ float bf1(bf16_t b) { return __builtin_bit_cast(float, (unsigned)b << 16); }
__device__ __forceinline__ float wave_sum(float v) {
#pragma unroll
    for (int o = 1; o < 64; o <<= 1) v += __shfl_xor(v, o);
    return v;
}
__device__ __forceinline__ int opaque_tid() { int t = threadIdx.x; asm volatile("" : "+v"(t)); return t; }
__device__ __forceinline__ float sigmoidf_(float x) { return 1.f / (1.f + __expf(-x)); }
__device__ __forceinline__ bf16x8 pack8(f32x4 a, f32x4 b) {
    u32x4 r; r.x = pk2(a.x, a.y); r.y = pk2(a.z, a.w); r.z = pk2(b.x, b.y); r.w = pk2(b.z, b.w);
    return __builtin_bit_cast(bf16x8, r);
}
__device__ __forceinline__ int perm32k(int d) { return (d & ~31) | (((d >> 2) & 3) << 3) | (((d >> 4) & 1) << 2) | (d & 3); }
__device__ __forceinline__ int perm16v(int s) { return (s & ~15) | (((s >> 2) & 1) << 3) | (((s >> 3) & 1) << 2) | (s & 3); }

#define XB_TMO      128
#define XB_XCNT(j)  (256  + 64 * (j))
#define XB_XSUB(j)  (1280 + 64 * (j))
#define XB_XGEN(j)  (2304 + 64 * (j))
#define XB_TOP      3328
#define XB_TOPGEN   3392
#define XCD_BAR_WORDS 3456
#define XB_SPIN_CAP (1u << 18)
__device__ __forceinline__ unsigned xb_ld(unsigned* p)              { return __hip_atomic_load(p, __ATOMIC_RELAXED, __HIP_MEMORY_SCOPE_AGENT); }
__device__ __forceinline__ unsigned xb_add(unsigned* p, unsigned v) { return __hip_atomic_fetch_add(p, v, __ATOMIC_RELAXED, __HIP_MEMORY_SCOPE_AGENT); }
__device__ __forceinline__ unsigned xb_xcc_id() { return (unsigned)__builtin_amdgcn_s_getreg((3 << 11) | 20) & 0xFu; }
#define XB_SPIN(cond, bar) do { unsigned _sp = 0; while (cond) { __builtin_amdgcn_s_sleep(1); \
    if ((++_sp & 255u) == 0u) { if (xb_ld(&(bar)[XB_TMO])) break; if (_sp > XB_SPIN_CAP) { atomicAdd(&(bar)[XB_TMO], 1u); break; } } } } while (0)
struct XcdBarrier { unsigned* bar; unsigned x; volatile LAS unsigned* st; };
__device__ __forceinline__ XcdBarrier xcd_barrier_post(unsigned* bar, volatile LAS unsigned* st) {
    XcdBarrier b; b.bar = bar; b.x = xb_xcc_id(); b.st = st;
    if (threadIdx.x == 0) (void)xb_add(&bar[XB_XCNT(b.x)], 1u);
    return b;
}
__device__ __forceinline__ void xcd_barrier_complete(unsigned* bar, unsigned x, unsigned& nloc, unsigned& nx) {
    const unsigned G = gridDim.x * gridDim.y * gridDim.z;
    unsigned sum, cnt, mine, sp = 0u;
    for (;;) {
        sum = 0u; cnt = 0u; mine = 0u;
#pragma unroll
        for (unsigned j = 0; j < 16; ++j) { const unsigned c = xb_ld(&bar[XB_XCNT(j)]); sum += c; cnt += (c > 0u) ? 1u : 0u; mine = (j == x) ? c : mine; }
        if (sum == G) break;
        __builtin_amdgcn_s_sleep(1);
        if ((++sp & 255u) == 0u) { if (xb_ld(&bar[XB_TMO])) break; if (sp > XB_SPIN_CAP) { atomicAdd(&bar[XB_TMO], 1u); break; } }
    }
    nloc = mine > 0u ? mine : 1u; nx = cnt > 0u ? cnt : 1u;
}
__device__ __forceinline__ void xcd_barrier(const XcdBarrier& b) {
    asm volatile("s_waitcnt vmcnt(0)" ::: "memory");
    __syncthreads();
    if (threadIdx.x == 0) {
        unsigned* bar = b.bar;
        __builtin_amdgcn_s_waitcnt(0);
        unsigned nloc = b.st[0], nx = b.st[1];
        if (nloc == 0u) { xcd_barrier_complete(bar, b.x, nloc, nx); b.st[0] = nloc; b.st[1] = nx; }
        const unsigned old = xb_add(&bar[XB_XSUB(b.x)], 1u);
        const unsigned gen = old / nloc;
        if (old + 1u == (gen + 1u) * nloc) {
            __builtin_amdgcn_fence(__ATOMIC_RELEASE, "agent");
            asm volatile("s_waitcnt vmcnt(0)" ::: "memory");
            const unsigned og = xb_add(&bar[XB_TOP], 1u);
            const unsigned tg = og / nx;
            if (og + 1u == (tg + 1u) * nx) xb_add(&bar[XB_TOPGEN], 1u);
            else XB_SPIN(xb_ld(&bar[XB_TOPGEN]) == tg, bar);
            __builtin_amdgcn_fence(__ATOMIC_ACQUIRE, "agent");
            xb_add(&bar[XB_XGEN(b.x)], 1u);
            asm volatile("s_waitcnt vmcnt(0)" ::: "memory");
        } else {
            XB_SPIN(xb_ld(&bar[XB_XGEN(b.x)]) == gen, bar);
            __builtin_amdgcn_fence(__ATOMIC_ACQUIRE, "agent");
            asm volatile("s_waitcnt vmcnt(0)" ::: "memory");
        }
    }
    __syncthreads();
}

namespace pg8 {
constexpr int BM = 256, BK = 64, HALF = 128, HTB = HALF * BK * 2, NXCD = 8, WGM = 8;
__device__ __forceinline__ int lds_byte(int r, int c) { const int st = (r >> 4) * 2 + (c >> 5), rr = r & 15, cc = c & 31, ob = rr * 64 + cc * 2; return st * 1024 + (ob ^ (((ob >> 9) & 1) << 5)); }
__device__ __forceinline__ void stage_rc(int b, int& R, int& C) { const int st = b / 1024, sb = b % 1024, swz = sb ^ (((sb >> 9) & 1) << 5); R = (st >> 1) * 16 + swz / 64; C = (st & 1) * 32 + (swz % 64) / 2; }
__device__ __forceinline__ int perm32(int rho) { const int n = rho >> 4, i = rho & 15; return 8 * (i >> 2) + 4 * n + (i & 3); }

struct Unit { int pm, pn, e; const char* A; const char* B; };

__device__ __forceinline__ void tile_order(int L, int nM, int nN, int& pm, int& pn) {
    const int nwg = nM * nN; int wgid = L;
    { const int q = nwg / NXCD, r = nwg % NXCD, xcd = wgid % NXCD, off = wgid / NXCD; wgid = (xcd < r ? xcd * (q + 1) : r * (q + 1) + (xcd - r) * q) + off; }
    const int nig = WGM * nN, gid = wgid / nig, fm = gid * WGM, gsz = (nM - fm) < WGM ? (nM - fm) : WGM;
    pm = fm + ((wgid % nig) % gsz); pn = (wgid % nig) / gsz;
}

template <class Epi, class Sched>
__device__ __forceinline__ void gemm_phase(LAS unsigned char* lds, const int K, const Sched& S, const Epi& E) {
    const int tid = opaque_tid(), wid = __builtin_amdgcn_readfirstlane(tid >> 6), lane = tid & 63, wr = wid >> 2, wc = wid & 3, fr = lane & 15, fq = lane >> 4;
    const int nt = K / BK;
    int Rr[2], Cc[2];
    unsigned voffB[2];
#pragma unroll
    for (int i = 0; i < 2; ++i) { stage_rc(tid * 16 + i * 8192, Rr[i], Cc[i]); const int Rb = Epi::PERM ? ((Rr[i] & ~31) + perm32(Rr[i] & 31)) : Rr[i]; voffB[i] = (unsigned)(Rb * K + Cc[i]) * 2u; }
    const size_t kstep = (size_t)(BK * 2);
    const unsigned hstep = (unsigned)HALF * K * 2;
    const unsigned ldsw = (unsigned)wid * 1024u;
    const int aoff = lds_byte(wr * 64 + fr, fq * 8), boff = lds_byte(wc * 32 + fr, fq * 8);
#define PG8_SA(b, h) (((b) * 2 + (h)) * HTB)
#define PG8_SB(b, h) ((4 + (b) * 2 + (h)) * HTB)
#define PG8_STAGE_A(bufoff, base, kb, h, VO) do { _Pragma("unroll") for (int _i = 0; _i < 2; ++_i) \
        __builtin_amdgcn_global_load_lds((const unsigned*)((base) + (kb) + (Sched::GATHER ? 0u : (h) * hstep) + (VO)[Sched::GATHER ? (h) : 0][_i]), (LAS unsigned*)(lds + (bufoff) + ldsw + _i * 8192), 16, 0, 0); } while (0)
#define PG8_STAGE_B(bufoff, base, kb, h) do { _Pragma("unroll") for (int _i = 0; _i < 2; ++_i) \
        __builtin_amdgcn_global_load_lds((const unsigned*)((base) + (kb) + (h) * hstep + voffB[_i]), (LAS unsigned*)(lds + (bufoff) + ldsw + _i * 8192), 16, 0, 0); } while (0)
#define PG8_LDA(dst, b, h) do { _Pragma("unroll") for (int m = 0; m < 4; ++m) _Pragma("unroll") for (int k = 0; k < 2; ++k) dst[m][k] = *(const LAS bf16x8*)(lds + PG8_SA(b, h) + aoff + m * 2048 + k * 1024); } while (0)
#define PG8_LDB(dst, b, h) do { _Pragma("unroll") for (int n = 0; n < 2; ++n) _Pragma("unroll") for (int k = 0; k < 2; ++k) dst[n][k] = *(const LAS bf16x8*)(lds + PG8_SB(b, h) + boff + n * 2048 + k * 1024); } while (0)
#define PG8_MMA(ai, bj, At, Bt) do { __builtin_amdgcn_s_setprio(1); _Pragma("unroll") for (int m = 0; m < 4; ++m) _Pragma("unroll") for (int n = 0; n < 2; ++n) _Pragma("unroll") for (int k = 0; k < 2; ++k) \
        acc[ai][bj][m][n] = __builtin_amdgcn_mfma_f32_16x16x32_bf16(Bt[n][k], At[m][k], acc[ai][bj][m][n], 0, 0, 0); __builtin_amdgcn_s_setprio(0); } while (0)
#define PG8_WAIT_V(n) asm volatile("s_waitcnt vmcnt(" #n ")" ::: "memory")
#define PG8_WAIT_L(n) asm volatile("s_waitcnt lgkmcnt(" #n ")" ::: "memory")
#define PG8_BAR __builtin_amdgcn_s_barrier()
#define PG8_SCHED __builtin_amdgcn_sched_barrier(0)
#define PG8_AOFFS(VO, u) do { _Pragma("unroll") for (int _h = 0; _h < 2; ++_h) _Pragma("unroll") for (int _i = 0; _i < 2; ++_i) { \
        if constexpr (Sched::GATHER) VO[_h][_i] = (unsigned)S.row_src(u, _h * HALF + Rr[_i]) * (unsigned)(K * 2) + (unsigned)(Cc[_i] * 2); \
        else VO[_h][_i] = (unsigned)(Rr[_i] * K + Cc[_i]) * 2u; } } while (0)
    Unit cur, nxt; int ui = 0;
    if (!S.next(0, cur)) return;
    unsigned voc[2][2], von[2][2];
    PG8_AOFFS(voc, cur);
    f32x4 acc[2][2][4][2];
#pragma unroll
    for (int a = 0; a < 2; ++a)
#pragma unroll
        for (int b = 0; b < 2; ++b)
#pragma unroll
            for (int m = 0; m < 4; ++m)
#pragma unroll
                for (int n = 0; n < 2; ++n) acc[a][b][m][n] = (f32x4){0.f, 0.f, 0.f, 0.f};
    bf16x8 At[4][2], B0[2][2], B1[2][2];
    const char* cA = cur.A; const char* cB = cur.B;
    PG8_STAGE_B(PG8_SB(0, 0), cB, 0, 0); PG8_STAGE_A(PG8_SA(0, 0), cA, 0, 0, voc); PG8_STAGE_B(PG8_SB(0, 1), cB, 0, 1); PG8_STAGE_A(PG8_SA(0, 1), cA, 0, 1, voc);
    if (wr == 1) PG8_BAR;
    PG8_WAIT_V(4); PG8_BAR;
    PG8_STAGE_B(PG8_SB(1, 0), cB, kstep, 0); PG8_STAGE_A(PG8_SA(1, 0), cA, kstep, 0, voc); PG8_STAGE_B(PG8_SB(1, 1), cB, kstep, 1);
    PG8_WAIT_V(6); PG8_BAR;
    for (;;) {
        const bool has_next = S.next(ui + 1, nxt);
        if constexpr (Sched::GATHER) {
            if (has_next) { PG8_AOFFS(von, nxt); }
            else {
#pragma unroll
                for (int _h = 0; _h < 2; ++_h)
#pragma unroll
                    for (int _i = 0; _i < 2; ++_i) von[_h][_i] = voc[_h][_i];
            }
        }
        const char* nA = has_next ? nxt.A : cA; const char* nB = has_next ? nxt.B : cB;
        for (int t = 0; t < nt; t += 2) {
            const bool last = (t == nt - 2);
            const size_t k1 = (size_t)(t + 1) * kstep;
            const char* a2 = last ? nA : cA; const char* b2 = last ? nB : cB;
            const size_t k2 = last ? 0 : (size_t)(t + 2) * kstep, k3 = k2 + kstep;
            unsigned vo2[2][2];
#pragma unroll
            for (int _h = 0; _h < 2; ++_h)
#pragma unroll
                for (int _i = 0; _i < 2; ++_i) { if constexpr (Sched::GATHER) vo2[_h][_i] = last ? von[_h][_i] : voc[_h][_i]; else vo2[_h][_i] = voc[_h][_i]; }
            PG8_LDB(B0, 0, 0); PG8_SCHED; PG8_LDA(At, 0, 0); PG8_STAGE_A(PG8_SA(1, 1), cA, k1, 1, voc);
            PG8_WAIT_L(8); PG8_BAR; PG8_WAIT_L(0); PG8_MMA(0, 0, At, B0); PG8_BAR; PG8_SCHED;
            PG8_LDB(B1, 0, 1); PG8_STAGE_B(PG8_SB(0, 0), b2, k2, 0);
            PG8_BAR; PG8_WAIT_L(0); PG8_MMA(0, 1, At, B1); PG8_BAR;
            PG8_LDA(At, 0, 1); PG8_STAGE_A(PG8_SA(0, 0), a2, k2, 0, vo2);
            PG8_BAR; PG8_WAIT_L(0); PG8_MMA(1, 0, At, B0); PG8_BAR; PG8_SCHED;
            PG8_STAGE_B(PG8_SB(0, 1), b2, k2, 1);
            PG8_WAIT_V(6); PG8_BAR; PG8_MMA(1, 1, At, B1); PG8_BAR;
            PG8_LDB(B0, 1, 0); PG8_SCHED; PG8_LDA(At, 1, 0); PG8_STAGE_A(PG8_SA(0, 1), a2, k2, 1, vo2);
            PG8_WAIT_L(8); PG8_BAR; PG8_WAIT_L(0); PG8_MMA(0, 0, At, B0); PG8_BAR; PG8_SCHED;
            PG8_LDB(B1, 1, 1); PG8_STAGE_B(PG8_SB(1, 0), b2, k3, 0);
            PG8_BAR; PG8_WAIT_L(0); PG8_MMA(0, 1, At, B1); PG8_BAR;
            PG8_LDA(At, 1, 1); PG8_STAGE_A(PG8_SA(1, 0), a2, k3, 0, vo2);
            PG8_BAR; PG8_WAIT_L(0); PG8_MMA(1, 0, At, B0); PG8_BAR; PG8_SCHED;
            PG8_STAGE_B(PG8_SB(1, 1), b2, k3, 1);
            PG8_WAIT_V(6); PG8_BAR; PG8_MMA(1, 1, At, B1); PG8_BAR;
        }
        E(acc, cur, wr, wc, fr, fq);
        if (!has_next) break;
#pragma unroll
        for (int a = 0; a < 2; ++a)
#pragma unroll
            for (int b = 0; b < 2; ++b)
#pragma unroll
                for (int m = 0; m < 4; ++m)
#pragma unroll
                    for (int n = 0; n < 2; ++n) acc[a][b][m][n] = (f32x4){0.f, 0.f, 0.f, 0.f};
        cur = nxt; cA = nA; cB = nB; ++ui;
        if constexpr (Sched::GATHER) {
#pragma unroll
            for (int _h = 0; _h < 2; ++_h)
#pragma unroll
                for (int _i = 0; _i < 2; ++_i) voc[_h][_i] = von[_h][_i];
        }
    }
    PG8_WAIT_V(0);
    if (wr == 0) PG8_BAR;
    PG8_BAR;
#undef PG8_SA
#undef PG8_SB
#undef PG8_STAGE_A
#undef PG8_STAGE_B
#undef PG8_LDA
#undef PG8_LDB
#undef PG8_MMA
#undef PG8_WAIT_V
#undef PG8_WAIT_L
#undef PG8_BAR
#undef PG8_SCHED
#undef PG8_AOFFS
}

struct DenseOrder {
    static constexpr bool GATHER = false;
    const char* A; const char* Bt; int nM, nN, K, G, c;
    __device__ __forceinline__ bool next(int i, Unit& u) const {
        const int L = i * G + c; if (L >= nM * nN) return false;
        tile_order(L, nM, nN, u.pm, u.pn); u.e = 0;
        u.A = A + (size_t)u.pm * BM * K * 2; u.B = Bt + (size_t)u.pn * BM * K * 2; return true;
    }
    __device__ __forceinline__ int row_src(const Unit&, int) const { return 0; }
};
}
using pg8::Unit;

struct EpiProj {
    static constexpr bool PERM = true;
    bf16_t* O;
    __device__ __forceinline__ void operator()(const f32x4 (&acc)[2][2][4][2], const Unit& u, int wr, int wc, int fr, int fq) const {
#pragma unroll
        for (int ai = 0; ai < 2; ++ai)
#pragma unroll
            for (int m = 0; m < 4; ++m) { const int row = u.pm * 256 + ai * 128 + wr * 64 + m * 16 + fr;
#pragma unroll
                for (int bj = 0; bj < 2; ++bj) { const int col = u.pn * 256 + bj * 128 + wc * 32 + 8 * fq; const f32x4 v0 = acc[ai][bj][m][0], v1 = acc[ai][bj][m][1];
                    u32x4 o; o.x = pk2(v0.x, v0.y); o.y = pk2(v0.z, v0.w); o.z = pk2(v1.x, v1.y); o.w = pk2(v1.z, v1.w);
                    *(u32x4*)(O + (size_t)row * DINP + col) = o; } }
    }
};
struct EpiQ {
    static constexpr bool PERM = false;
    bf16_t* Q; const float* tab;
    __device__ __forceinline__ void operator()(const f32x4 (&acc)[2][2][4][2], const Unit& u, int wr, int wc, int fr, int fq) const {
        const float sc = 0.10206207261596577f * 1.4426950408889634f;
#pragma unroll
        for (int ai = 0; ai < 2; ++ai)
#pragma unroll
            for (int m = 0; m < 4; ++m) { const int row = u.pm * 256 + ai * 128 + wr * 64 + m * 16 + fr; const int b = row / SEQ, s = row % SEQ;
#pragma unroll
                for (int bj = 0; bj < 2; ++bj) { const int c0 = u.pn * 256 + bj * 128 + wc * 32; const int g32 = c0 >> 5; const int head = c0 / 96;
                    f32x4 v0 = acc[ai][bj][m][0], v1 = acc[ai][bj][m][1];
                    if (g32 % 3 == 2) {
                        const f32x4 cs = *(const f32x4*)(tab + (size_t)row * 32 + 4 * fq), sn = *(const f32x4*)(tab + (size_t)row * 32 + 16 + 4 * fq);
                        const f32x4 r0 = v0 * cs - v1 * sn, r1 = v1 * cs + v0 * sn; v0 = r0; v1 = r1;
                    }
                    v0 = v0 * sc; v1 = v1 * sc;
                    bf16_t* base = Q + ((size_t)(b * MH + head) * SEQ + s) * DQK + (c0 - head * 96) + 4 * fq;
                    u32x2 o0; o0.x = pk2(v0.x, v0.y); o0.y = pk2(v0.z, v0.w); *(u32x2*)(base) = o0;
                    u32x2 o1; o1.x = pk2(v1.x, v1.y); o1.y = pk2(v1.z, v1.w); *(u32x2*)(base + 16) = o1; } }
    }
};
struct EpiKV {
    static constexpr bool PERM = false;
    bf16_t* Kp; bf16_t* VT;
    __device__ __forceinline__ void operator()(const f32x4 (&acc)[2][2][4][2], const Unit& u, int wr, int wc, int fr, int fq) const {
#pragma unroll
        for (int ai = 0; ai < 2; ++ai)
#pragma unroll
            for (int m = 0; m < 4; ++m) { const int row = u.pm * 256 + ai * 128 + wr * 64 + m * 16 + fr; const int b = row / SEQ, s = row % SEQ;
#pragma unroll
                for (int bj = 0; bj < 2; ++bj) { const int c0 = u.pn * 256 + bj * 128 + wc * 32; const int head = c0 >> 7; const int w0 = c0 & 127;
#pragma unroll
                    for (int n = 0; n < 2; ++n) { const f32x4 v = acc[ai][bj][m][n]; const int within = w0 + 16 * n + 4 * fq;
                        if (within < 64) { u32x2 o; o.x = pk2(v.x, v.y); o.y = pk2(v.z, v.w); *(u32x2*)(Kp + ((size_t)(b * MH + head) * SEQ + s) * DQK + within) = o; }
                        else { bf16_t* vb = VT + ((size_t)(b * MH + head) * 64 + (within - 64)) * SEQ + perm16v(s);
                            vb[0] = (bf16_t)f2bf(v.x); vb[SEQ] = (bf16_t)f2bf(v.y); vb[2 * SEQ] = (bf16_t)f2bf(v.z); vb[3 * SEQ] = (bf16_t)f2bf(v.w); } } } }
    }
};
struct EpiX1 {
    static constexpr bool PERM = false;
    const float* x; float* X1;
    __device__ __forceinline__ void operator()(const f32x4 (&acc)[2][2][4][2], const Unit& u, int wr, int wc, int fr, int fq) const {
#pragma unroll
        for (int ai = 0; ai < 2; ++ai)
#pragma unroll
            for (int m = 0; m < 4; ++m) { const int row = u.pm * 256 + ai * 128 + wr * 64 + m * 16 + fr;
#pragma unroll
                for (int bj = 0; bj < 2; ++bj)
#pragma unroll
                    for (int n = 0; n < 2; ++n) { const size_t o = (size_t)row * D + u.pn * 256 + bj * 128 + wc * 32 + 16 * n + 4 * fq;
                        *(f32x4*)(X1 + o) = *(const f32x4*)(x + o) + acc[ai][bj][m][n]; } }
    }
};
struct EpiAct {
    static constexpr bool PERM = true;
    bf16_t* ACT; const float* b1;
    __device__ __forceinline__ void operator()(const f32x4 (&acc)[2][2][4][2], const Unit& u, int wr, int wc, int fr, int fq) const {
        const float* bb = b1 + (size_t)u.e * 2048;
#pragma unroll
        for (int bj = 0; bj < 2; ++bj) { const int col = u.pn * 256 + bj * 128 + wc * 32 + 8 * fq;
            const f32x4 bv0 = *(const f32x4*)(bb + col), bv1 = *(const f32x4*)(bb + col + 4);
#pragma unroll
            for (int ai = 0; ai < 2; ++ai)
#pragma unroll
                for (int m = 0; m < 4; ++m) { const int row = u.pm * 256 + ai * 128 + wr * 64 + m * 16 + fr;
                    const f32x4 v0 = acc[ai][bj][m][0] + bv0, v1 = acc[ai][bj][m][1] + bv1;
                    float g[4] = {v0.x, v0.z, v1.x, v1.z}, l[4] = {v0.y, v0.w, v1.y, v1.w}, a[4];
#pragma unroll
                    for (int i = 0; i < 4; ++i) { const float xg = fminf(g[i], 7.f), xl = fminf(fmaxf(l[i], -7.f), 7.f); a[i] = xg * sigmoidf_(1.702f * xg) * (xl + 1.f); }
                    u32x2 o; o.x = pk2(a[0], a[1]); o.y = pk2(a[2], a[3]);
                    *(u32x2*)(ACT + (size_t)row * DFF + (col >> 1)) = o; } }
    }
};
struct EpiY {
    static constexpr bool PERM = true;
    bf16_t* Y; const float* b2;
    __device__ __forceinline__ void operator()(const f32x4 (&acc)[2][2][4][2], const Unit& u, int wr, int wc, int fr, int fq) const {
        const float* bb = b2 + (size_t)u.e * 1024;
#pragma unroll
        for (int bj = 0; bj < 2; ++bj) { const int col = u.pn * 256 + bj * 128 + wc * 32 + 8 * fq;
            const f32x4 bv0 = *(const f32x4*)(bb + col), bv1 = *(const f32x4*)(bb + col + 4);
#pragma unroll
            for (int ai = 0; ai < 2; ++ai)
#pragma unroll
                for (int m = 0; m < 4; ++m) { const int row = u.pm * 256 + ai * 128 + wr * 64 + m * 16 + fr;
                    const f32x4 v0 = acc[ai][bj][m][0] + bv0, v1 = acc[ai][bj][m][1] + bv1;
                    u32x4 o; o.x = pk2(v0.x, v0.y); o.y = pk2(v0.z, v0.w); o.z = pk2(v1.x, v1.y); o.w = pk2(v1.z, v1.w);
                    *(u32x4*)(Y + (size_t)row * D + col) = o; } }
    }
};

struct MoeOrder1 {
    static constexpr bool GATHER = true;
    const char* H2; const char* W1T; const int* list; const LAS int* tstart; const LAS int* cnt; int G, c;
    __device__ __forceinline__ bool next(int i, Unit& u) const {
        const int L = i * G + c; const int ntile = tstart[NE]; if (L >= ntile * 8) return false;
        u.pm = L >> 3; u.pn = L & 7; int e = 0;
#pragma unroll 1
        for (int j = 1; j < NE; ++j) e = (tstart[j] <= u.pm) ? j : e;
        u.e = e; u.A = H2; u.B = W1T + ((size_t)e * 2048 + (size_t)u.pn * 256) * 1024 * 2; return true;
    }
    __device__ __forceinline__ int row_src(const Unit& u, int r) const {
        const int rank = (u.pm - tstart[u.e]) * 256 + r; return rank < cnt[u.e] ? list[u.e * T + rank] : 0;
    }
};
struct MoeOrder2 {
    static constexpr bool GATHER = false;
    const char* ACT; const char* W2T; const LAS int* tstart; int G, c;
    __device__ __forceinline__ bool next(int i, Unit& u) const {
        const int L = i * G + c; const int ntile = tstart[NE]; if (L >= ntile * 4) return false;
        u.pm = L >> 2; u.pn = L & 3; int e = 0;
#pragma unroll 1
        for (int j = 1; j < NE; ++j) e = (tstart[j] <= u.pm) ? j : e;
        u.e = e; u.A = ACT + (size_t)u.pm * 256 * 1024 * 2; u.B = W2T + ((size_t)e * 1024 + (size_t)u.pn * 256) * 1024 * 2; return true;
    }
    __device__ __forceinline__ int row_src(const Unit&, int) const { return 0; }
};

__device__ __forceinline__ void transpose_tile(const float* W, int K, int N, bf16_t* WT, int kb, int nb, unsigned char* smem, int tid) {
    float* tile = (float*)smem;
    const int k0 = 64 * kb, n0 = 256 * nb, n4 = tid & 63, kr = tid >> 6;
    f32x4 v[8];
#pragma unroll
    for (int i = 0; i < 8; ++i) { const int k = kr + 8 * i; v[i] = (n0 + 4 * n4 < N) ? *(const f32x4*)(W + (size_t)(k0 + k) * N + n0 + 4 * n4) : (f32x4){0.f, 0.f, 0.f, 0.f}; }
    __syncthreads();
#pragma unroll
    for (int i = 0; i < 8; ++i) { const int k = kr + 8 * i; *(f32x4*)(tile + k * 260 + ((4 * n4) ^ (8 * (k >> 3)))) = v[i]; }
    __syncthreads();
#pragma unroll
    for (int j = 0; j < 4; ++j) { const int c = tid + 512 * j, n = c >> 3, kc = c & 7; const float* src = tile + (8 * kc) * 260 + (n ^ (8 * kc));
        u32x4 o; o.x = pk2(src[0], src[260]); o.y = pk2(src[2 * 260], src[3 * 260]); o.z = pk2(src[4 * 260], src[5 * 260]); o.w = pk2(src[6 * 260], src[7 * 260]);
        *(u32x4*)(WT + (size_t)(n0 + n) * K + k0 + 8 * kc) = o; }
}
constexpr int TT_OUT = 64, TT_W1 = 128, TT_W2 = 64, TT_TOTAL = TT_OUT + NE * TT_W1 + NE * TT_W2;
__device__ __forceinline__ void late_transpose_item(const Params& P, unsigned char* smem, int it, int tid) {
    unsigned char* ws = P.ws;
    if (it < TT_OUT) { transpose_tile(P.w_out, D, D, (bf16_t*)(ws + WS_WOUT), it >> 2, it & 3, smem, tid); return; }
    it -= TT_OUT;
    if (it < NE * TT_W1) { const int e = it >> 7, r = it & 127; transpose_tile(P.w1 + (size_t)e * D * 2048, D, 2048, (bf16_t*)(ws + WS_W1) + (size_t)e * 2048 * D, r >> 3, r & 7, smem, tid); return; }
    it -= NE * TT_W1;
    { const int e = it >> 6, r = it & 63; transpose_tile(P.w2 + (size_t)e * DFF * D, DFF, D, (bf16_t*)(ws + WS_W2) + (size_t)e * D * DFF, r >> 2, r & 3, smem, tid); }
}

__device__ __forceinline__ void phase0(const Params& P, unsigned char* smem) {
    unsigned char* ws = P.ws;
    const int tid_ = opaque_tid(), lane = tid_ & 63, wave = tid_ >> 6, gw = blockIdx.x * NWAVES + wave, ngw = gridDim.x * NWAVES;
    float* slab = (float*)(smem + 73728);
    for (int i = tid_; i < 1024 * 8; i += NTHREADS) slab[i] = P.w_in[(size_t)(i >> 3) * DIN + 2048 + (i & 7)];
    __syncthreads();
    bf16_t* H = (bf16_t*)(ws + WS_H); float* AB = (float*)(ws + WS_AB);
    for (int row = gw; row < T; row += ngw) {
        const f32x4* xr = (const f32x4*)(P.x + (size_t)row * D) + lane;
        f32x4 v[4]; float ss = 0.f;
#pragma unroll
        for (int j = 0; j < 4; ++j) { v[j] = xr[64 * j]; ss += v[j].x * v[j].x + v[j].y * v[j].y + v[j].z * v[j].z + v[j].w * v[j].w; }
        const float rstd = rsqrtf(wave_sum(ss) * (1.f / D) + EPS);
        float acc[8];
#pragma unroll
        for (int c = 0; c < 8; ++c) acc[c] = 0.f;
#pragma unroll
        for (int j = 0; j < 4; ++j) {
            const f32x4 w = *((const f32x4*)P.norm_mix_w + lane + 64 * j);
            v[j] = v[j] * rstd * w;
            u32x2 o; o.x = pk2(v[j].x, v[j].y); o.y = pk2(v[j].z, v[j].w);
            *((u32x2*)(H + (size_t)row * D) + lane + 64 * j) = o;
#pragma unroll
            for (int i = 0; i < 4; ++i) { const float* sw = slab + (size_t)(4 * lane + 256 * j + i) * 8; const f32x4 w0 = *(const f32x4*)sw, w1 = *(const f32x4*)(sw + 4); const float hv = v[j][i];
                acc[0] += hv * w0.x; acc[1] += hv * w0.y; acc[2] += hv * w0.z; acc[3] += hv * w0.w; acc[4] += hv * w1.x; acc[5] += hv * w1.y; acc[6] += hv * w1.z; acc[7] += hv * w1.w; }
        }
#pragma unroll
        for (int c = 0; c < 8; ++c) acc[c] = wave_sum(acc[c]);
        if (lane == 0) { *(f32x4*)(AB + (size_t)row * 8) = (f32x4){acc[0], acc[1], acc[2], acc[3]}; *(f32x4*)(AB + (size_t)row * 8 + 4) = (f32x4){acc[4], acc[5], acc[6], acc[7]}; }
    }
    __syncthreads();
    for (int it = blockIdx.x; it < 210; it += gridDim.x) {
        if (it < 176) transpose_tile(P.w_in, D, DIN, (bf16_t*)(ws + WS_WIN), it / 11, it % 11, smem, tid_);
        else if (it < 194) transpose_tile(P.w_uq, QL, 768, (bf16_t*)(ws + WS_WUQ), (it - 176) / 3, (it - 176) % 3, smem, tid_);
        else transpose_tile(P.w_ukv, KVL, 1024, (bf16_t*)(ws + WS_WUKV), (it - 194) >> 2, (it - 194) & 3, smem, tid_);
    }
}

__constant__ float c_inv_freq[16] = {1.0f, 0.5623413324356079f, 0.3162277638912201f, 0.17782793939113617f, 0.10000000149011612f, 0.05623413249850273f, 0.03162277489900589f,
    0.017782794311642647f, 0.009999999776482582f, 0.005623413249850273f, 0.003162277629598975f, 0.0017782794311642647f, 0.0010000000474974513f, 0.000562341301701963f,
    0.0003162277571391314f, 0.00017782794020604342f};
__device__ __forceinline__ void phase2a(const Params& P) {
    unsigned char* ws = P.ws;
    const int tid_ = opaque_tid(), lane = tid_ & 63, gw = blockIdx.x * NWAVES + (tid_ >> 6), ngw = gridDim.x * NWAVES;
    const bf16_t* PROJ = (const bf16_t*)(ws + WS_PROJ); bf16_t* CQN = (bf16_t*)(ws + WS_CQN); bf16_t* CKVN = (bf16_t*)(ws + WS_CKVN);
    bf16_t* Kp = (bf16_t*)(ws + WS_K); float* tab = (float*)(ws + WS_TAB);
    for (int row = gw; row < T; row += ngw) {
        const bf16_t* pr = PROJ + (size_t)row * DINP; const int b = row / SEQ, s = row % SEQ;
        {
            unsigned a[3]; float ss = 0.f;
#pragma unroll
            for (int j = 0; j < 3; ++j) { a[j] = *(const unsigned*)(pr + C_CQ + 2 * (lane + 64 * j)); const float lo = bflo(a[j]), hi = bfhi(a[j]); ss += lo * lo + hi * hi; }
            const float rstd = rsqrtf(wave_sum(ss) * (1.f / QL) + EPS);
#pragma unroll
            for (int j = 0; j < 3; ++j) { const int idx = 2 * (lane + 64 * j); *(unsigned*)(CQN + (size_t)row * QL + idx) = pk2(bflo(a[j]) * rstd * P.q_norm_w[idx], bfhi(a[j]) * rstd * P.q_norm_w[idx + 1]); }
        }
        {
            unsigned a[2]; float ss = 0.f;
#pragma unroll
            for (int j = 0; j < 2; ++j) { a[j] = *(const unsigned*)(pr + C_CKV + 2 * (lane + 64 * j)); const float lo = bflo(a[j]), hi = bfhi(a[j]); ss += lo * lo + hi * hi; }
            const float rstd = rsqrtf(wave_sum(ss) * (1.f / KVL) + EPS);
#pragma unroll
            for (int j = 0; j < 2; ++j) { const int idx = 2 * (lane + 64 * j); *(unsigned*)(CKVN + (size_t)row * KVL + idx) = pk2(bflo(a[j]) * rstd * P.kv_norm_w[idx], bfhi(a[j]) * rstd * P.kv_norm_w[idx + 1]); }
        }
        if (lane < 16) {
            const float x1 = bf1(pr[C_KR + lane]), x2 = bf1(pr[C_KR + 16 + lane]);
            const float ang = (float)P.pos[row] * c_inv_freq[lane];
            double tt = (double)ang * 0.15915494309189535; tt -= floor(tt);
            if (tt > 0.5) tt -= 1.0;
            const float ar = (float)(tt * 6.283185307179586);
            const float cs = __cosf(ar), sn = __sinf(ar);
            tab[(size_t)row * 32 + lane] = cs; tab[(size_t)row * 32 + 16 + lane] = sn;
            const bf16_t o1 = (bf16_t)f2bf(x1 * cs - x2 * sn), o2 = (bf16_t)f2bf(x2 * cs + x1 * sn);
#pragma unroll
            for (int h = 0; h < MH; ++h) { bf16_t* kp = Kp + ((size_t)(b * MH + h) * SEQ + s) * DQK + 64; kp[lane] = o1; kp[16 + lane] = o2; }
        }
    }
}

__device__ __forceinline__ float softplusf_(float x) { return fmaxf(x, 0.f) + log1pf(__expf(-fabsf(x))); }
__device__ void gdn_prep_item(const Params& P, unsigned char* smem, int item) {
    unsigned char* ws = P.ws;
    const int tid = opaque_tid(), wave = tid >> 6, lane = tid & 63;
    const int n = item % NCH, hh = (item / NCH) % GH, b = item / (NCH * GH);
    const bf16_t* PROJ = (const bf16_t*)(ws + WS_PROJ); const float* AB = (const float*)(ws + WS_AB);
    unsigned char* gp = ws + WS_GP + (size_t)item * GP_ITEM;
    float* Ug = (float*)(gp + GP_U); bf16_t* Wg = (bf16_t*)(gp + GP_W); bf16_t* QDg = (bf16_t*)(gp + GP_QD); bf16_t* KDTg = (bf16_t*)(gp + GP_KDT); bf16_t* QKg = (bf16_t*)(gp + GP_QK);
    float* qs = (float*)smem; float* ks = qs + 64 * 132; float* vs = ks + 64 * 132; float* Am = vs + 64 * 132;
    float* sbeta = Am + 64 * 68; float* sG = sbeta + 64; float* seG = sG + 64; float* sekd = seG + 64;
    __syncthreads();
    if (tid < 384) {
        const int cp = tid % 192, rg = tid / 192, which = (2 * cp) >> 7, cc = (2 * cp) & 127, gc = which * 512 + hh * 128 + cc;
        float w0[4], w1[4];
#pragma unroll
        for (int j = 0; j < 4; ++j) { w0[j] = P.conv_w[j * 1536 + gc]; w1[j] = P.conv_w[j * 1536 + gc + 1]; }
        float* dst = qs + which * (64 * 132);
        float xa[4] = {0.f, 0.f, 0.f, 0.f}, xb[4] = {0.f, 0.f, 0.f, 0.f};
        for (int rr = -3; rr < 32; ++rr) {
            const int r = 32 * rg + rr, t = 64 * n + r;
            unsigned u = 0u;
            if (t >= 0) u = *(const unsigned*)(PROJ + (size_t)(b * SEQ + t) * DINP + gc);
            xa[0] = xa[1]; xa[1] = xa[2]; xa[2] = xa[3]; xa[3] = bflo(u);
            xb[0] = xb[1]; xb[1] = xb[2]; xb[2] = xb[3]; xb[3] = bfhi(u);
            if (rr >= 0) {
                const float ya = w0[0] * xa[0] + w0[1] * xa[1] + w0[2] * xa[2] + w0[3] * xa[3];
                const float yb = w1[0] * xb[0] + w1[1] * xb[1] + w1[2] * xb[2] + w1[3] * xb[3];
                dst[r * 132 + cc] = ya * sigmoidf_(ya); dst[r * 132 + cc + 1] = yb * sigmoidf_(yb);
            }
        }
    } else if (tid >= 448) {
        const int r = lane; const size_t tok = (size_t)b * SEQ + 64 * n + r;
        const float a = AB[tok * 8 + hh], bb = AB[tok * 8 + 4 + hh];
        const float g = -__expf(P.a_log[hh]) * softplusf_(a + P.dt_bias[hh]);
        float G = g;
#pragma unroll
        for (int o = 1; o < 64; o <<= 1) { const float up = __shfl_up(G, o); if (lane >= o) G += up; }
        const float Gl = __shfl(G, 63);
        sbeta[r] = sigmoidf_(bb); sG[r] = G; seG[r] = __expf(G); sekd[r] = __expf(Gl - G);
        if (lane == 0) ((float*)(ws + WS_GT))[item] = __expf(Gl);
    }
    __syncthreads();
    for (int p = wave; p < 128; p += NWAVES) {
        const int which = p >> 6, r = p & 63; float* row = qs + which * (64 * 132) + r * 132;
        const float a0 = row[2 * lane], a1 = row[2 * lane + 1];
        const float ss = wave_sum(a0 * a0 + a1 * a1);
        const float sc = rsqrtf(ss + EPS) * (which == 0 ? 0.08838834764831845f : 1.f);
        row[2 * lane] = a0 * sc; row[2 * lane + 1] = a1 * sc;
    }
    for (int idx = tid; idx < 6 * 256; idx += NTHREADS) {
        const int u = idx >> 8, w = idx & 255; const int I = (u < 3) ? 0 : (u < 5 ? 1 : 2), J = (u < 3) ? u + 1 : (u < 5 ? u - 1 : 3);
        QKg[(16 * I + (w >> 4)) * 64 + perm32k(16 * J + (w & 15))] = 0;
    }
    __syncthreads();
    for (int job = wave; job < 20; job += NWAVES) {
        const int kind = job / 10, p = job % 10; const int I = (p < 1) ? 0 : (p < 3 ? 1 : (p < 6 ? 2 : 3)); const int J = p - (I * (I + 1)) / 2;
        const float* Ar = (kind ? qs : ks) + (16 * I + (lane & 15)) * 132 + (lane >> 4);
        const float* Br = ks + (16 * J + (lane & 15)) * 132 + (lane >> 4);
        f32x4 acc = {0.f, 0.f, 0.f, 0.f};
#pragma unroll 8
        for (int s = 0; s < 32; ++s) acc = __builtin_amdgcn_mfma_f32_16x16x4f32(Ar[4 * s], Br[4 * s], acc, 0, 0, 0);
        const int j = 16 * J + (lane & 15);
#pragma unroll
        for (int r = 0; r < 4; ++r) { const int i = 16 * I + 4 * (lane >> 4) + r;
            const float dec = (i >= j) ? __expf(sG[i] - sG[j]) : 0.f;
            if (kind == 0) Am[i * 68 + j] = (i > j) ? sbeta[i] * acc[r] * dec : 0.f;
            else QKg[i * 64 + perm32k(j)] = (bf16_t)f2bf((i >= j) ? acc[r] * dec : 0.f); }
    }
    __syncthreads();
    if (tid < 256) {
        const int c = tid; float X[64];
        const LAS float* AmL = (const LAS float*)Am; asm volatile("" : "+v"(AmL));
        const LAS float* scL = (const LAS float*)sbeta; asm volatile("" : "+v"(scL));
        const LAS float* rhsL = (c < 128) ? ((const LAS float*)vs + c) : ((const LAS float*)ks + (c - 128));
        const bool isw = (c >= 128);
#pragma unroll
        for (int i = 0; i < 64; ++i) {
            const float eg = isw ? scL[128 + i] : 1.f;
            float a0 = scL[i] * rhsL[i * 132] * eg, a1 = 0.f, a2 = 0.f, a3 = 0.f;
#pragma unroll
            for (int jb = 0; jb < (i + 3) / 4; ++jb) { const f32x4 av = *(const LAS f32x4*)(AmL + i * 68 + 4 * jb);
                if (4 * jb + 0 < i) a0 -= av.x * X[4 * jb + 0];
                if (4 * jb + 1 < i) a1 -= av.y * X[4 * jb + 1];
                if (4 * jb + 2 < i) a2 -= av.z * X[4 * jb + 2];
                if (4 * jb + 3 < i) a3 -= av.w * X[4 * jb + 3];
                if ((jb & 3) == 3) __builtin_amdgcn_sched_barrier(0); }
            X[i] = (a0 + a1) + (a2 + a3);
            asm volatile("" : "+v"(X[i]));
            __builtin_amdgcn_sched_barrier(0);
        }
        if (c < 128) {
#pragma unroll
            for (int i = 0; i < 64; ++i) Ug[i * 128 + c] = X[i];
        } else { const int pd = perm32k(c - 128);
#pragma unroll
            for (int i = 0; i < 64; ++i) Wg[i * 128 + pd] = (bf16_t)f2bf(-X[i]);
        }
    } else {
        const int t2 = tid - 256;
        for (int idx = t2; idx < 64 * 128; idx += 256) { const int i = idx >> 7, d = idx & 127; QDg[i * 128 + perm32k(d)] = (bf16_t)f2bf(qs[i * 132 + d] * seG[i]); }
        for (int idx = t2; idx < 128 * 64; idx += 256) { const int d = idx >> 6, cc = idx & 63; KDTg[d * 64 + perm32k(cc)] = (bf16_t)f2bf(ks[cc * 132 + d] * sekd[cc]); }
    }
}

__device__ void gdn_scan(const Params& P, unsigned char* smem, int bh) {
    unsigned char* ws = P.ws;
    const int tid = opaque_tid(), wave = tid >> 6, lane = tid & 63, e = lane & 15, g = lane >> 4, e0 = 16 * wave;
    float* OA = (float*)(ws + WS_OA); const float* GT = (const float*)(ws + WS_GT);
    constexpr int BUF = 64512, OW = 0, OQD = 18432, OQK = 36864, OKD = 46080;
    f32x4 S[8];
#pragma unroll
    for (int t = 0; t < 8; ++t) S[t] = (f32x4){0.f, 0.f, 0.f, 0.f};
    u32x4 st[7];
    auto gload = [&](int n) {
        const unsigned char* gp = ws + WS_GP + (size_t)(bh * NCH + n) * GP_ITEM;
#pragma unroll
        for (int k = 0; k < 2; ++k) st[k] = *(const u32x4*)(gp + GP_W + (size_t)(tid + 512 * k) * 16);
#pragma unroll
        for (int k = 0; k < 2; ++k) st[2 + k] = *(const u32x4*)(gp + GP_QD + (size_t)(tid + 512 * k) * 16);
        st[4] = *(const u32x4*)(gp + GP_QK + (size_t)tid * 16);
#pragma unroll
        for (int k = 0; k < 2; ++k) st[5 + k] = *(const u32x4*)(gp + GP_KDT + (size_t)(tid + 512 * k) * 16);
    };
    auto lwrite = [&](int buf) {
        unsigned char* L = smem + buf * BUF;
#pragma unroll
        for (int k = 0; k < 2; ++k) { const int c = tid + 512 * k; *(u32x4*)(L + OW + (c >> 4) * 288 + (c & 15) * 16) = st[k]; }
#pragma unroll
        for (int k = 0; k < 2; ++k) { const int c = tid + 512 * k; *(u32x4*)(L + OQD + (c >> 4) * 288 + (c & 15) * 16) = st[2 + k]; }
        { const int c = tid; *(u32x4*)(L + OQK + (c >> 3) * 144 + (c & 7) * 16) = st[4]; }
#pragma unroll
        for (int k = 0; k < 2; ++k) { const int c = tid + 512 * k; *(u32x4*)(L + OKD + (c >> 3) * 144 + (c & 7) * 16) = st[5 + k]; }
    };
    f32x4 un[4]; float gtn;
    auto uload = [&](int n) {
        const float* Ug = (const float*)(ws + WS_GP + (size_t)(bh * NCH + n) * GP_ITEM + GP_U);
#pragma unroll
        for (int m = 0; m < 4; ++m)
#pragma unroll
            for (int r = 0; r < 4; ++r) un[m][r] = Ug[(16 * m + 4 * g + r) * 128 + e0 + e];
        gtn = GT[bh * NCH + n];
    };
    __syncthreads();
    gload(0); lwrite(0); uload(0);
    __syncthreads();
    for (int n = 0; n < NCH; ++n) {
        f32x4 av[4], ao[4];
#pragma unroll
        for (int m = 0; m < 4; ++m) { av[m] = un[m]; ao[m] = (f32x4){0.f, 0.f, 0.f, 0.f}; }
        const float gt = gtn;
        if (n + 1 < NCH) { gload(n + 1); uload(n + 1); }
        const unsigned char* L = smem + (n & 1) * BUF;
        bf16x8 Sb[4];
#pragma unroll
        for (int s = 0; s < 4; ++s) Sb[s] = pack8(S[2 * s], S[2 * s + 1]);
#pragma unroll
        for (int m = 0; m < 4; ++m)
#pragma unroll
            for (int s = 0; s < 4; ++s) {
                const bf16x8 wf = *(const bf16x8*)(L + OW + (16 * m + e) * 288 + (32 * s + 8 * g) * 2);
                const bf16x8 qf = *(const bf16x8*)(L + OQD + (16 * m + e) * 288 + (32 * s + 8 * g) * 2);
                av[m] = __builtin_amdgcn_mfma_f32_16x16x32_bf16(wf, Sb[s], av[m], 0, 0, 0);
                ao[m] = __builtin_amdgcn_mfma_f32_16x16x32_bf16(qf, Sb[s], ao[m], 0, 0, 0);
            }
        bf16x8 Vb[2];
#pragma unroll
        for (int s = 0; s < 2; ++s) Vb[s] = pack8(av[2 * s], av[2 * s + 1]);
#pragma unroll
        for (int m = 0; m < 4; ++m)
#pragma unroll
            for (int s = 0; s < 2; ++s) {
                const bf16x8 kf = *(const bf16x8*)(L + OQK + (16 * m + e) * 144 + (32 * s + 8 * g) * 2);
                ao[m] = __builtin_amdgcn_mfma_f32_16x16x32_bf16(kf, Vb[s], ao[m], 0, 0, 0);
            }
#pragma unroll
        for (int t = 0; t < 8; ++t) { S[t] = S[t] * gt;
#pragma unroll
            for (int s = 0; s < 2; ++s) {
                const bf16x8 df = *(const bf16x8*)(L + OKD + (16 * t + e) * 144 + (32 * s + 8 * g) * 2);
                S[t] = __builtin_amdgcn_mfma_f32_16x16x32_bf16(df, Vb[s], S[t], 0, 0, 0);
            } }
        {
            f32x4* oav = (f32x4*)OA + ((size_t)(bh * NCH + n) * 8 + wave) * 256 + lane;
#pragma unroll
            for (int m = 0; m < 4; ++m) oav[m * 64] = ao[m];
        }
        if (n + 1 < NCH) lwrite((n + 1) & 1);
        __syncthreads();
    }
}

__device__ void attn_item(const Params& P, unsigned char* smem, int item) {
    unsigned char* ws = P.ws;
    const int tid = opaque_tid(), wave = tid >> 6, lane = tid & 63, ql = lane & 31, hf = lane >> 5;
    const int qt = 15 - (item >> 5), bh = item & 31;
    const bf16_t* Qg = (const bf16_t*)(ws + WS_Q) + (size_t)bh * SEQ * DQK;
    const unsigned char* Kg = (const unsigned char*)((const bf16_t*)(ws + WS_K) + (size_t)bh * SEQ * DQK);
    const bf16_t* VTg = (const bf16_t*)(ws + WS_VT) + (size_t)bh * 64 * SEQ;
    bf16_t* OB = (bf16_t*)(ws + WS_OB);
    const int q0 = qt * 256 + 32 * wave;
    const int nkt_w = (q0 >> 6) + 1, nkt_b = 4 * qt + 4;
    constexpr int KB_ = 13312, VB_ = 9216, OK0 = 0, OV0 = 2 * KB_;
    bf16x8 qf[6];
#pragma unroll
    for (int ks = 0; ks < 6; ++ks) qf[ks] = *(const bf16x8*)(Qg + (size_t)(q0 + ql) * DQK + 16 * ks + 8 * hf);
    f32x16 o0, o1;
#pragma unroll
    for (int i = 0; i < 16; ++i) { o0[i] = 0.f; o1[i] = 0.f; }
    float mrun = -1e30f, lsum = 0.f;
    u32x4 sk0, sk1, sv;
    auto gload = [&](int kt) {
        const unsigned char* kp = Kg + (size_t)kt * 64 * DQK * 2;
        sk0 = *(const u32x4*)(kp + (size_t)tid * 16);
        if (tid < 256) sk1 = *(const u32x4*)(kp + (size_t)(tid + 512) * 16);
        sv = *(const u32x4*)(VTg + (size_t)(tid >> 3) * SEQ + kt * 64 + (tid & 7) * 8);
    };
    auto lwrite = [&](int buf) {
        { const int c = tid; *(u32x4*)(smem + OK0 + buf * KB_ + (c / 12) * 208 + (c % 12) * 16) = sk0; }
        if (tid < 256) { const int c = tid + 512; *(u32x4*)(smem + OK0 + buf * KB_ + (c / 12) * 208 + (c % 12) * 16) = sk1; }
        *(u32x4*)(smem + OV0 + buf * VB_ + (tid >> 3) * 144 + (tid & 7) * 16) = sv;
    };
    __syncthreads();
    gload(0); lwrite(0);
    __syncthreads();
    for (int kt = 0; kt < nkt_b; ++kt) {
        if (kt + 1 < nkt_b) gload(kt + 1);
        if (kt < nkt_w) {
            const unsigned char* Kl = smem + OK0 + (kt & 1) * KB_; const unsigned char* Vl = smem + OV0 + (kt & 1) * VB_;
            f32x16 s0, s1;
#pragma unroll
            for (int i = 0; i < 16; ++i) { s0[i] = 0.f; s1[i] = 0.f; }
#pragma unroll
            for (int ks = 0; ks < 6; ++ks) {
                const bf16x8 k0 = *(const bf16x8*)(Kl + ql * 208 + (16 * ks + 8 * hf) * 2);
                const bf16x8 k1 = *(const bf16x8*)(Kl + (32 + ql) * 208 + (16 * ks + 8 * hf) * 2);
                s0 = __builtin_amdgcn_mfma_f32_32x32x16_bf16(k0, qf[ks], s0, 0, 0, 0);
                s1 = __builtin_amdgcn_mfma_f32_32x32x16_bf16(k1, qf[ks], s1, 0, 0, 0);
            }
            float mx = s0[0];
#pragma unroll
            for (int i = 1; i < 16; ++i) mx = fmaxf(mx, s0[i]);
#pragma unroll
            for (int i = 0; i < 16; ++i) mx = fmaxf(mx, s1[i]);
            mx = fmaxf(mx, __shfl_xor(mx, 32));
            const float mnew = fmaxf(mrun, mx), alpha = __builtin_amdgcn_exp2f(mrun - mnew);
            mrun = mnew;
            float ps = 0.f;
#pragma unroll
            for (int i = 0; i < 16; ++i) { s0[i] = __builtin_amdgcn_exp2f(s0[i] - mnew); s1[i] = __builtin_amdgcn_exp2f(s1[i] - mnew); ps += s0[i] + s1[i]; }
            lsum = lsum * alpha + ps;
#pragma unroll
            for (int i = 0; i < 16; ++i) { o0[i] *= alpha; o1[i] *= alpha; }
            bf16x8 pb[2][2];
#pragma unroll
            for (int sp = 0; sp < 2; ++sp) {
                pb[0][sp] = pack8((f32x4){s0[8 * sp], s0[8 * sp + 1], s0[8 * sp + 2], s0[8 * sp + 3]}, (f32x4){s0[8 * sp + 4], s0[8 * sp + 5], s0[8 * sp + 6], s0[8 * sp + 7]});
                pb[1][sp] = pack8((f32x4){s1[8 * sp], s1[8 * sp + 1], s1[8 * sp + 2], s1[8 * sp + 3]}, (f32x4){s1[8 * sp + 4], s1[8 * sp + 5], s1[8 * sp + 6], s1[8 * sp + 7]});
            }
#pragma unroll
            for (int u = 0; u < 2; ++u)
#pragma unroll
                for (int sp = 0; sp < 2; ++sp) {
                    const bf16x8 v0 = *(const bf16x8*)(Vl + ql * 144 + (32 * u + 16 * sp + 8 * hf) * 2);
                    const bf16x8 v1 = *(const bf16x8*)(Vl + (32 + ql) * 144 + (32 * u + 16 * sp + 8 * hf) * 2);
                    o0 = __builtin_amdgcn_mfma_f32_32x32x16_bf16(v0, pb[u][sp], o0, 0, 0, 0);
                    o1 = __builtin_amdgcn_mfma_f32_32x32x16_bf16(v1, pb[u][sp], o1, 0, 0, 0);
                }
        }
        if (kt + 1 < nkt_b) lwrite((kt + 1) & 1);
        __syncthreads();
    }
    lsum += __shfl_xor(lsum, 32);
    const float inv = 1.f / lsum;
    const int b = bh >> 3, h = bh & 7;
    bf16_t* orow = OB + ((size_t)b * SEQ + q0 + ql) * 512 + h * 64;
#pragma unroll
    for (int r = 0; r < 16; ++r) { const int dv = (r & 3) + 8 * (r >> 2) + 4 * hf; orow[dv] = (bf16_t)f2bf(o0[r] * inv); orow[32 + dv] = (bf16_t)f2bf(o1[r] * inv); }
}

__device__ __forceinline__ void phase5(const Params& P) {
    unsigned char* ws = P.ws;
    const int tid_ = opaque_tid(), lane = tid_ & 63, gw = blockIdx.x * NWAVES + (tid_ >> 6), ngw = gridDim.x * NWAVES;
    const f32x4* OA4 = (const f32x4*)(ws + WS_OA); const bf16_t* OB = (const bf16_t*)(ws + WS_OB); const bf16_t* PROJ = (const bf16_t*)(ws + WS_PROJ); bf16_t* OCAT = (bf16_t*)(ws + WS_OCAT);
    const int w = lane >> 3, ep = lane & 7;
    const float gw0 = P.gdn_norm_w[16 * w + 2 * ep], gw1 = P.gdn_norm_w[16 * w + 2 * ep + 1];
    for (int tq = gw; tq < T / 4; tq += ngw) {
        const int t0 = 4 * tq, b = t0 / SEQ, s0 = t0 % SEQ, n = s0 >> 6, c0 = s0 & 63, m = c0 >> 4, g = (c0 >> 2) & 3;
#pragma unroll
        for (int h = 0; h < GH; ++h) {
            const size_t base = ((size_t)((b * GH + h) * NCH + n) * 8 + w) * 256 + m * 64 + g * 16 + 2 * ep;
            const f32x4 va = OA4[base], vb = OA4[base + 1];
#pragma unroll
            for (int r = 0; r < 4; ++r) {
                const float a0 = va[r], a1 = vb[r];
                const float rstd = rsqrtf(wave_sum(a0 * a0 + a1 * a1) * (1.f / 128.f) + EPS);
                const size_t row = (size_t)t0 + r;
                const unsigned zu = *(const unsigned*)(PROJ + row * DINP + C_Z + h * 128 + 16 * w + 2 * ep); const float z0 = bflo(zu), z1 = bfhi(zu);
                *(unsigned*)(OCAT + row * D + h * 128 + 16 * w + 2 * ep) = pk2(a0 * rstd * gw0 * z0 * sigmoidf_(z0), a1 * rstd * gw1 * z1 * sigmoidf_(z1));
            }
        }
#pragma unroll
        for (int r = 0; r < 4; ++r) {
            const size_t row = (size_t)t0 + r;
            const u32x4 v = *((const u32x4*)(OB + row * 512) + lane);
            float f[8] = {bflo(v.x), bfhi(v.x), bflo(v.y), bfhi(v.y), bflo(v.z), bfhi(v.z), bflo(v.w), bfhi(v.w)};
            float ss = 0.f;
#pragma unroll
            for (int i = 0; i < 8; ++i) ss += f[i] * f[i];
            const float rstd = rsqrtf(wave_sum(ss) * (1.f / 512.f) + EPS);
            const float* wn = P.mla_out_norm_w + 8 * lane;
            u32x4 o; o.x = pk2(f[0] * rstd * wn[0], f[1] * rstd * wn[1]); o.y = pk2(f[2] * rstd * wn[2], f[3] * rstd * wn[3]); o.z = pk2(f[4] * rstd * wn[4], f[5] * rstd * wn[5]); o.w = pk2(f[6] * rstd * wn[6], f[7] * rstd * wn[7]);
            *((u32x4*)(OCAT + row * D + 512) + lane) = o;
        }
    }
}

__device__ void phase7(const Params& P, unsigned char* smem) {
    unsigned char* ws = P.ws;
    const int tid = opaque_tid(), wave = tid >> 6, lane = tid & 63;
    float* rw = (float*)smem;
    int* lctl = (int*)(smem + LDS_MISC + 256);
    for (int i = tid; i < 1024 * 8; i += NTHREADS) { const int k = i >> 3, c = i & 7; *(f32x4*)(rw + k * 32 + 4 * (c ^ (k & 7))) = *(const f32x4*)(P.router_w + (size_t)k * 32 + 4 * c); }
    const float* X1 = (const float*)(ws + WS_X1); bf16_t* H2 = (bf16_t*)(ws + WS_H);
    int* tok_e = (int*)(ws + WS_TOKE); int* tok_r = (int*)(ws + WS_TOKR); float* gate = (float*)(ws + WS_GATE); int* list = (int*)(ws + WS_LIST);
    unsigned* cnt = (unsigned*)(ws + WS_CTL) + CW_CNT;
    for (int tg = blockIdx.x; tg < T / 64; tg += gridDim.x) {
    __syncthreads();
    if (tid < 64) lctl[tid] = 0;
    __syncthreads();
    const int tok0 = tg * 64 + wave * 8;
    for (int ti = 0; ti < 8; ++ti) {
        const int row = tok0 + ti;
        float hv[16]; float ss = 0.f;
#pragma unroll
        for (int i = 0; i < 16; ++i) { hv[i] = X1[(size_t)row * D + lane + 64 * i]; ss += hv[i] * hv[i]; }
        const float rstd = rsqrtf(wave_sum(ss) * (1.f / D) + EPS);
        float lg[32];
#pragma unroll
        for (int j = 0; j < 32; ++j) lg[j] = 0.f;
#pragma unroll
        for (int i = 0; i < 16; ++i) { const int k = lane + 64 * i; hv[i] = hv[i] * rstd * P.norm_ffn_w[k];
            H2[(size_t)row * D + k] = (bf16_t)f2bf(hv[i]);
#pragma unroll
            for (int c = 0; c < 8; ++c) { const f32x4 w = *(const f32x4*)(rw + k * 32 + 4 * (c ^ (k & 7)));
                lg[4 * c] += hv[i] * w.x; lg[4 * c + 1] += hv[i] * w.y; lg[4 * c + 2] += hv[i] * w.z; lg[4 * c + 3] += hv[i] * w.w; } }
#pragma unroll
        for (int j = 0; j < 32; ++j) lg[j] = wave_sum(lg[j]) + P.router_b[j];
        int ei[4]; float ev[4];
#pragma unroll
        for (int k = 0; k < 4; ++k) { float best = -3.0e38f; int bi = 0;
#pragma unroll
            for (int j = 0; j < 32; ++j) { const bool taken = (k > 0 && ei[0] == j) || (k > 1 && ei[1] == j) || (k > 2 && ei[2] == j); if (!taken && lg[j] > best) { best = lg[j]; bi = j; } }
            ei[k] = bi; ev[k] = best; }
        float gs = 0.f, gv[4];
#pragma unroll
        for (int k = 0; k < 4; ++k) { gv[k] = __expf(ev[k] - ev[0]); gs += gv[k]; }
        if (lane < 4) {
            const int e = ei[lane == 0 ? 0 : (lane == 1 ? 1 : (lane == 2 ? 2 : 3))]; const float gg = gv[lane == 0 ? 0 : (lane == 1 ? 1 : (lane == 2 ? 2 : 3))] / gs;
            const int lr = atomicAdd(&lctl[e], 1);
            lctl[64 + ((wave * 8 + ti) * 4 + lane) * 2] = e; lctl[64 + ((wave * 8 + ti) * 4 + lane) * 2 + 1] = lr;
            gate[(size_t)row * 4 + lane] = gg;
        }
    }
    __syncthreads();
    if (tid < 32) lctl[32 + tid] = (int)atomicAdd(&cnt[tid], (unsigned)lctl[tid]);
    __syncthreads();
    if (tid < 256) { const int e = lctl[64 + tid * 2], lr = lctl[64 + tid * 2 + 1]; const int row = tg * 64 + (tid >> 2); const int rank = lctl[32 + e] + lr;
        tok_e[(size_t)row * 4 + (tid & 3)] = e; tok_r[(size_t)row * 4 + (tid & 3)] = rank; list[e * T + rank] = row; }
    }
}

__device__ __forceinline__ void moe_tiles(const Params& P, unsigned char* smem) {
    int* tstart = (int*)(smem + LDS_MISC + 256); int* cntl = tstart + 64;
    const unsigned* cnt = (const unsigned*)(P.ws + WS_CTL) + CW_CNT;
    __syncthreads();
    if (threadIdx.x == 0) { int acc = 0; for (int e = 0; e < NE; ++e) { const int c = (int)__hip_atomic_load(&cnt[e], __ATOMIC_RELAXED, __HIP_MEMORY_SCOPE_AGENT); cntl[e] = c; tstart[e] = acc; acc += (c + 255) >> 8; } tstart[NE] = acc; }
    __syncthreads();
}

__device__ __forceinline__ void phase11(const Params& P, unsigned char* smem) {
    unsigned char* ws = P.ws;
    const int tid_ = opaque_tid(), lane = tid_ & 63, gw = blockIdx.x * NWAVES + (tid_ >> 6), ngw = gridDim.x * NWAVES;
#if LEVEL >= 2
    const float* X1 = (const float*)(ws + WS_X1);
#else
    const float* X1 = P.x;
#endif
#if LEVEL >= 4
    const int* tstart = (const int*)(smem + LDS_MISC + 256);
    const int* tok_e = (const int*)(ws + WS_TOKE); const int* tok_r = (const int*)(ws + WS_TOKR); const float* gate = (const float*)(ws + WS_GATE); const bf16_t* Y = (const bf16_t*)(ws + WS_Y);
#endif
    for (int row = gw; row < T; row += ngw) {
        f32x4 v[4];
#pragma unroll
        for (int j = 0; j < 4; ++j) v[j] = *((const f32x4*)(X1 + (size_t)row * D) + lane + 64 * j);
#if LEVEL >= 4
#pragma unroll
        for (int k = 0; k < 4; ++k) { const int e = tok_e[(size_t)row * 4 + k], rk = tok_r[(size_t)row * 4 + k]; const float gg = gate[(size_t)row * 4 + k];
            const bf16_t* yr = Y + (size_t)(tstart[e] * 256 + rk) * D;
#pragma unroll
            for (int j = 0; j < 4; ++j) { const u32x2 yy = *((const u32x2*)yr + lane + 64 * j); v[j].x += gg * bflo(yy.x); v[j].y += gg * bfhi(yy.x); v[j].z += gg * bflo(yy.y); v[j].w += gg * bfhi(yy.y); } }
#endif
        float ss = 0.f;
#pragma unroll
        for (int j = 0; j < 4; ++j) ss += v[j].x * v[j].x + v[j].y * v[j].y + v[j].z * v[j].z + v[j].w * v[j].w;
        const float rstd = rsqrtf(wave_sum(ss) * (1.f / D) + EPS);
#pragma unroll
        for (int j = 0; j < 4; ++j) *((f32x4*)(P.out + (size_t)row * D) + lane + 64 * j) = v[j] * rstd * *((const f32x4*)P.norm_final_w + lane + 64 * j);
    }
}

extern "C" __global__ void __launch_bounds__(NTHREADS) fwd_megakernel(Params P) {
    extern __shared__ __attribute__((aligned(16))) unsigned char smem[];
    LAS unsigned char* lds = (LAS unsigned char*)smem;
    unsigned char* ws = P.ws;
    const int tid = threadIdx.x;
    const int G = gridDim.x, bid = blockIdx.x;
    volatile LAS unsigned* misc = (volatile LAS unsigned*)(lds + LDS_MISC);
    if (tid < 64) misc[tid] = 0u;
    __syncthreads();
    XcdBarrier bar = xcd_barrier_post((unsigned*)(ws + WS_CTL) + CW_BAR, misc);
#define GRID_BAR() xcd_barrier(bar)

    REP(0) phase0(P, smem);
    GRID_BAR();
#if LEVEL >= 2
    REP(1) {
        pg8::DenseOrder S{(const char*)(ws + WS_H), (const char*)(ws + WS_WIN), T / 256, DINP / 256, D, G, bid};
        EpiProj E{(bf16_t*)(ws + WS_PROJ)};
        pg8::gemm_phase<EpiProj, pg8::DenseOrder>(lds, D, S, E);
    }
    GRID_BAR();
    REP(2) phase2a(P);
#if LEVEL >= 3
    REP(12) for (int item = bid; item < NB * GH * NCH; item += G) gdn_prep_item(P, smem, item);
#endif
    GRID_BAR();
    REP(3) {
        pg8::DenseOrder S{(const char*)(ws + WS_CQN), (const char*)(ws + WS_WUQ), T / 256, 768 / 256, QL, G, bid};
        EpiQ E{(bf16_t*)(ws + WS_Q), (const float*)(ws + WS_TAB)};
        pg8::gemm_phase<EpiQ, pg8::DenseOrder>(lds, QL, S, E);
        pg8::DenseOrder S2{(const char*)(ws + WS_CKVN), (const char*)(ws + WS_WUKV), T / 256, 1024 / 256, KVL, G, (bid + 64) % G};
        EpiKV E2{(bf16_t*)(ws + WS_K), (bf16_t*)(ws + WS_VT)};
        pg8::gemm_phase<EpiKV, pg8::DenseOrder>(lds, KVL, S2, E2);
    }
    GRID_BAR();
    {
        if (bid < NB * GH) gdn_scan(P, smem, bid);
        unsigned* aq = (unsigned*)(ws + WS_CTL) + CW_AQ;
        const int tidq = opaque_tid();
        const bool tfirst = ((bid & 3) == 3);
#pragma unroll 1
        for (int pass = 0; pass < 2; ++pass) {
            const bool do_t = (pass == 0) == tfirst;
            unsigned* qh = aq + (do_t ? 64 : 0);
            const int qn = do_t ? TT_TOTAL : 512;
            for (;;) {
                __syncthreads();
                if (tidq == 0) misc[8] = atomicAdd(qh, 1u);
                __syncthreads();
                const int item = (int)misc[8];
                if (item >= qn) break;
                if (do_t) late_transpose_item(P, smem, item, tidq); else attn_item(P, smem, item);
            }
        }
    }
    GRID_BAR();
    REP(5) phase5(P);
    GRID_BAR();
    REP(6) {
        pg8::DenseOrder S{(const char*)(ws + WS_OCAT), (const char*)(ws + WS_WOUT), T / 256, D / 256, D, G, bid};
        EpiX1 E{P.x, (float*)(ws + WS_X1)};
        pg8::gemm_phase<EpiX1, pg8::DenseOrder>(lds, D, S, E);
    }
    GRID_BAR();
#endif
#if LEVEL >= 4
    phase7(P, smem);
    GRID_BAR();
    moe_tiles(P, smem);
    REP(9) {
        const LAS int* ts = (const LAS int*)(lds + LDS_MISC + 256);
        MoeOrder1 S{(const char*)(ws + WS_H), (const char*)(ws + WS_W1), (const int*)(ws + WS_LIST), ts, ts + 64, G, bid};
        EpiAct E{(bf16_t*)(ws + WS_ACT), P.b1};
        pg8::gemm_phase<EpiAct, MoeOrder1>(lds, D, S, E);
    }
    GRID_BAR();
    REP(10) {
        const LAS int* ts = (const LAS int*)(lds + LDS_MISC + 256);
        MoeOrder2 S{(const char*)(ws + WS_ACT), (const char*)(ws + WS_W2), ts, G, bid};
        EpiY E{(bf16_t*)(ws + WS_Y), P.b2};
        pg8::gemm_phase<EpiY, MoeOrder2>(lds, DFF, S, E);
    }
    GRID_BAR();
#endif
    REP(11) phase11(P, smem);
}

extern "C" void kernel_launch(void* const* d_in, const int* in_sizes, int n_in, void* d_out, int out_size, void* d_ws, size_t ws_size, hipStream_t stream) {
    static int grid = 0;
    if (grid == 0) {
        if (n_in != 22 || in_sizes[0] != T * D || out_size != T * D || ws_size < WS_END) {
            fprintf(stderr, "kernel_launch: unexpected shapes (n_in %d, in0 %d, out %d, ws %zu < %zu)\n", n_in, n_in > 0 ? in_sizes[0] : -1, out_size, ws_size, (size_t)WS_END); grid = -1; return; }
        int dev = 0, cus = 0, per_cu = 0;
        if (hipGetDevice(&dev) != hipSuccess || hipDeviceGetAttribute(&cus, hipDeviceAttributeMultiprocessorCount, dev) != hipSuccess) { grid = -1; return; }
        if (hipFuncSetAttribute((const void*)fwd_megakernel, hipFuncAttributeMaxDynamicSharedMemorySize, LDS_BYTES) != hipSuccess) { fprintf(stderr, "kernel_launch: hipFuncSetAttribute failed\n"); grid = -1; return; }
        if (hipOccupancyMaxActiveBlocksPerMultiprocessor(&per_cu, (const void*)fwd_megakernel, NTHREADS, LDS_BYTES) != hipSuccess || per_cu < 1) { fprintf(stderr, "kernel_launch: occupancy query says %d\n", per_cu); (void)hipGetLastError(); grid = -1; return; }
        grid = cus;
        if (grid != 256) fprintf(stderr, "kernel_launch: note: %d CUs\n", grid);
    }
    if (grid < 0) return;
    (void)hipMemsetAsync((char*)d_ws + WS_CTL, 0, CTL_BYTES, stream);
    Params p{};
    p.x = (const float*)d_in[0]; p.pos = (const int*)d_in[1]; p.norm_mix_w = (const float*)d_in[2]; p.w_in = (const float*)d_in[3]; p.conv_w = (const float*)d_in[4];
    p.a_log = (const float*)d_in[5]; p.dt_bias = (const float*)d_in[6]; p.gdn_norm_w = (const float*)d_in[7]; p.q_norm_w = (const float*)d_in[8]; p.w_uq = (const float*)d_in[9];
    p.kv_norm_w = (const float*)d_in[10]; p.w_ukv = (const float*)d_in[11]; p.mla_out_norm_w = (const float*)d_in[12]; p.w_out = (const float*)d_in[13]; p.norm_ffn_w = (const float*)d_in[14];
    p.router_w = (const float*)d_in[15]; p.router_b = (const float*)d_in[16]; p.w1 = (const float*)d_in[17]; p.b1 = (const float*)d_in[18]; p.w2 = (const float*)d_in[19];
    p.b2 = (const float*)d_in[20]; p.norm_final_w = (const float*)d_in[21]; p.out = (float*)d_out; p.ws = (unsigned char*)d_ws;
    void* args[] = {&p};
    hipError_t e = hipLaunchCooperativeKernel((const void*)fwd_megakernel, dim3(grid), dim3(NTHREADS), args, LDS_BYTES, stream);
    if (e != hipSuccess) fprintf(stderr, "kernel_launch: cooperative launch failed: %s (grid %d)\n", hipGetErrorString(e), grid);
}
```

```cpp
#include <hip/hip_runtime.h>
#include <cstdio>
#include <cstdint>

#ifndef LEVEL
#define LEVEL 4
#endif

#ifndef DUP
#define DUP -1
#endif
#ifndef TSA
#define TSA -1
#define TSB -1
#endif
#define REP(k) for (int rep_ = 0; rep_ < ((DUP == (k)) ? 2 : 1); ++rep_)
#define LAS __attribute__((address_space(3)))
typedef unsigned short bf16_t;
typedef short bf16x8 __attribute__((ext_vector_type(8)));
typedef float f32x4 __attribute__((ext_vector_type(4)));
typedef float f32x16 __attribute__((ext_vector_type(16)));
typedef unsigned u32x4 __attribute__((ext_vector_type(4)));
typedef unsigned u32x2 __attribute__((ext_vector_type(2)));

constexpr int NB = 4, SEQ = 4096, T = NB * SEQ, D = 1024, DIN = 2728, DINP = 2816;
constexpr int GH = 4, NCH = SEQ / 64;
constexpr int MH = 8, DQK = 96, QL = 384, KVL = 256;
constexpr int NE = 32, DFF = 1024;
constexpr int C_Z = 1536, C_CQ = 2056, C_CKV = 2440, C_KR = 2696;
constexpr float EPS = 1e-6f;
constexpr int NTHREADS = 512, NWAVES = 8;
constexpr int LDS_BYTES = 147456;
constexpr int LDS_MISC = 131072;
constexpr int MOE_MAXROWS = 73728;

constexpr size_t MiB = 1u << 20;
constexpr size_t WS_CTL = 0, CTL_BYTES = 65536;
constexpr size_t WS_WIN = 1 * MiB, WS_WUQ = 7 * MiB, WS_WUKV = 8 * MiB, WS_WOUT = 9 * MiB, WS_W1 = 11 * MiB, WS_W2 = 139 * MiB;
constexpr size_t WS_X1 = 203 * MiB, WS_H = 267 * MiB, WS_AB = 299 * MiB, WS_TAB = 300 * MiB;
constexpr size_t WS_TOKE = 302 * MiB, WS_TOKR = WS_TOKE + 256 * 1024, WS_GATE = WS_TOKR + 256 * 1024, WS_LIST = 303 * MiB;
constexpr size_t WS_R = 306 * MiB;
constexpr size_t WS_PROJ = WS_R, WS_CQN = WS_R + 88 * MiB, WS_CKVN = WS_R + 100 * MiB, WS_Q = WS_R + 108 * MiB, WS_K = WS_R + 132 * MiB, WS_VT = WS_R + 156 * MiB;
constexpr size_t WS_GP = WS_R + 172 * MiB;
constexpr size_t GP_ITEM = 90112, GP_U = 0, GP_W = 32768, GP_QD = 49152, GP_KDT = 65536, GP_QK = 81920;
constexpr size_t WS_GT = WS_R + 260 * MiB, WS_OA = WS_R + 261 * MiB, WS_OB = WS_R + 293 * MiB, WS_OCAT = WS_R + 309 * MiB;
constexpr size_t WS_ACT = WS_R, WS_Y = WS_R + 144 * MiB, WS_XG = WS_R + 288 * MiB;
constexpr size_t WS_SB = WS_R + 341 * MiB;
constexpr size_t WS_END = WS_R + 373 * MiB;
constexpr int CW_BAR = 4096, CW_CNT = 8192  , CW_AQ = 8320  , CW_TS = 12288  ;

struct Params {
    const float* x; const int* pos; const float* norm_mix_w; const float* w_in; const float* conv_w; const float* a_log; const float* dt_bias;
    const float* gdn_norm_w; const float* q_norm_w; const float* w_uq; const float* kv_norm_w; const float* w_ukv; const float* mla_out_norm_w;
    const float* w_out; const float* norm_ffn_w; const float* router_w; const float* router_b; const float* w1; const float* b1; const float* w2;
    const float* b2; const float* norm_final_w; float* out; unsigned char* ws;
};

typedef float f32x2v __attribute__((ext_vector_type(2)));
typedef __bf16 bf16x2v __attribute__((ext_vector_type(2)));
__device__ __forceinline__ unsigned pk2(float lo, float hi) { const f32x2v v = {lo, hi}; return __builtin_bit_cast(unsigned, __builtin_convertvector(v, bf16x2v)); }
__device__ __forceinline__ unsigned f2bf(float f) { return pk2(f, 0.f) & 0xffffu; }
__device__ __forceinline__ unsigned pk4_fp8(float a, float b, float c, float d) { unsigned w = 0u; w = __builtin_amdgcn_cvt_pk_fp8_f32(a, b, w, false); w = __builtin_amdgcn_cvt_pk_fp8_f32(c, d, w, true); return w; }
typedef int v4i_t __attribute__((ext_vector_type(4)));
typedef int v8i_t __attribute__((ext_vector_type(8)));
__device__ __forceinline__ float bflo(unsigned u) { return __builtin_bit_cast(float, u << 16); }
__device__ __forceinline__ float bfhi(unsigned u) { return __builtin_bit_cast(float, u & 0xffff0000u); }
__device__ __forceinline__ float bf1(bf16_t b) { return __builtin_bit_cast(float, (unsigned)b << 16); }
__device__ __forceinline__ float wave_sum(float v) {
#pragma unroll
    for (int o = 1; o < 64; o <<= 1) v += __shfl_xor(v, o);
    return v;
}
__device__ __forceinline__ int opaque_tid() { int t = threadIdx.x; asm volatile("" : "+v"(t)); return t; }
__device__ __forceinline__ float sigmoidf_(float x) { return 1.f / (1.f + __expf(-x)); }
__device__ __forceinline__ bf16x8 pack8(f32x4 a, f32x4 b) {
    u32x4 r; r.x = pk2(a.x, a.y); r.y = pk2(a.z, a.w); r.z = pk2(b.x, b.y); r.w = pk2(b.z, b.w);
    return __builtin_bit_cast(bf16x8, r);
}
__device__ __forceinline__ int perm32k(int d) { return (d & ~31) | (((d >> 2) & 3) << 3) | (((d >> 4) & 1) << 2) | (d & 3); }
__device__ __forceinline__ int perm16v(int s) { return (s & ~15) | (((s >> 2) & 1) << 3) | (((s >> 3) & 1) << 2) | (s & 3); }

#define XB_TMO      128
#define XB_XCNT(j)  (256  + 64 * (j))
#define XB_XSUB(j)  (1280 + 64 * (j))
#define XB_XGEN(j)  (2304 + 64 * (j))
#define XB_TOP      3328
#define XB_TOPGEN   3392
#define XCD_BAR_WORDS 3456
#define XB_SPIN_CAP (1u << 18)
__device__ __forceinline__ unsigned xb_ld(unsigned* p)              { return __hip_atomic_load(p, __ATOMIC_RELAXED, __HIP_MEMORY_SCOPE_AGENT); }
__device__ __forceinline__ unsigned xb_add(unsigned* p, unsigned v) { return __hip_atomic_fetch_add(p, v, __ATOMIC_RELAXED, __HIP_MEMORY_SCOPE_AGENT); }
__device__ __forceinline__ unsigned xb_xcc_id() { return (unsigned)__builtin_amdgcn_s_getreg((3 << 11) | 20) & 0xFu; }
#define XB_SPIN(cond, bar) do { unsigned _sp = 0; while (cond) { __builtin_amdgcn_s_sleep(1); \
    if ((++_sp & 255u) == 0u) { if (xb_ld(&(bar)[XB_TMO])) break; if (_sp > XB_SPIN_CAP) { atomicAdd(&(bar)[XB_TMO], 1u); break; } } } } while (0)
struct XcdBarrier { unsigned* bar; unsigned x; volatile LAS unsigned* st; };
__device__ __forceinline__ XcdBarrier xcd_barrier_post(unsigned* bar, volatile LAS unsigned* st) {
    XcdBarrier b; b.bar = bar; b.x = xb_xcc_id(); b.st = st;
    if (threadIdx.x == 0) (void)xb_add(&bar[XB_XCNT(b.x)], 1u);
    return b;
}
__device__ __forceinline__ void xcd_barrier_complete(unsigned* bar, unsigned x, unsigned& nloc, unsigned& nx) {
    const unsigned G = gridDim.x * gridDim.y * gridDim.z;
    unsigned sum, cnt, mine, sp = 0u;
    for (;;) {
        sum = 0u; cnt = 0u; mine = 0u;
#pragma unroll
        for (unsigned j = 0; j < 16; ++j) { const unsigned c = xb_ld(&bar[XB_XCNT(j)]); sum += c; cnt += (c > 0u) ? 1u : 0u; mine = (j == x) ? c : mine; }
        if (sum == G) break;
        __builtin_amdgcn_s_sleep(1);
        if ((++sp & 255u) == 0u) { if (xb_ld(&bar[XB_TMO])) break; if (sp > XB_SPIN_CAP) { atomicAdd(&bar[XB_TMO], 1u); break; } }
    }
    nloc = mine > 0u ? mine : 1u; nx = cnt > 0u ? cnt : 1u;
}
__device__ __forceinline__ void xcd_barrier(const XcdBarrier& b) {
    asm volatile("s_waitcnt vmcnt(0)" ::: "memory");
    __syncthreads();
    if (threadIdx.x == 0) {
        unsigned* bar = b.bar;
        __builtin_amdgcn_s_waitcnt(0);
        unsigned nloc = b.st[0], nx = b.st[1];
        if (nloc == 0u) { xcd_barrier_complete(bar, b.x, nloc, nx); b.st[0] = nloc; b.st[1] = nx; }
        const unsigned old = xb_add(&bar[XB_XSUB(b.x)], 1u);
        const unsigned gen = old / nloc;
        if (old + 1u == (gen + 1u) * nloc) {
            __builtin_amdgcn_fence(__ATOMIC_RELEASE, "agent");
            asm volatile("s_waitcnt vmcnt(0)" ::: "memory");
            const unsigned og = xb_add(&bar[XB_TOP], 1u);
            const unsigned tg = og / nx;
            if (og + 1u == (tg + 1u) * nx) xb_add(&bar[XB_TOPGEN], 1u);
            else XB_SPIN(xb_ld(&bar[XB_TOPGEN]) == tg, bar);
            __builtin_amdgcn_fence(__ATOMIC_ACQUIRE, "agent");
            xb_add(&bar[XB_XGEN(b.x)], 1u);
            asm volatile("s_waitcnt vmcnt(0)" ::: "memory");
        } else {
            XB_SPIN(xb_ld(&bar[XB_XGEN(b.x)]) == gen, bar);
            __builtin_amdgcn_fence(__ATOMIC_ACQUIRE, "agent");
            asm volatile("s_waitcnt vmcnt(0)" ::: "memory");
        }
    }
    __syncthreads();
}

namespace pg8 {
constexpr int BM = 256, BK = 64, HALF = 128, HTB = HALF * BK * 2, NXCD = 8, WGM = 8;
__device__ __forceinline__ int lds_byte(int r, int c) { const int st = (r >> 4) * 2 + (c >> 5), rr = r & 15, cc = c & 31, ob = rr * 64 + cc * 2; return st * 1024 + (ob ^ (((ob >> 9) & 1) << 5)); }
__device__ __forceinline__ void stage_rc(int b, int& R, int& C) { const int st = b / 1024, sb = b % 1024, swz = sb ^ (((sb >> 9) & 1) << 5); R = (st >> 1) * 16 + swz / 64; C = (st & 1) * 32 + (swz % 64) / 2; }
__device__ __forceinline__ int perm32(int rho) { const int n = rho >> 4, i = rho & 15; return 8 * (i >> 2) + 4 * n + (i & 3); }

struct Unit { int pm, pn, e; const char* A; const char* B; };

__device__ __forceinline__ void tile_order(int L, int nM, int nN, int& pm, int& pn) {
    const int nwg = nM * nN; int wgid = L;
    { const int q = nwg / NXCD, r = nwg % NXCD, xcd = wgid % NXCD, off = wgid / NXCD; wgid = (xcd < r ? xcd * (q + 1) : r * (q + 1) + (xcd - r) * q) + off; }
    const int nig = WGM * nN, gid = wgid / nig, fm = gid * WGM, gsz = (nM - fm) < WGM ? (nM - fm) : WGM;
    pm = fm + ((wgid % nig) % gsz); pn = (wgid % nig) / gsz;
}

template <class Epi, class Sched, bool FP8 = false>
__device__ __forceinline__ void gemm_phase(LAS unsigned char* lds, const int K, const Sched& S, const Epi& E) {
    const int tid = opaque_tid(), wid = __builtin_amdgcn_readfirstlane(tid >> 6), lane = tid & 63, wr = wid >> 2, wc = wid & 3, fr = lane & 15, fq = lane >> 4;
    const int RB = FP8 ? K : 2 * K;
    const int nt = RB / 128;
    int Rr[2], Cc[2];
    unsigned voffB[2];
#pragma unroll
    for (int i = 0; i < 2; ++i) { stage_rc(tid * 16 + i * 8192, Rr[i], Cc[i]); const int Rb = Epi::PERM ? ((Rr[i] & ~31) + perm32(Rr[i] & 31)) : Rr[i]; voffB[i] = (unsigned)(Rb * RB + Cc[i] * 2); }
    const size_t kstep = (size_t)(BK * 2);
    const unsigned hstep = (unsigned)HALF * RB;
    const unsigned ldsw = (unsigned)wid * 1024u;
    const int aoff = lds_byte(wr * 64 + fr, fq * 8), boff = lds_byte(wc * 32 + fr, fq * 8);
#define PG8_SA(b, h) (((b) * 2 + (h)) * HTB)
#define PG8_SB(b, h) ((4 + (b) * 2 + (h)) * HTB)
#define PG8_RS(p) __builtin_amdgcn_make_buffer_rsrc((void*)(p), 0, 0x7fffffff, 0x00020000)
#define PG8_STAGE_A(bufoff, base, kb, h, VO) do { const auto rs_ = PG8_RS(base); _Pragma("unroll") for (int _i = 0; _i < 2; ++_i) \
        __builtin_amdgcn_raw_ptr_buffer_load_lds(rs_, (LAS void*)(lds + (bufoff) + ldsw + _i * 8192), 16, (int)(VO)[Sched::GATHER ? (h) : 0][_i], (int)((kb) + (Sched::GATHER ? 0u : (h) * hstep)), 0, 0); } while (0)
#define PG8_STAGE_B(bufoff, base, kb, h) do { const auto rs_ = PG8_RS(base); _Pragma("unroll") for (int _i = 0; _i < 2; ++_i) \
        __builtin_amdgcn_raw_ptr_buffer_load_lds(rs_, (LAS void*)(lds + (bufoff) + ldsw + _i * 8192), 16, (int)voffB[_i], (int)((kb) + (h) * hstep), 0, 0); } while (0)
#define PG8_LDA(dst, b, h) do { if constexpr (FP8) { _Pragma("unroll") for (int m = 0; m < 4; ++m) { const v4i_t x0_ = *(const LAS v4i_t*)(lds + PG8_SA(b, h) + aoff + m * 2048), x1_ = *(const LAS v4i_t*)(lds + PG8_SA(b, h) + aoff + m * 2048 + 1024); \
            dst##8[m] = __builtin_shufflevector(x0_, x1_, 0, 1, 2, 3, 4, 5, 6, 7); } } \
        else { _Pragma("unroll") for (int m = 0; m < 4; ++m) _Pragma("unroll") for (int k = 0; k < 2; ++k) dst[m][k] = *(const LAS bf16x8*)(lds + PG8_SA(b, h) + aoff + m * 2048 + k * 1024); } } while (0)
#define PG8_LDB(dst, b, h) do { if constexpr (FP8) { _Pragma("unroll") for (int n = 0; n < 2; ++n) { const v4i_t x0_ = *(const LAS v4i_t*)(lds + PG8_SB(b, h) + boff + n * 2048), x1_ = *(const LAS v4i_t*)(lds + PG8_SB(b, h) + boff + n * 2048 + 1024); \
            dst##8[n] = __builtin_shufflevector(x0_, x1_, 0, 1, 2, 3, 4, 5, 6, 7); } } \
        else { _Pragma("unroll") for (int n = 0; n < 2; ++n) _Pragma("unroll") for (int k = 0; k < 2; ++k) dst[n][k] = *(const LAS bf16x8*)(lds + PG8_SB(b, h) + boff + n * 2048 + k * 1024); } } while (0)
#define PG8_MMA(ai, bj, At, Bt) do { __builtin_amdgcn_s_setprio(1); \
        if constexpr (FP8) { _Pragma("unroll") for (int m = 0; m < 4; ++m) _Pragma("unroll") for (int n = 0; n < 2; ++n) \
            asm volatile("v_mfma_f32_16x16x128_f8f6f4 %0, %1, %2, %0" : "+v"(acc[ai][bj][m][n]) : "v"(Bt##8[n]), "v"(At##8[m])); } \
        else { _Pragma("unroll") for (int m = 0; m < 4; ++m) _Pragma("unroll") for (int n = 0; n < 2; ++n) _Pragma("unroll") for (int k = 0; k < 2; ++k) \
            acc[ai][bj][m][n] = __builtin_amdgcn_mfma_f32_16x16x32_bf16(Bt[n][k], At[m][k], acc[ai][bj][m][n], 0, 0, 0); } \
        __builtin_amdgcn_s_setprio(0); } while (0)
#define PG8_WAIT_V(n) asm volatile("s_waitcnt vmcnt(" #n ")" ::: "memory")
#define PG8_WAIT_L(n) asm volatile("s_waitcnt lgkmcnt(" #n ")" ::: "memory")
#define PG8_BAR __builtin_amdgcn_s_barrier()
#define PG8_SCHED __builtin_amdgcn_sched_barrier(0)
#define PG8_AOFFS(VO, u) do { _Pragma("unroll") for (int _h = 0; _h < 2; ++_h) _Pragma("unroll") for (int _i = 0; _i < 2; ++_i) { \
        if constexpr (Sched::GATHER) VO[_h][_i] = (unsigned)S.row_src(u, _h * HALF + Rr[_i]) * (unsigned)RB + (unsigned)(Cc[_i] * 2); \
        else VO[_h][_i] = (unsigned)(Rr[_i] * RB + Cc[_i] * 2); } } while (0)
    Unit cur, nxt; int ui = 0;
    if (!S.next(0, cur)) return;
    unsigned voc[2][2], von[2][2];
    PG8_AOFFS(voc, cur);
    f32x4 acc[2][2][4][2];
#pragma unroll
    for (int a = 0; a < 2; ++a)
#pragma unroll
        for (int b = 0; b < 2; ++b)
#pragma unroll
            for (int m = 0; m < 4; ++m)
#pragma unroll
                for (int n = 0; n < 2; ++n) acc[a][b][m][n] = (f32x4){0.f, 0.f, 0.f, 0.f};
    bf16x8 At[4][2], B0[2][2], B1[2][2]; v8i_t At8[4], B08[2], B18[2];
    const char* cA = cur.A; const char* cB = cur.B;
    PG8_STAGE_B(PG8_SB(0, 0), cB, 0, 0); PG8_STAGE_A(PG8_SA(0, 0), cA, 0, 0, voc); PG8_STAGE_B(PG8_SB(0, 1), cB, 0, 1); PG8_STAGE_A(PG8_SA(0, 1), cA, 0, 1, voc);
    if (wr == 1) PG8_BAR;
    PG8_WAIT_V(4); PG8_BAR;
    PG8_STAGE_B(PG8_SB(1, 0), cB, kstep, 0); PG8_STAGE_A(PG8_SA(1, 0), cA, kstep, 0, voc); PG8_STAGE_B(PG8_SB(1, 1), cB, kstep, 1);
    PG8_WAIT_V(6); PG8_BAR;
    for (;;) {
        const bool has_next = S.next(ui + 1, nxt);
        if constexpr (Sched::GATHER) {
            if (has_next) { PG8_AOFFS(von, nxt); }
            else {
#pragma unroll
                for (int _h = 0; _h < 2; ++_h)
#pragma unroll
                    for (int _i = 0; _i < 2; ++_i) von[_h][_i] = voc[_h][_i];
            }
        }
        const char* nA = has_next ? nxt.A : cA; const char* nB = has_next ? nxt.B : cB;
        for (int t = 0; t < nt; t += 2) {
            const bool last = (t == nt - 2);
            const size_t k1 = (size_t)(t + 1) * kstep;
            const char* a2 = last ? nA : cA; const char* b2 = last ? nB : cB;
            const size_t k2 = last ? 0 : (size_t)(t + 2) * kstep, k3 = k2 + kstep;
            unsigned vo2[2][2];
#pragma unroll
            for (int _h = 0; _h < 2; ++_h)
#pragma unroll
                for (int _i = 0; _i < 2; ++_i) { if constexpr (Sched::GATHER) vo2[_h][_i] = last ? von[_h][_i] : voc[_h][_i]; else vo2[_h][_i] = voc[_h][_i]; }
            PG8_LDB(B0, 0, 0); PG8_SCHED; PG8_LDA(At, 0, 0); PG8_STAGE_A(PG8_SA(1, 1), cA, k1, 1, voc);
            PG8_WAIT_L(8); PG8_BAR; PG8_WAIT_L(0); PG8_MMA(0, 0, At, B0); PG8_BAR; PG8_SCHED;
            PG8_LDB(B1, 0, 1); PG8_STAGE_B(PG8_SB(0, 0), b2, k2, 0);
            PG8_BAR; PG8_WAIT_L(0); PG8_MMA(0, 1, At, B1); PG8_BAR;
            PG8_LDA(At, 0, 1); PG8_STAGE_A(PG8_SA(0, 0), a2, k2, 0, vo2);
            PG8_BAR; PG8_WAIT_L(0); PG8_MMA(1, 0, At, B0); PG8_BAR; PG8_SCHED;
            PG8_STAGE_B(PG8_SB(0, 1), b2, k2, 1);
            PG8_WAIT_V(6); PG8_BAR; PG8_MMA(1, 1, At, B1); PG8_BAR;
            PG8_LDB(B0, 1, 0); PG8_SCHED; PG8_LDA(At, 1, 0); PG8_STAGE_A(PG8_SA(0, 1), a2, k2, 1, vo2);
            PG8_WAIT_L(8); PG8_BAR; PG8_WAIT_L(0); PG8_MMA(0, 0, At, B0); PG8_BAR; PG8_SCHED;
            PG8_LDB(B1, 1, 1); PG8_STAGE_B(PG8_SB(1, 0), b2, k3, 0);
            PG8_BAR; PG8_WAIT_L(0); PG8_MMA(0, 1, At, B1); PG8_BAR;
            PG8_LDA(At, 1, 1); PG8_STAGE_A(PG8_SA(1, 0), a2, k3, 0, vo2);
            PG8_BAR; PG8_WAIT_L(0); PG8_MMA(1, 0, At, B0); PG8_BAR; PG8_SCHED;
            PG8_STAGE_B(PG8_SB(1, 1), b2, k3, 1);
            PG8_WAIT_V(6); PG8_BAR; PG8_MMA(1, 1, At, B1); PG8_BAR;
        }
        if constexpr (FP8) asm volatile("s_nop 15\n\ts_nop 15" ::: "memory");
        E(acc, cur, wr, wc, fr, fq);
        if (!has_next) break;
#pragma unroll
        for (int a = 0; a < 2; ++a)
#pragma unroll
            for (int b = 0; b < 2; ++b)
#pragma unroll
                for (int m = 0; m < 4; ++m)
#pragma unroll
                    for (int n = 0; n < 2; ++n) acc[a][b][m][n] = (f32x4){0.f, 0.f, 0.f, 0.f};
        cur = nxt; cA = nA; cB = nB; ++ui;
        if constexpr (Sched::GATHER) {
#pragma unroll
            for (int _h = 0; _h < 2; ++_h)
#pragma unroll
                for (int _i = 0; _i < 2; ++_i) voc[_h][_i] = von[_h][_i];
        }
    }
    PG8_WAIT_V(0);
    if (wr == 0) PG8_BAR;
    PG8_BAR;
#undef PG8_SA
#undef PG8_SB
#undef PG8_STAGE_A
#undef PG8_RS
#undef PG8_STAGE_B
#undef PG8_LDA
#undef PG8_LDB
#undef PG8_MMA
#undef PG8_WAIT_V
#undef PG8_WAIT_L
#undef PG8_BAR
#undef PG8_SCHED
#undef PG8_AOFFS
}

struct DenseOrder {
    static constexpr bool GATHER = false;
    const char* A; const char* Bt; int nM, nN, K, G, c;
    __device__ __forceinline__ bool next(int i, Unit& u) const {
        const int L = i * G + c; if (L >= nM * nN) return false;
        tile_order(L, nM, nN, u.pm, u.pn); u.e = 0;
        u.A = A + (size_t)u.pm * BM * K * 2; u.B = Bt + (size_t)u.pn * BM * K * 2; return true;
    }
    __device__ __forceinline__ int row_src(const Unit&, int) const { return 0; }
};
}
using pg8::Unit;

struct EpiProj {
    static constexpr bool PERM = true;
    bf16_t* O;
    __device__ __forceinline__ void operator()(const f32x4 (&acc)[2][2][4][2], const Unit& u, int wr, int wc, int fr, int fq) const {
#pragma unroll
        for (int ai = 0; ai < 2; ++ai)
#pragma unroll
            for (int m = 0; m < 4; ++m) { const int row = u.pm * 256 + ai * 128 + wr * 64 + m * 16 + fr;
#pragma unroll
                for (int bj = 0; bj < 2; ++bj) { const int col = u.pn * 256 + bj * 128 + wc * 32 + 8 * fq; const f32x4 v0 = acc[ai][bj][m][0], v1 = acc[ai][bj][m][1];
                    u32x4 o; o.x = pk2(v0.x, v0.y); o.y = pk2(v0.z, v0.w); o.z = pk2(v1.x, v1.y); o.w = pk2(v1.z, v1.w);
                    *(u32x4*)(O + (size_t)row * DINP + col) = o; } }
    }
};
struct EpiQ {
    static constexpr bool PERM = false;
    bf16_t* Q; const float* tab;
    __device__ __forceinline__ void operator()(const f32x4 (&acc)[2][2][4][2], const Unit& u, int wr, int wc, int fr, int fq) const {
        const float sc = 0.10206207261596577f * 1.4426950408889634f;
#pragma unroll
        for (int ai = 0; ai < 2; ++ai)
#pragma unroll
            for (int m = 0; m < 4; ++m) { const int row = u.pm * 256 + ai * 128 + wr * 64 + m * 16 + fr; const int b = row / SEQ, s = row % SEQ;
#pragma unroll
                for (int bj = 0; bj < 2; ++bj) { const int c0 = u.pn * 256 + bj * 128 + wc * 32; const int g32 = c0 >> 5; const int head = c0 / 96;
                    f32x4 v0 = acc[ai][bj][m][0], v1 = acc[ai][bj][m][1];
                    if (g32 % 3 == 2) {
                        const f32x4 cs = *(const f32x4*)(tab + (unsigned)(row * 32 + 4 * fq)), sn = *(const f32x4*)(tab + (unsigned)(row * 32 + 16 + 4 * fq));
                        const f32x4 r0 = v0 * cs - v1 * sn, r1 = v1 * cs + v0 * sn; v0 = r0; v1 = r1;
                    }
                    v0 = v0 * sc; v1 = v1 * sc;
                    bf16_t* base = Q + (unsigned)(((b * MH + head) * SEQ + s) * DQK + (c0 - head * 96) + 4 * fq);
                    u32x2 o0; o0.x = pk2(v0.x, v0.y); o0.y = pk2(v0.z, v0.w); *(u32x2*)(base) = o0;
                    u32x2 o1; o1.x = pk2(v1.x, v1.y); o1.y = pk2(v1.z, v1.w); *(u32x2*)(base + 16) = o1; }
                __builtin_amdgcn_sched_barrier(0); }
    }
};
struct EpiKV {
    static constexpr bool PERM = false;
    bf16_t* Kp; bf16_t* VT;
    __device__ __forceinline__ void operator()(const f32x4 (&acc)[2][2][4][2], const Unit& u, int wr, int wc, int fr, int fq) const {
#pragma unroll
        for (int ai = 0; ai < 2; ++ai)
#pragma unroll
            for (int m = 0; m < 4; ++m) { const int row = u.pm * 256 + ai * 128 + wr * 64 + m * 16 + fr; const int b = row / SEQ, s = row % SEQ;
#pragma unroll
                for (int bj = 0; bj < 2; ++bj) { const int c0 = u.pn * 256 + bj * 128 + wc * 32; const int head = c0 >> 7; const int w0 = c0 & 127;
#pragma unroll
                    for (int n = 0; n < 2; ++n) { const f32x4 v = acc[ai][bj][m][n]; const int within = w0 + 16 * n + 4 * fq;
                        if (within < 64) { u32x2 o; o.x = pk2(v.x, v.y); o.y = pk2(v.z, v.w); *(u32x2*)(Kp + ((size_t)(b * MH + head) * SEQ + s) * DQK + within) = o; }
                        else { bf16_t* vb = VT + ((size_t)(b * MH + head) * 64 + (within - 64)) * SEQ + perm16v(s);
                            vb[0] = (bf16_t)f2bf(v.x); vb[SEQ] = (bf16_t)f2bf(v.y); vb[2 * SEQ] = (bf16_t)f2bf(v.z); vb[3 * SEQ] = (bf16_t)f2bf(v.w); } } } }
    }
};
struct EpiX1 {
    static constexpr bool PERM = false;
    const float* x; float* X1;
    __device__ __forceinline__ void operator()(const f32x4 (&acc)[2][2][4][2], const Unit& u, int wr, int wc, int fr, int fq) const {
#pragma unroll
        for (int ai = 0; ai < 2; ++ai)
#pragma unroll
            for (int m = 0; m < 4; ++m) { const int row = u.pm * 256 + ai * 128 + wr * 64 + m * 16 + fr;
#pragma unroll
                for (int bj = 0; bj < 2; ++bj)
#pragma unroll
                    for (int n = 0; n < 2; ++n) { const size_t o = (size_t)row * D + u.pn * 256 + bj * 128 + wc * 32 + 16 * n + 4 * fq;
                        *(f32x4*)(X1 + o) = *(const f32x4*)(x + o) + acc[ai][bj][m][n]; } }
    }
};
struct EpiAct {
    static constexpr bool PERM = true;
    unsigned char* ACT; const float* b1;
    __device__ __forceinline__ void operator()(const f32x4 (&acc)[2][2][4][2], const Unit& u, int wr, int wc, int fr, int fq) const {
        const float* bb = b1 + (size_t)u.e * 2048;
#pragma unroll
        for (int bj = 0; bj < 2; ++bj) { const int col = u.pn * 256 + bj * 128 + wc * 32 + 8 * fq;
            const f32x4 bv0 = *(const f32x4*)(bb + col), bv1 = *(const f32x4*)(bb + col + 4);
#pragma unroll
            for (int ai = 0; ai < 2; ++ai)
#pragma unroll
                for (int m = 0; m < 4; ++m) { const int row = u.pm * 256 + ai * 128 + wr * 64 + m * 16 + fr;
                    const f32x4 v0 = acc[ai][bj][m][0] * 0.03125f + bv0, v1 = acc[ai][bj][m][1] * 0.03125f + bv1;
                    float g[4] = {v0.x, v0.z, v1.x, v1.z}, l[4] = {v0.y, v0.w, v1.y, v1.w}, a[4];
#pragma unroll
                    for (int i = 0; i < 4; ++i) { const float xg = fminf(g[i], 7.f), xl = fminf(fmaxf(l[i], -7.f), 7.f); a[i] = xg * sigmoidf_(1.702f * xg) * (xl + 1.f); }
                    *(unsigned*)(ACT + (unsigned)(row * DFF + (col >> 1))) = pk4_fp8(a[0], a[1], a[2], a[3]);
                    __builtin_amdgcn_sched_barrier(0); } }
    }
};
struct EpiY {
    static constexpr bool PERM = true;
    bf16_t* Y; const float* b2;
    __device__ __forceinline__ void operator()(const f32x4 (&acc)[2][2][4][2], const Unit& u, int wr, int wc, int fr, int fq) const {
        const float* bb = b2 + (size_t)u.e * 1024;
#pragma unroll
        for (int bj = 0; bj < 2; ++bj) { const int col = u.pn * 256 + bj * 128 + wc * 32 + 8 * fq;
            const f32x4 bv0 = *(const f32x4*)(bb + col), bv1 = *(const f32x4*)(bb + col + 4);
#pragma unroll
            for (int ai = 0; ai < 2; ++ai)
#pragma unroll
                for (int m = 0; m < 4; ++m) { const int row = u.pm * 256 + ai * 128 + wr * 64 + m * 16 + fr;
                    const f32x4 v0 = acc[ai][bj][m][0] * 0.03125f + bv0, v1 = acc[ai][bj][m][1] * 0.03125f + bv1;
                    u32x4 o; o.x = pk2(v0.x, v0.y); o.y = pk2(v0.z, v0.w); o.z = pk2(v1.x, v1.y); o.w = pk2(v1.z, v1.w);
                    *(u32x4*)(Y + (size_t)row * D + col) = o;
                    __builtin_amdgcn_sched_barrier(0); } }
    }
};

struct MoeOrder1 {
    static constexpr bool GATHER = false;
    const char* XG; const char* W1T; const LAS int* tstart; int G, c;
    __device__ __forceinline__ bool next(int i, Unit& u) const {
        const int L = i * G + c; const int ntile = __builtin_amdgcn_readfirstlane(tstart[NE]); if (L >= ntile * 8) return false;
        u.pm = L >> 3; u.pn = L & 7; int e = 0;
#pragma unroll 1
        for (int j = 1; j < NE; ++j) e = (tstart[j] <= u.pm) ? j : e;
        e = __builtin_amdgcn_readfirstlane(e);
        u.e = e; u.A = XG + (size_t)u.pm * 256 * 1024; u.B = W1T + ((size_t)e * 2048 + (size_t)u.pn * 256) * 1024; return true;
    }
    __device__ __forceinline__ int row_src(const Unit&, int) const { return 0; }
};
struct MoeOrder2 {
    static constexpr bool GATHER = false;
    const char* ACT; const char* W2T; const LAS int* tstart; int G, c;
    __device__ __forceinline__ bool next(int i, Unit& u) const {
        const int L = i * G + c; const int ntile = __builtin_amdgcn_readfirstlane(tstart[NE]); if (L >= ntile * 4) return false;
        u.pm = L >> 2; u.pn = L & 3; int e = 0;
#pragma unroll 1
        for (int j = 1; j < NE; ++j) e = (tstart[j] <= u.pm) ? j : e;
        e = __builtin_amdgcn_readfirstlane(e);
        u.e = e; u.A = ACT + (size_t)u.pm * 256 * 1024; u.B = W2T + ((size_t)e * 1024 + (size_t)u.pn * 256) * 1024; return true;
    }
    __device__ __forceinline__ int row_src(const Unit&, int) const { return 0; }
};

__device__ __forceinline__ void transpose_tile(const float* W, int K, int N, bf16_t* WT, int kb, int nb, unsigned char* smem, int tid) {
    float* tile = (float*)smem;
    const int k0 = 64 * kb, n0 = 256 * nb, n4 = tid & 63, kr = tid >> 6;
    f32x4 v[8];
#pragma unroll
    for (int i = 0; i < 8; ++i) { const int k = kr + 8 * i; v[i] = (n0 + 4 * n4 < N) ? *(const f32x4*)(W + (size_t)(k0 + k) * N + n0 + 4 * n4) : (f32x4){0.f, 0.f, 0.f, 0.f}; }
    __syncthreads();
#pragma unroll
    for (int i = 0; i < 8; ++i) { const int k = kr + 8 * i; *(f32x4*)(tile + k * 260 + ((4 * n4) ^ (8 * (k >> 3)))) = v[i]; }
    __syncthreads();
#pragma unroll
    for (int j = 0; j < 4; ++j) { const int c = tid + 512 * j, n = c >> 3, kc = c & 7; const float* src = tile + (8 * kc) * 260 + (n ^ (8 * kc));
        u32x4 o; o.x = pk2(src[0], src[260]); o.y = pk2(src[2 * 260], src[3 * 260]); o.z = pk2(src[4 * 260], src[5 * 260]); o.w = pk2(src[6 * 260], src[7 * 260]);
        *(u32x4*)(WT + (size_t)(n0 + n) * K + k0 + 8 * kc) = o; }
}
__device__ __forceinline__ void transpose_tile_fp8(const float* W, int K, int N, unsigned char* WT, int kb, int nb, float scale, unsigned char* smem, int tid) {
    float* tile = (float*)smem;
    const int k0 = 64 * kb, n0 = 256 * nb, n4 = tid & 63, kr = tid >> 6;
    f32x4 v[8];
#pragma unroll
    for (int i = 0; i < 8; ++i) { const int k = kr + 8 * i; v[i] = *(const f32x4*)(W + (size_t)(k0 + k) * N + n0 + 4 * n4) * scale; }
    __syncthreads();
#pragma unroll
    for (int i = 0; i < 8; ++i) { const int k = kr + 8 * i; *(f32x4*)(tile + k * 260 + ((4 * n4) ^ (8 * (k >> 3)))) = v[i]; }
    __syncthreads();
#pragma unroll
    for (int j = 0; j < 2; ++j) { const int c = tid + 512 * j, n = c >> 2, kc = c & 3;
        const float* s0 = tile + (16 * kc) * 260 + (n ^ (8 * (2 * kc))); const float* s1 = tile + (16 * kc + 8) * 260 + (n ^ (8 * (2 * kc + 1)));
        u32x4 o; o.x = pk4_fp8(s0[0], s0[260], s0[2 * 260], s0[3 * 260]); o.y = pk4_fp8(s0[4 * 260], s0[5 * 260], s0[6 * 260], s0[7 * 260]);
        o.z = pk4_fp8(s1[0], s1[260], s1[2 * 260], s1[3 * 260]); o.w = pk4_fp8(s1[4 * 260], s1[5 * 260], s1[6 * 260], s1[7 * 260]);
        *(u32x4*)(WT + (size_t)(n0 + n) * K + k0 + 16 * kc) = o; }
}
constexpr int TT_OUT = 64, TT_W1 = 128, TT_W2 = 64, TT_TOTAL = TT_OUT + NE * TT_W1 + NE * TT_W2;
__device__ __forceinline__ void late_transpose_item(const Params& P, unsigned char* smem, int it, int tid) {
    unsigned char* ws = P.ws;
    if (it < TT_OUT) { transpose_tile(P.w_out, D, D, (bf16_t*)(ws + WS_WOUT), it >> 2, it & 3, smem, tid); return; }
    it -= TT_OUT;
    if (it < NE * TT_W1) { const int e = it >> 7, r = it & 127; transpose_tile_fp8(P.w1 + (size_t)e * D * 2048, D, 2048, ws + WS_W1 + (size_t)e * 2048 * D, r >> 3, r & 7, 32.f, smem, tid); return; }
    it -= NE * TT_W1;
    { const int e = it >> 6, r = it & 63; transpose_tile_fp8(P.w2 + (size_t)e * DFF * D, DFF, D, ws + WS_W2 + (size_t)e * D * DFF, r >> 2, r & 3, 32.f, smem, tid); }
}

__device__ __forceinline__ void phase0(const Params& P, unsigned char* smem) {
    unsigned char* ws = P.ws;
    const int tid_ = opaque_tid(), lane = tid_ & 63, wave = tid_ >> 6, gw = blockIdx.x * NWAVES + wave, ngw = gridDim.x * NWAVES;
    float* slab = (float*)(smem + 73728);
    for (int i = tid_; i < 1024 * 8; i += NTHREADS) slab[i] = P.w_in[(size_t)(i >> 3) * DIN + 2048 + (i & 7)];
    __syncthreads();
    bf16_t* H = (bf16_t*)(ws + WS_H); float* AB = (float*)(ws + WS_AB);
    for (int row = gw; row < T; row += ngw) {
        const f32x4* xr = (const f32x4*)(P.x + (size_t)row * D) + lane;
        f32x4 v[4]; float ss = 0.f;
#pragma unroll
        for (int j = 0; j < 4; ++j) { v[j] = xr[64 * j]; ss += v[j].x * v[j].x + v[j].y * v[j].y + v[j].z * v[j].z + v[j].w * v[j].w; }
        const float rstd = rsqrtf(wave_sum(ss) * (1.f / D) + EPS);
        float acc[8];
#pragma unroll
        for (int c = 0; c < 8; ++c) acc[c] = 0.f;
#pragma unroll
        for (int j = 0; j < 4; ++j) {
            const f32x4 w = *((const f32x4*)P.norm_mix_w + lane + 64 * j);
            v[j] = v[j] * rstd * w;
            u32x2 o; o.x = pk2(v[j].x, v[j].y); o.y = pk2(v[j].z, v[j].w);
            *((u32x2*)(H + (size_t)row * D) + lane + 64 * j) = o;
#pragma unroll
            for (int i = 0; i < 4; ++i) { const float* sw = slab + (size_t)(4 * lane + 256 * j + i) * 8; const f32x4 w0 = *(const f32x4*)sw, w1 = *(const f32x4*)(sw + 4); const float hv = v[j][i];
                acc[0] += hv * w0.x; acc[1] += hv * w0.y; acc[2] += hv * w0.z; acc[3] += hv * w0.w; acc[4] += hv * w1.x; acc[5] += hv * w1.y; acc[6] += hv * w1.z; acc[7] += hv * w1.w; }
        }
#pragma unroll
        for (int c = 0; c < 8; ++c) acc[c] = wave_sum(acc[c]);
        if (lane == 0) { *(f32x4*)(AB + (size_t)row * 8) = (f32x4){acc[0], acc[1], acc[2], acc[3]}; *(f32x4*)(AB + (size_t)row * 8 + 4) = (f32x4){acc[4], acc[5], acc[6], acc[7]}; }
    }
    __syncthreads();
    for (int it = blockIdx.x; it < 210; it += gridDim.x) {
        if (it < 176) transpose_tile(P.w_in, D, DIN, (bf16_t*)(ws + WS_WIN), it / 11, it % 11, smem, tid_);
        else if (it < 194) transpose_tile(P.w_uq, QL, 768, (bf16_t*)(ws + WS_WUQ), (it - 176) / 3, (it - 176) % 3, smem, tid_);
        else transpose_tile(P.w_ukv, KVL, 1024, (bf16_t*)(ws + WS_WUKV), (it - 194) >> 2, (it - 194) & 3, smem, tid_);
    }
}

__constant__ float c_inv_freq[16] = {1.0f, 0.5623413324356079f, 0.3162277638912201f, 0.17782793939113617f, 0.10000000149011612f, 0.05623413249850273f, 0.03162277489900589f,
    0.017782794311642647f, 0.009999999776482582f, 0.005623413249850273f, 0.003162277629598975f, 0.0017782794311642647f, 0.0010000000474974513f, 0.000562341301701963f,
    0.0003162277571391314f, 0.00017782794020604342f};
__device__ __forceinline__ void phase2a(const Params& P) {
    unsigned char* ws = P.ws;
    const int tid_ = opaque_tid(), lane = tid_ & 63, gw = blockIdx.x * NWAVES + (tid_ >> 6), ngw = gridDim.x * NWAVES;
    const bf16_t* PROJ = (const bf16_t*)(ws + WS_PROJ); bf16_t* CQN = (bf16_t*)(ws + WS_CQN); bf16_t* CKVN = (bf16_t*)(ws + WS_CKVN);
    bf16_t* Kp = (bf16_t*)(ws + WS_K); float* tab = (float*)(ws + WS_TAB);
    for (int row = gw; row < T; row += ngw) {
        const bf16_t* pr = PROJ + (size_t)row * DINP; const int b = row / SEQ, s = row % SEQ;
        {
            unsigned a[3]; float ss = 0.f;
#pragma unroll
            for (int j = 0; j < 3; ++j) { a[j] = *(const unsigned*)(pr + C_CQ + 2 * (lane + 64 * j)); const float lo = bflo(a[j]), hi = bfhi(a[j]); ss += lo * lo + hi * hi; }
            const float rstd = rsqrtf(wave_sum(ss) * (1.f / QL) + EPS);
#pragma unroll
            for (int j = 0; j < 3; ++j) { const int idx = 2 * (lane + 64 * j); *(unsigned*)(CQN + (size_t)row * QL + idx) = pk2(bflo(a[j]) * rstd * P.q_norm_w[idx], bfhi(a[j]) * rstd * P.q_norm_w[idx + 1]); }
        }
        {
            unsigned a[2]; float ss = 0.f;
#pragma unroll
            for (int j = 0; j < 2; ++j) { a[j] = *(const unsigned*)(pr + C_CKV + 2 * (lane + 64 * j)); const float lo = bflo(a[j]), hi = bfhi(a[j]); ss += lo * lo + hi * hi; }
            const float rstd = rsqrtf(wave_sum(ss) * (1.f / KVL) + EPS);
#pragma unroll
            for (int j = 0; j < 2; ++j) { const int idx = 2 * (lane + 64 * j); *(unsigned*)(CKVN + (size_t)row * KVL + idx) = pk2(bflo(a[j]) * rstd * P.kv_norm_w[idx], bfhi(a[j]) * rstd * P.kv_norm_w[idx + 1]); }
        }
        if (lane < 16) {
            const float x1 = bf1(pr[C_KR + lane]), x2 = bf1(pr[C_KR + 16 + lane]);
            const float ang = (float)P.pos[row] * c_inv_freq[lane];
            double tt = (double)ang * 0.15915494309189535; tt -= floor(tt);
            if (tt > 0.5) tt -= 1.0;
            const float ar = (float)(tt * 6.283185307179586);
            const float cs = __cosf(ar), sn = __sinf(ar);
            tab[(size_t)row * 32 + lane] = cs; tab[(size_t)row * 32 + 16 + lane] = sn;
            const bf16_t o1 = (bf16_t)f2bf(x1 * cs - x2 * sn), o2 = (bf16_t)f2bf(x2 * cs + x1 * sn);
#pragma unroll
            for (int h = 0; h < MH; ++h) { bf16_t* kp = Kp + ((size_t)(b * MH + h) * SEQ + s) * DQK + 64; kp[lane] = o1; kp[16 + lane] = o2; }
        }
    }
}

__device__ __forceinline__ float softplusf_(float x) { return fmaxf(x, 0.f) + log1pf(__expf(-fabsf(x))); }
__device__ __forceinline__ void gdn_prep_item(const Params& P, unsigned char* smem, int item) {
    unsigned char* ws = P.ws;
    const int tid = opaque_tid(), wave = tid >> 6, lane = tid & 63;
    const int n = item % NCH, hh = (item / NCH) % GH, b = item / (NCH * GH);
    const bf16_t* PROJ = (const bf16_t*)(ws + WS_PROJ); const float* AB = (const float*)(ws + WS_AB);
    unsigned char* gp = ws + WS_GP + (size_t)item * GP_ITEM;
    float* Ug = (float*)(gp + GP_U); bf16_t* Wg = (bf16_t*)(gp + GP_W); bf16_t* QDg = (bf16_t*)(gp + GP_QD); bf16_t* KDTg = (bf16_t*)(gp + GP_KDT); bf16_t* QKg = (bf16_t*)(gp + GP_QK);
    float* qs = (float*)smem; float* ks = qs + 64 * 132; float* vs = ks + 64 * 132; float* Am = vs + 64 * 132;
    float* sbeta = Am + 64 * 68; float* sG = sbeta + 64; float* seG = sG + 64; float* sekd = seG + 64;
    __syncthreads();
    if (tid < 384) {
        const int cp = tid % 192, rg = tid / 192, which = (2 * cp) >> 7, cc = (2 * cp) & 127, gc = which * 512 + hh * 128 + cc;
        float w0[4], w1[4];
#pragma unroll
        for (int j = 0; j < 4; ++j) { w0[j] = P.conv_w[j * 1536 + gc]; w1[j] = P.conv_w[j * 1536 + gc + 1]; }
        float* dst = qs + which * (64 * 132);
        float xa[4] = {0.f, 0.f, 0.f, 0.f}, xb[4] = {0.f, 0.f, 0.f, 0.f};
        for (int rr = -3; rr < 32; ++rr) {
            const int r = 32 * rg + rr, t = 64 * n + r;
            unsigned u = 0u;
            if (t >= 0) u = *(const unsigned*)(PROJ + (size_t)(b * SEQ + t) * DINP + gc);
            xa[0] = xa[1]; xa[1] = xa[2]; xa[2] = xa[3]; xa[3] = bflo(u);
            xb[0] = xb[1]; xb[1] = xb[2]; xb[2] = xb[3]; xb[3] = bfhi(u);
            if (rr >= 0) {
                const float ya = w0[0] * xa[0] + w0[1] * xa[1] + w0[2] * xa[2] + w0[3] * xa[3];
                const float yb = w1[0] * xb[0] + w1[1] * xb[1] + w1[2] * xb[2] + w1[3] * xb[3];
                dst[r * 132 + cc] = ya * sigmoidf_(ya); dst[r * 132 + cc + 1] = yb * sigmoidf_(yb);
            }
        }
    } else if (tid >= 448) {
        const int r = lane; const size_t tok = (size_t)b * SEQ + 64 * n + r;
        const float a = AB[tok * 8 + hh], bb = AB[tok * 8 + 4 + hh];
        const float g = -__expf(P.a_log[hh]) * softplusf_(a + P.dt_bias[hh]);
        float G = g;
#pragma unroll
        for (int o = 1; o < 64; o <<= 1) { const float up = __shfl_up(G, o); if (lane >= o) G += up; }
        const float Gl = __shfl(G, 63);
        sbeta[r] = sigmoidf_(bb); sG[r] = G; seG[r] = __expf(G); sekd[r] = __expf(Gl - G);
        if (lane == 0) ((float*)(ws + WS_GT))[item] = __expf(Gl);
    }
    __syncthreads();
    for (int p = wave; p < 128; p += NWAVES) {
        const int which = p >> 6, r = p & 63; float* row = qs + which * (64 * 132) + r * 132;
        const float a0 = row[2 * lane], a1 = row[2 * lane + 1];
        const float ss = wave_sum(a0 * a0 + a1 * a1);
        const float sc = rsqrtf(ss + EPS) * (which == 0 ? 0.08838834764831845f : 1.f);
        row[2 * lane] = a0 * sc; row[2 * lane + 1] = a1 * sc;
    }
    for (int idx = tid; idx < 6 * 256; idx += NTHREADS) {
        const int u = idx >> 8, w = idx & 255; const int I = (u < 3) ? 0 : (u < 5 ? 1 : 2), J = (u < 3) ? u + 1 : (u < 5 ? u - 1 : 3);
        QKg[(16 * I + (w >> 4)) * 64 + perm32k(16 * J + (w & 15))] = 0;
    }
    __syncthreads();
    for (int job = wave; job < 20; job += NWAVES) {
        const int kind = job / 10, p = job % 10; const int I = (p < 1) ? 0 : (p < 3 ? 1 : (p < 6 ? 2 : 3)); const int J = p - (I * (I + 1)) / 2;
        const float* Ar = (kind ? qs : ks) + (16 * I + (lane & 15)) * 132 + (lane >> 4);
        const float* Br = ks + (16 * J + (lane & 15)) * 132 + (lane >> 4);
        f32x4 acc = {0.f, 0.f, 0.f, 0.f};
#pragma unroll 8
        for (int s = 0; s < 32; ++s) acc = __builtin_amdgcn_mfma_f32_16x16x4f32(Ar[4 * s], Br[4 * s], acc, 0, 0, 0);
        const int j = 16 * J + (lane & 15);
#pragma unroll
        for (int r = 0; r < 4; ++r) { const int i = 16 * I + 4 * (lane >> 4) + r;
            const float dec = (i >= j) ? __expf(sG[i] - sG[j]) : 0.f;
            if (kind == 0) Am[i * 68 + j] = (i > j) ? sbeta[i] * acc[r] * dec : 0.f;
            else QKg[i * 64 + perm32k(j)] = (bf16_t)f2bf((i >= j) ? acc[r] * dec : 0.f); }
    }
    __syncthreads();
    if (tid < 256) {
        const int c = tid; float X[64];
        const LAS float* AmL = (const LAS float*)Am; asm volatile("" : "+v"(AmL));
        const LAS float* scL = (const LAS float*)sbeta; asm volatile("" : "+v"(scL));
        const LAS float* rhsL = (c < 128) ? ((const LAS float*)vs + c) : ((const LAS float*)ks + (c - 128));
        const bool isw = (c >= 128);
#pragma unroll
        for (int i = 0; i < 64; ++i) {
            const float eg = isw ? scL[128 + i] : 1.f;
            float a0 = scL[i] * rhsL[i * 132] * eg, a1 = 0.f, a2 = 0.f, a3 = 0.f;
#pragma unroll
            for (int jb = 0; jb < (i + 3) / 4; ++jb) { const f32x4 av = *(const LAS f32x4*)(AmL + i * 68 + 4 * jb);
                if (4 * jb + 0 < i) a0 -= av.x * X[4 * jb + 0];
                if (4 * jb + 1 < i) a1 -= av.y * X[4 * jb + 1];
                if (4 * jb + 2 < i) a2 -= av.z * X[4 * jb + 2];
                if (4 * jb + 3 < i) a3 -= av.w * X[4 * jb + 3];
                if ((jb & 3) == 3) __builtin_amdgcn_sched_barrier(0); }
            X[i] = (a0 + a1) + (a2 + a3);
            asm volatile("" : "+v"(X[i]));
            __builtin_amdgcn_sched_barrier(0);
        }
        if (c < 128) {
            u32x2* u2 = (u32x2*)Ug + (c >> 4) * 256 + (c & 15);
#pragma unroll
            for (int q = 0; q < 16; ++q) { u32x2 o; o.x = pk2(X[4 * q], X[4 * q + 1]); o.y = pk2(X[4 * q + 2], X[4 * q + 3]); u2[(q >> 2) * 64 + (q & 3) * 16] = o; }
        } else { const int pd = perm32k(c - 128);
#pragma unroll
            for (int i = 0; i < 64; ++i) Wg[i * 128 + pd] = (bf16_t)f2bf(-X[i]);
        }
    } else {
        const int t2 = tid - 256;
        for (int idx = t2; idx < 64 * 128; idx += 256) { const int i = idx >> 7, d = idx & 127; QDg[i * 128 + perm32k(d)] = (bf16_t)f2bf(qs[i * 132 + d] * seG[i]); }
        for (int idx = t2; idx < 128 * 64; idx += 256) { const int d = idx >> 6, cc = idx & 63; KDTg[d * 64 + perm32k(cc)] = (bf16_t)f2bf(ks[cc * 132 + d] * sekd[cc]); }
    }
}

__device__ __forceinline__ void gdn_scan(const Params& P, unsigned char* smem, int bh) {
    unsigned char* ws = P.ws;
    const int tid = opaque_tid(), wave = tid >> 6, lane = tid & 63, e = lane & 15, g = lane >> 4;
    const float* GT = (const float*)(ws + WS_GT);
    constexpr int BUF = 36864, OW = 0, OKD = 18432;
    f32x4 S[8];
#pragma unroll
    for (int t = 0; t < 8; ++t) S[t] = (f32x4){0.f, 0.f, 0.f, 0.f};
    u32x4 st[2][4]; u32x2 un[2][4]; float gtn[2];
#define SCAN_GLOAD(p, n) do { const unsigned char* gp_ = ws + WS_GP + (size_t)(bh * NCH + (n)) * GP_ITEM; \
        _Pragma("unroll") for (int k = 0; k < 2; ++k) st[p][k] = *(const u32x4*)(gp_ + GP_W + (size_t)(tid + 512 * k) * 16); \
        _Pragma("unroll") for (int k = 0; k < 2; ++k) st[p][2 + k] = *(const u32x4*)(gp_ + GP_KDT + (size_t)(tid + 512 * k) * 16); \
        const u32x2* ug_ = (const u32x2*)(gp_ + GP_U) + wave * 256 + lane; \
        _Pragma("unroll") for (int m = 0; m < 4; ++m) un[p][m] = ug_[m * 64]; \
        gtn[p] = GT[bh * NCH + (n)]; } while (0)
#define SCAN_LWRITE(p, buf) do { unsigned char* L_ = smem + (buf) * BUF; \
        _Pragma("unroll") for (int k = 0; k < 2; ++k) { const int c = tid + 512 * k; *(u32x4*)(L_ + OW + (c >> 4) * 288 + (c & 15) * 16) = st[p][k]; } \
        _Pragma("unroll") for (int k = 0; k < 2; ++k) { const int c = tid + 512 * k; *(u32x4*)(L_ + OKD + (c >> 3) * 144 + (c & 7) * 16) = st[p][2 + k]; } } while (0)
    __syncthreads();
    SCAN_GLOAD(0, 0); SCAN_LWRITE(0, 0); SCAN_GLOAD(1, 1);
    __syncthreads();
    for (int n2 = 0; n2 < NCH; n2 += 2) {
#pragma unroll
      for (int p = 0; p < 2; ++p) {
        const int n = n2 + p;
        f32x4 av[4];
#pragma unroll
        for (int m = 0; m < 4; ++m) av[m] = (f32x4){bflo(un[p][m].x), bfhi(un[p][m].x), bflo(un[p][m].y), bfhi(un[p][m].y)};
        const float gt = gtn[p];
        if (n + 2 < NCH) SCAN_GLOAD(p, n + 2);
        const unsigned char* L = smem + p * BUF;
        bf16x8 Sb[4];
#pragma unroll
        for (int s = 0; s < 4; ++s) Sb[s] = pack8(S[2 * s], S[2 * s + 1]);
        {
            bf16x8* sb = (bf16x8*)(ws + WS_SB) + ((size_t)(bh * NCH + n) * 8 + wave) * 256 + lane;
#pragma unroll
            for (int s = 0; s < 4; ++s) sb[s * 64] = Sb[s];
        }
#pragma unroll
        for (int s = 0; s < 4; ++s)
#pragma unroll
            for (int m = 0; m < 4; ++m) {
                const bf16x8 wf = *(const bf16x8*)(L + OW + (16 * m + e) * 288 + (32 * s + 8 * g) * 2);
                av[m] = __builtin_amdgcn_mfma_f32_16x16x32_bf16(wf, Sb[s], av[m], 0, 0, 0);
            }
        bf16x8 Vb[2];
#pragma unroll
        for (int s = 0; s < 2; ++s) Vb[s] = pack8(av[2 * s], av[2 * s + 1]);
#pragma unroll
        for (int t = 0; t < 8; ++t) { S[t] = S[t] * gt;
#pragma unroll
            for (int s = 0; s < 2; ++s) {
                const bf16x8 df = *(const bf16x8*)(L + OKD + (16 * t + e) * 144 + (32 * s + 8 * g) * 2);
                S[t] = __builtin_amdgcn_mfma_f32_16x16x32_bf16(df, Vb[s], S[t], 0, 0, 0);
            } }
        if (n + 1 < NCH) SCAN_LWRITE(p ^ 1, p ^ 1);
        __syncthreads();
      }
    }
#undef SCAN_GLOAD
#undef SCAN_LWRITE
}

__device__ __forceinline__ void gdn_out_item(const Params& P, unsigned char* smem, int item) {
    unsigned char* ws = P.ws;
    const int tid = opaque_tid(), wave = tid >> 6, lane = tid & 63, e = lane & 15, g = lane >> 4;
    const int n = item % NCH, hh = (item / NCH) % GH, b = item / (NCH * GH);
    const unsigned char* gp = ws + WS_GP + (size_t)item * GP_ITEM;
    constexpr int OW = 0, OQD = 18432, OQK = 36864, OSS = 46080, ORS = OSS + 2048, OT = 49152;
    float* ssq = (float*)(smem + OSS); float* rs = (float*)(smem + ORS);
    u32x4 st[5];
#pragma unroll
    for (int k = 0; k < 2; ++k) st[k] = *(const u32x4*)(gp + GP_W + (size_t)(tid + 512 * k) * 16);
#pragma unroll
    for (int k = 0; k < 2; ++k) st[2 + k] = *(const u32x4*)(gp + GP_QD + (size_t)(tid + 512 * k) * 16);
    st[4] = *(const u32x4*)(gp + GP_QK + (size_t)tid * 16);
    bf16x8 Sb[4]; u32x2 un[4];
    {
        const bf16x8* sb = (const bf16x8*)(ws + WS_SB) + ((size_t)item * 8 + wave) * 256 + lane;
#pragma unroll
        for (int s = 0; s < 4; ++s) Sb[s] = sb[s * 64];
        const u32x2* ug = (const u32x2*)(gp + GP_U) + wave * 256 + lane;
#pragma unroll
        for (int m = 0; m < 4; ++m) un[m] = ug[m * 64];
    }
    __syncthreads();
#pragma unroll
    for (int k = 0; k < 2; ++k) { const int c = tid + 512 * k; *(u32x4*)(smem + OW + (c >> 4) * 288 + (c & 15) * 16) = st[k]; }
#pragma unroll
    for (int k = 0; k < 2; ++k) { const int c = tid + 512 * k; *(u32x4*)(smem + OQD + (c >> 4) * 288 + (c & 15) * 16) = st[2 + k]; }
    { const int c = tid; *(u32x4*)(smem + OQK + (c >> 3) * 144 + (c & 7) * 16) = st[4]; }
    __syncthreads();
    f32x4 av[4], ao[4];
#pragma unroll
    for (int m = 0; m < 4; ++m) { av[m] = (f32x4){bflo(un[m].x), bfhi(un[m].x), bflo(un[m].y), bfhi(un[m].y)}; ao[m] = (f32x4){0.f, 0.f, 0.f, 0.f}; }
#pragma unroll
    for (int s = 0; s < 4; ++s)
#pragma unroll
        for (int m = 0; m < 4; ++m) {
            const bf16x8 wf = *(const bf16x8*)(smem + OW + (16 * m + e) * 288 + (32 * s + 8 * g) * 2);
            const bf16x8 qf = *(const bf16x8*)(smem + OQD + (16 * m + e) * 288 + (32 * s + 8 * g) * 2);
            av[m] = __builtin_amdgcn_mfma_f32_16x16x32_bf16(wf, Sb[s], av[m], 0, 0, 0);
            ao[m] = __builtin_amdgcn_mfma_f32_16x16x32_bf16(qf, Sb[s], ao[m], 0, 0, 0);
        }
    bf16x8 Vb[2];
#pragma unroll
    for (int s = 0; s < 2; ++s) Vb[s] = pack8(av[2 * s], av[2 * s + 1]);
#pragma unroll
    for (int m = 0; m < 4; ++m)
#pragma unroll
        for (int s = 0; s < 2; ++s) {
            const bf16x8 kf = *(const bf16x8*)(smem + OQK + (16 * m + e) * 144 + (32 * s + 8 * g) * 2);
            ao[m] = __builtin_amdgcn_mfma_f32_16x16x32_bf16(kf, Vb[s], ao[m], 0, 0, 0);
        }
#pragma unroll
    for (int m = 0; m < 4; ++m)
#pragma unroll
        for (int r = 0; r < 4; ++r) { float q = ao[m][r] * ao[m][r];
            q += __shfl_xor(q, 1); q += __shfl_xor(q, 2); q += __shfl_xor(q, 4); q += __shfl_xor(q, 8);
            if (e == 0) ssq[wave * 64 + 16 * m + 4 * g + r] = q;
            *(bf16_t*)(smem + OT + (16 * m + 4 * g + r) * 272 + (16 * wave + e) * 2) = (bf16_t)f2bf(ao[m][r]); }
    __syncthreads();
    if (tid < 64) { float q = 0.f;
#pragma unroll
        for (int w = 0; w < 8; ++w) q += ssq[w * 64 + tid];
        rs[tid] = rsqrtf(q * (1.f / 128.f) + EPS); }
    __syncthreads();
    {
        const int row = tid >> 3, seg = tid & 7; const size_t tok = (size_t)b * SEQ + 64 * n + row;
        const u32x4* tp = (const u32x4*)(smem + OT + row * 272 + seg * 32);
        const u32x4 o0 = tp[0], o1 = tp[1];
        const u32x4* zp = (const u32x4*)((const bf16_t*)(ws + WS_PROJ) + tok * DINP + C_Z + hh * 128 + seg * 16);
        const u32x4 z0 = zp[0], z1 = zp[1];
        const float r_ = rs[row]; const float* gwp = P.gdn_norm_w + seg * 16;
        unsigned ov[8]; const unsigned oo[8] = {o0.x, o0.y, o0.z, o0.w, o1.x, o1.y, o1.z, o1.w}, zz[8] = {z0.x, z0.y, z0.z, z0.w, z1.x, z1.y, z1.z, z1.w};
#pragma unroll
        for (int i = 0; i < 8; ++i) { const float za = bflo(zz[i]), zb = bfhi(zz[i]);
            ov[i] = pk2(bflo(oo[i]) * r_ * gwp[2 * i] * za * sigmoidf_(za), bfhi(oo[i]) * r_ * gwp[2 * i + 1] * zb * sigmoidf_(zb)); }
        u32x4* op = (u32x4*)((bf16_t*)(ws + WS_OCAT) + tok * D + hh * 128 + seg * 16);
        op[0] = (u32x4){ov[0], ov[1], ov[2], ov[3]}; op[1] = (u32x4){ov[4], ov[5], ov[6], ov[7]};
    }
}

__device__ __forceinline__ void attn_item(const Params& P, unsigned char* smem, int item) {
    unsigned char* ws = P.ws;
    const int tid = opaque_tid(), wave = tid >> 6, lane = tid & 63, ql = lane & 31, hf = lane >> 5;
    const int qt = 15 - (item >> 5), bh = item & 31;
    const bf16_t* Qg = (const bf16_t*)(ws + WS_Q) + (size_t)bh * SEQ * DQK;
    const unsigned char* Kg = (const unsigned char*)((const bf16_t*)(ws + WS_K) + (size_t)bh * SEQ * DQK);
    const bf16_t* VTg = (const bf16_t*)(ws + WS_VT) + (size_t)bh * 64 * SEQ;
    bf16_t* OB = (bf16_t*)(ws + WS_OB);
    const int q0 = qt * 256 + 32 * wave;
    const int nkt_w = (q0 >> 6) + 1, nkt_b = 4 * qt + 4;
    constexpr int KB_ = 13312, VB_ = 9216, OK0 = 0, OV0 = 2 * KB_;
    bf16x8 qf[6];
#pragma unroll
    for (int ks = 0; ks < 6; ++ks) qf[ks] = *(const bf16x8*)(Qg + (size_t)(q0 + ql) * DQK + 16 * ks + 8 * hf);
    f32x16 o0, o1;
#pragma unroll
    for (int i = 0; i < 16; ++i) { o0[i] = 0.f; o1[i] = 0.f; }
    float mrun = -1e30f, lsum = 0.f;
    u32x4 sk0, sk1, sv;
    auto gload = [&](int kt) {
        const unsigned char* kp = Kg + (size_t)kt * 64 * DQK * 2;
        sk0 = *(const u32x4*)(kp + (size_t)tid * 16);
        if (tid < 256) sk1 = *(const u32x4*)(kp + (size_t)(tid + 512) * 16);
        sv = *(const u32x4*)(VTg + (size_t)(tid >> 3) * SEQ + kt * 64 + (tid & 7) * 8);
    };
    auto lwrite = [&](int buf) {
        { const int c = tid; *(u32x4*)(smem + OK0 + buf * KB_ + (c / 12) * 208 + (c % 12) * 16) = sk0; }
        if (tid < 256) { const int c = tid + 512; *(u32x4*)(smem + OK0 + buf * KB_ + (c / 12) * 208 + (c % 12) * 16) = sk1; }
        *(u32x4*)(smem + OV0 + buf * VB_ + (tid >> 3) * 144 + (tid & 7) * 16) = sv;
    };
    __syncthreads();
    gload(0); lwrite(0);
    __syncthreads();
    for (int kt = 0; kt < nkt_b; ++kt) {
        if (kt + 1 < nkt_b) gload(kt + 1);
        if (kt < nkt_w) {
            const unsigned char* Kl = smem + OK0 + (kt & 1) * KB_; const unsigned char* Vl = smem + OV0 + (kt & 1) * VB_;
            f32x16 s0, s1;
#pragma unroll
            for (int i = 0; i < 16; ++i) { s0[i] = 0.f; s1[i] = 0.f; }
#pragma unroll
            for (int ks = 0; ks < 6; ++ks) {
                const bf16x8 k0 = *(const bf16x8*)(Kl + ql * 208 + (16 * ks + 8 * hf) * 2);
                const bf16x8 k1 = *(const bf16x8*)(Kl + (32 + ql) * 208 + (16 * ks + 8 * hf) * 2);
                s0 = __builtin_amdgcn_mfma_f32_32x32x16_bf16(k0, qf[ks], s0, 0, 0, 0);
                s1 = __builtin_amdgcn_mfma_f32_32x32x16_bf16(k1, qf[ks], s1, 0, 0, 0);
            }
            float mx = s0[0];
#pragma unroll
            for (int i = 1; i < 16; ++i) mx = fmaxf(mx, s0[i]);
#pragma unroll
            for (int i = 0; i < 16; ++i) mx = fmaxf(mx, s1[i]);
            mx = fmaxf(mx, __shfl_xor(mx, 32));
            const float mnew = fmaxf(mrun, mx), alpha = __builtin_amdgcn_exp2f(mrun - mnew);
            mrun = mnew;
            float ps = 0.f;
#pragma unroll
            for (int i = 0; i < 16; ++i) { s0[i] = __builtin_amdgcn_exp2f(s0[i] - mnew); s1[i] = __builtin_amdgcn_exp2f(s1[i] - mnew); ps += s0[i] + s1[i]; }
            lsum = lsum * alpha + ps;
#pragma unroll
            for (int i = 0; i < 16; ++i) { o0[i] *= alpha; o1[i] *= alpha; }
            bf16x8 pb[2][2];
#pragma unroll
            for (int sp = 0; sp < 2; ++sp) {
                pb[0][sp] = pack8((f32x4){s0[8 * sp], s0[8 * sp + 1], s0[8 * sp + 2], s0[8 * sp + 3]}, (f32x4){s0[8 * sp + 4], s0[8 * sp + 5], s0[8 * sp + 6], s0[8 * sp + 7]});
                pb[1][sp] = pack8((f32x4){s1[8 * sp], s1[8 * sp + 1], s1[8 * sp + 2], s1[8 * sp + 3]}, (f32x4){s1[8 * sp + 4], s1[8 * sp + 5], s1[8 * sp + 6], s1[8 * sp + 7]});
            }
#pragma unroll
            for (int u = 0; u < 2; ++u)
#pragma unroll
                for (int sp = 0; sp < 2; ++sp) {
                    const bf16x8 v0 = *(const bf16x8*)(Vl + ql * 144 + (32 * u + 16 * sp + 8 * hf) * 2);
                    const bf16x8 v1 = *(const bf16x8*)(Vl + (32 + ql) * 144 + (32 * u + 16 * sp + 8 * hf) * 2);
                    o0 = __builtin_amdgcn_mfma_f32_32x32x16_bf16(v0, pb[u][sp], o0, 0, 0, 0);
                    o1 = __builtin_amdgcn_mfma_f32_32x32x16_bf16(v1, pb[u][sp], o1, 0, 0, 0);
                }
        }
        if (kt + 1 < nkt_b) lwrite((kt + 1) & 1);
        __syncthreads();
    }
    lsum += __shfl_xor(lsum, 32);
    const float inv = 1.f / lsum;
    const int b = bh >> 3, h = bh & 7;
    bf16_t* orow = OB + ((size_t)b * SEQ + q0 + ql) * 512 + h * 64;
#pragma unroll
    for (int r = 0; r < 16; ++r) { const int dv = (r & 3) + 8 * (r >> 2) + 4 * hf; orow[dv] = (bf16_t)f2bf(o0[r] * inv); orow[32 + dv] = (bf16_t)f2bf(o1[r] * inv); }
}

__device__ __forceinline__ void phase5(const Params& P) {
    unsigned char* ws = P.ws;
    const int tid_ = opaque_tid(), lane = tid_ & 63, gw = blockIdx.x * NWAVES + (tid_ >> 6), ngw = gridDim.x * NWAVES;
    const bf16_t* OB = (const bf16_t*)(ws + WS_OB); bf16_t* OCAT = (bf16_t*)(ws + WS_OCAT);
    for (int tq = gw; tq < T / 4; tq += ngw) {
        const int t0 = 4 * tq;
#pragma unroll
        for (int r = 0; r < 4; ++r) {
            const size_t row = (size_t)t0 + r;
            const u32x4 v = *((const u32x4*)(OB + row * 512) + lane);
            float f[8] = {bflo(v.x), bfhi(v.x), bflo(v.y), bfhi(v.y), bflo(v.z), bfhi(v.z), bflo(v.w), bfhi(v.w)};
            float ss = 0.f;
#pragma unroll
            for (int i = 0; i < 8; ++i) ss += f[i] * f[i];
            const float rstd = rsqrtf(wave_sum(ss) * (1.f / 512.f) + EPS);
            const float* wn = P.mla_out_norm_w + 8 * lane;
            u32x4 o; o.x = pk2(f[0] * rstd * wn[0], f[1] * rstd * wn[1]); o.y = pk2(f[2] * rstd * wn[2], f[3] * rstd * wn[3]); o.z = pk2(f[4] * rstd * wn[4], f[5] * rstd * wn[5]); o.w = pk2(f[6] * rstd * wn[6], f[7] * rstd * wn[7]);
            *((u32x4*)(OCAT + row * D + 512) + lane) = o;
        }
    }
}

__device__ __forceinline__ void phase7(const Params& P, unsigned char* smem) {
    unsigned char* ws = P.ws;
    const int tid = opaque_tid(), wave = tid >> 6, lane = tid & 63;
    float* rw = (float*)smem;
    int* lctl = (int*)(smem + LDS_MISC + 256);
    float* lgs = (float*)(smem + LDS_MISC + 256 + 2560);
    for (int i = tid; i < 1024 * 8; i += NTHREADS) { const int k = i >> 3, c = i & 7; const f32x4 v = *(const f32x4*)(P.router_w + (size_t)k * 32 + 4 * c) * P.norm_ffn_w[k];
        *(f32x4*)(rw + k * 32 + ((4 * c + 16 * ((k >> 2) & 1)) & 31)) = v; }
    const float* X1 = (const float*)(ws + WS_X1); unsigned char* H2 = ws + WS_H;
    int* tok_e = (int*)(ws + WS_TOKE); int* tok_r = (int*)(ws + WS_TOKR); float* gate = (float*)(ws + WS_GATE);
    unsigned* cnt = (unsigned*)(ws + WS_CTL) + CW_CNT;
    for (int tg = blockIdx.x; tg < T / 64; tg += gridDim.x) {
    __syncthreads();
    if (tid < 64) lctl[tid] = 0;
    __syncthreads();
    if (wave < 4) {
        const int ti = lane & 15, kk = lane >> 4; const int row = tg * 64 + wave * 16 + ti;
        const f32x4* xr = (const f32x4*)(X1 + (size_t)row * D) + kk;
        const float* bw = rw + (4 * kk) * 32 + (((lane & 15) + 16 * (kk & 1)) & 31);
        f32x4 a0 = {0.f, 0.f, 0.f, 0.f}, a1 = {0.f, 0.f, 0.f, 0.f}; float ss = 0.f;
#pragma unroll 1
        for (int sb = 0; sb < 64; sb += 8) {
            f32x4 xv[8];
#pragma unroll
            for (int u = 0; u < 8; ++u) xv[u] = xr[4 * (sb + u)];
#pragma unroll
            for (int u = 0; u < 8; ++u) { ss += xv[u].x * xv[u].x + xv[u].y * xv[u].y + xv[u].z * xv[u].z + xv[u].w * xv[u].w;
#pragma unroll
                for (int j = 0; j < 4; ++j) { const float* bp = bw + (16 * (sb + u) + j) * 32; const float b0 = bp[0], b1 = *(const float*)((const char*)bp + ((((lane & 15) + 16 * (kk & 1)) & 16) ? -64 : 64));
                    a0 = __builtin_amdgcn_mfma_f32_16x16x4f32(xv[u][j], b0, a0, 0, 0, 0);
                    a1 = __builtin_amdgcn_mfma_f32_16x16x4f32(xv[u][j], b1, a1, 0, 0, 0); } }
        }
        ss += __shfl_xor(ss, 16); ss += __shfl_xor(ss, 32);
        const float rstd = rsqrtf(ss * (1.f / D) + EPS);
        float* lg = lgs + wave * (16 * 33);
#pragma unroll
        for (int r = 0; r < 4; ++r) { const int t = 4 * kk + r; const float rs = __shfl(rstd, t);
            lg[t * 33 + (lane & 15)] = a0[r] * rs + P.router_b[lane & 15]; lg[t * 33 + 16 + (lane & 15)] = a1[r] * rs + P.router_b[16 + (lane & 15)]; }
        asm volatile("s_waitcnt lgkmcnt(0)" ::: "memory");
        if (lane < 16) {
            const float* l = lg + lane * 33; const int trow = tg * 64 + wave * 16 + lane;
            int ei[4]; float ev[4];
#pragma unroll
            for (int k = 0; k < 4; ++k) { float best = -3.0e38f; int bi = 0;
                for (int j = 0; j < 32; ++j) { const float v = l[j]; const bool taken = (k > 0 && ei[0] == j) || (k > 1 && ei[1] == j) || (k > 2 && ei[2] == j); if (!taken && v > best) { best = v; bi = j; } }
                ei[k] = bi; ev[k] = best; }
            float gs = 0.f, gv[4];
#pragma unroll
            for (int k = 0; k < 4; ++k) { gv[k] = __expf(ev[k] - ev[0]); gs += gv[k]; }
            const float ig = 1.f / gs;
#pragma unroll
            for (int k = 0; k < 4; ++k) { const int lr = atomicAdd(&lctl[ei[k]], 1);
                lctl[64 + ((wave * 16 + lane) * 4 + k) * 2] = ei[k]; lctl[64 + ((wave * 16 + lane) * 4 + k) * 2 + 1] = lr; }
            *(f32x4*)(gate + (size_t)trow * 4) = (f32x4){gv[0] * ig, gv[1] * ig, gv[2] * ig, gv[3] * ig};
        }
    } else {
        for (int ti = 0; ti < 16; ++ti) { const int row = tg * 64 + (wave - 4) * 16 + ti;
            f32x4 v[4]; float ss = 0.f;
#pragma unroll
            for (int j = 0; j < 4; ++j) { v[j] = *((const f32x4*)(X1 + (size_t)row * D) + lane + 64 * j); ss += v[j].x * v[j].x + v[j].y * v[j].y + v[j].z * v[j].z + v[j].w * v[j].w; }
            const float rstd = rsqrtf(wave_sum(ss) * (1.f / D) + EPS);
#pragma unroll
            for (int j = 0; j < 4; ++j) { const f32x4 h = v[j] * rstd * *((const f32x4*)P.norm_ffn_w + lane + 64 * j);
                *((unsigned*)(H2 + (size_t)row * D) + lane + 64 * j) = pk4_fp8(h.x, h.y, h.z, h.w); }
        }
    }
    __syncthreads();
    if (tid < 32) lctl[32 + tid] = (int)atomicAdd(&cnt[tid], (unsigned)lctl[tid]);
    __syncthreads();
    if (tid < 256) { const int e = lctl[64 + tid * 2], lr = lctl[64 + tid * 2 + 1]; const int row = tg * 64 + (tid >> 2); const int rank = lctl[32 + e] + lr;
        tok_e[(size_t)row * 4 + (tid & 3)] = e; tok_r[(size_t)row * 4 + (tid & 3)] = rank; }
    }
}

__device__ __forceinline__ void moe_tiles(const Params& P, unsigned char* smem) {
    int* tstart = (int*)(smem + LDS_MISC + 256); int* cntl = tstart + 64;
    const unsigned* cnt = (const unsigned*)(P.ws + WS_CTL) + CW_CNT;
    __syncthreads();
    if (threadIdx.x == 0) { int acc = 0; for (int e = 0; e < NE; ++e) { const int c = (int)__hip_atomic_load(&cnt[e], __ATOMIC_RELAXED, __HIP_MEMORY_SCOPE_AGENT); cntl[e] = c; tstart[e] = acc; acc += (c + 255) >> 8; } tstart[NE] = acc; }
    __syncthreads();
}

__device__ __forceinline__ void phase8(const Params& P, unsigned char* smem) {
    unsigned char* ws = P.ws;
    const int tid_ = opaque_tid(), lane = tid_ & 63, gw = blockIdx.x * NWAVES + (tid_ >> 6), ngw = gridDim.x * NWAVES;
    const int* tstart = (const int*)(smem + LDS_MISC + 256);
    const int* tok_e = (const int*)(ws + WS_TOKE); const int* tok_r = (const int*)(ws + WS_TOKR);
    const unsigned char* H2 = ws + WS_H; unsigned char* XG = ws + WS_XG;
    for (int row = gw; row < T; row += ngw) {
        const u32x4 v = *((const u32x4*)(H2 + (size_t)row * D) + lane);
#pragma unroll
        for (int k = 0; k < 4; ++k) { const int e = tok_e[(size_t)row * 4 + k], rk = tok_r[(size_t)row * 4 + k];
            *((u32x4*)(XG + (size_t)(tstart[e] * 256 + rk) * D) + lane) = v; }
    }
}

__device__ __forceinline__ void phase11(const Params& P, unsigned char* smem) {
    unsigned char* ws = P.ws;
    const int tid_ = opaque_tid(), lane = tid_ & 63, gw = blockIdx.x * NWAVES + (tid_ >> 6), ngw = gridDim.x * NWAVES;
#if LEVEL >= 2
    const float* X1 = (const float*)(ws + WS_X1);
#else
    const float* X1 = P.x;
#endif
#if LEVEL >= 4
    const int* tstart = (const int*)(smem + LDS_MISC + 256);
    const int* tok_e = (const int*)(ws + WS_TOKE); const int* tok_r = (const int*)(ws + WS_TOKR); const float* gate = (const float*)(ws + WS_GATE); const bf16_t* Y = (const bf16_t*)(ws + WS_Y);
#endif
    for (int row = gw; row < T; row += ngw) {
        f32x4 v[4];
#pragma unroll
        for (int j = 0; j < 4; ++j) v[j] = *((const f32x4*)(X1 + (size_t)row * D) + lane + 64 * j);
#if LEVEL >= 4
#pragma unroll
        for (int k = 0; k < 4; ++k) { const int e = tok_e[(size_t)row * 4 + k], rk = tok_r[(size_t)row * 4 + k]; const float gg = gate[(size_t)row * 4 + k];
            const bf16_t* yr = Y + (size_t)(tstart[e] * 256 + rk) * D;
#pragma unroll
            for (int j = 0; j < 4; ++j) { const u32x2 yy = *((const u32x2*)yr + lane + 64 * j); v[j].x += gg * bflo(yy.x); v[j].y += gg * bfhi(yy.x); v[j].z += gg * bflo(yy.y); v[j].w += gg * bfhi(yy.y); } }
#endif
        float ss = 0.f;
#pragma unroll
        for (int j = 0; j < 4; ++j) ss += v[j].x * v[j].x + v[j].y * v[j].y + v[j].z * v[j].z + v[j].w * v[j].w;
        const float rstd = rsqrtf(wave_sum(ss) * (1.f / D) + EPS);
#pragma unroll
        for (int j = 0; j < 4; ++j) *((f32x4*)(P.out + (size_t)row * D) + lane + 64 * j) = v[j] * rstd * *((const f32x4*)P.norm_final_w + lane + 64 * j);
    }
}

extern "C" __global__ void __launch_bounds__(NTHREADS) fwd_megakernel(Params P) {
    extern __shared__ __attribute__((aligned(16))) unsigned char smem[];
    LAS unsigned char* lds = (LAS unsigned char*)smem;
    unsigned char* ws = P.ws;
    const int tid = threadIdx.x;
    const int G = gridDim.x, bid = blockIdx.x;
    volatile LAS unsigned* misc = (volatile LAS unsigned*)(lds + LDS_MISC);
    if (tid < 64) misc[tid] = 0u;
    __syncthreads();
    XcdBarrier bar = xcd_barrier_post((unsigned*)(ws + WS_CTL) + CW_BAR, misc);
#if TSA >= 0
    unsigned long long* tsw = (unsigned long long*)((unsigned*)(ws + WS_CTL) + CW_TS); int tsi = 0;
#define STAMP() do { if (bid == 0 && tid == 0) tsw[tsi] = __builtin_amdgcn_s_memrealtime(); ++tsi; } while (0)
#else
#define STAMP() do { } while (0)
#endif
#define GRID_BAR() do { xcd_barrier(bar); STAMP(); } while (0)
    STAMP();

    REP(0) phase0(P, smem);
    GRID_BAR();
#if LEVEL >= 2
    REP(1) {
        pg8::DenseOrder S{(const char*)(ws + WS_H), (const char*)(ws + WS_WIN), T / 256, DINP / 256, D, G, bid};
        EpiProj E{(bf16_t*)(ws + WS_PROJ)};
        pg8::gemm_phase<EpiProj, pg8::DenseOrder>(lds, D, S, E);
    }
    GRID_BAR();
    REP(2) phase2a(P);
#if LEVEL >= 3
    REP(12) for (int item = bid; item < NB * GH * NCH; item += G) gdn_prep_item(P, smem, item);
#endif
    GRID_BAR();
    REP(3) {
        pg8::DenseOrder S{(const char*)(ws + WS_CQN), (const char*)(ws + WS_WUQ), T / 256, 768 / 256, QL, G, bid};
        EpiQ E{(bf16_t*)(ws + WS_Q), (const float*)(ws + WS_TAB)};
        pg8::gemm_phase<EpiQ, pg8::DenseOrder>(lds, QL, S, E);
        pg8::DenseOrder S2{(const char*)(ws + WS_CKVN), (const char*)(ws + WS_WUKV), T / 256, 1024 / 256, KVL, G, (bid + 64) % G};
        EpiKV E2{(bf16_t*)(ws + WS_K), (bf16_t*)(ws + WS_VT)};
        pg8::gemm_phase<EpiKV, pg8::DenseOrder>(lds, KVL, S2, E2);
    }
    GRID_BAR();
    {
        REP(14) if (bid < NB * GH) gdn_scan(P, smem, bid);
#if TSA >= 0
        if (bid == 0 && tid == 0) { tsw[20] = tsw[tsi - 1]; tsw[21] = __builtin_amdgcn_s_memrealtime(); }
#endif
        const int tidq = opaque_tid();
        const bool tfirst = ((bid & 3) == 3);
        for (int rep_ = 0; rep_ < ((DUP == 4 || DUP == 15) ? 2 : 1); ++rep_)
#pragma unroll 1
        for (int pass = 0; pass < 2; ++pass) {
            unsigned* aq = (unsigned*)(ws + WS_CTL) + CW_AQ + 128 * rep_;
            const bool do_t = (pass == 0) == tfirst;
            unsigned* qh = aq + (do_t ? 64 : 0);
            const int qn = do_t ? ((rep_ == 1 && DUP == 4) ? 0 : TT_TOTAL) : ((rep_ == 1 && DUP == 15) ? 0 : 512);
            for (;;) {
                __syncthreads();
                if (tidq == 0) misc[8] = atomicAdd(qh, 1u);
                __syncthreads();
                const int item = (int)misc[8];
                if (item >= qn) break;
                if (do_t) late_transpose_item(P, smem, item, tidq); else attn_item(P, smem, item);
            }
        }
    }
    GRID_BAR();
    REP(5) { phase5(P); for (int item = bid; item < NB * GH * NCH; item += G) gdn_out_item(P, smem, item); }
    GRID_BAR();
    REP(6) {
        pg8::DenseOrder S{(const char*)(ws + WS_OCAT), (const char*)(ws + WS_WOUT), T / 256, D / 256, D, G, bid};
        EpiX1 E{P.x, (float*)(ws + WS_X1)};
        pg8::gemm_phase<EpiX1, pg8::DenseOrder>(lds, D, S, E);
    }
    GRID_BAR();
#endif
#if LEVEL >= 4
    phase7(P, smem);
    GRID_BAR();
    moe_tiles(P, smem);
    phase8(P, smem);
    GRID_BAR();
    REP(9) {
        const LAS int* ts = (const LAS int*)(lds + LDS_MISC + 256);
        MoeOrder1 S{(const char*)(ws + WS_XG), (const char*)(ws + WS_W1), ts, G, bid};
        EpiAct E{ws + WS_ACT, P.b1};
        pg8::gemm_phase<EpiAct, MoeOrder1, true>(lds, D, S, E);
    }
    GRID_BAR();
    REP(10) {
        const LAS int* ts = (const LAS int*)(lds + LDS_MISC + 256);
        MoeOrder2 S{(const char*)(ws + WS_ACT), (const char*)(ws + WS_W2), ts, G, bid};
        EpiY E{(bf16_t*)(ws + WS_Y), P.b2};
        pg8::gemm_phase<EpiY, MoeOrder2, true>(lds, DFF, S, E);
    }
    GRID_BAR();
#endif
    REP(11) phase11(P, smem);
#if TSA >= 0
    if (bid == 0) {
        __syncthreads();
        if (tid == 0) { const unsigned long long dt = tsw[TSA + 1] - tsw[TSA], t0 = __builtin_amdgcn_s_memrealtime();
            while (__builtin_amdgcn_s_memrealtime() - t0 < dt) __builtin_amdgcn_s_sleep(8); }
        __syncthreads();
    }
#endif
}

extern "C" void kernel_launch(void* const* d_in, const int* in_sizes, int n_in, void* d_out, int out_size, void* d_ws, size_t ws_size, hipStream_t stream) {
    static int grid = 0;
    if (grid == 0) {
        if (n_in != 22 || in_sizes[0] != T * D || out_size != T * D || ws_size < WS_END) {
            fprintf(stderr, "kernel_launch: unexpected shapes (n_in %d, in0 %d, out %d, ws %zu < %zu)\n", n_in, n_in > 0 ? in_sizes[0] : -1, out_size, ws_size, (size_t)WS_END); grid = -1; return; }
        int dev = 0, cus = 0, per_cu = 0;
        if (hipGetDevice(&dev) != hipSuccess || hipDeviceGetAttribute(&cus, hipDeviceAttributeMultiprocessorCount, dev) != hipSuccess) { grid = -1; return; }
        if (hipFuncSetAttribute((const void*)fwd_megakernel, hipFuncAttributeMaxDynamicSharedMemorySize, LDS_BYTES) != hipSuccess) { fprintf(stderr, "kernel_launch: hipFuncSetAttribute failed\n"); grid = -1; return; }
        if (hipOccupancyMaxActiveBlocksPerMultiprocessor(&per_cu, (const void*)fwd_megakernel, NTHREADS, LDS_BYTES) != hipSuccess || per_cu < 1) { fprintf(stderr, "kernel_launch: occupancy query says %d\n", per_cu); (void)hipGetLastError(); grid = -1; return; }
        grid = cus;
        if (grid != 256) fprintf(stderr, "kernel_launch: note: %d CUs\n", grid);
    }
    if (grid < 0) return;
    (void)hipMemsetAsync((char*)d_ws + WS_CTL, 0, CTL_BYTES, stream);
    Params p{};
    p.x = (const float*)d_in[0]; p.pos = (const int*)d_in[1]; p.norm_mix_w = (const float*)d_in[2]; p.w_in = (const float*)d_in[3]; p.conv_w = (const float*)d_in[4];
    p.a_log = (const float*)d_in[5]; p.dt_bias = (const float*)d_in[6]; p.gdn_norm_w = (const float*)d_in[7]; p.q_norm_w = (const float*)d_in[8]; p.w_uq = (const float*)d_in[9];
    p.kv_norm_w = (const float*)d_in[10]; p.w_ukv = (const float*)d_in[11]; p.mla_out_norm_w = (const float*)d_in[12]; p.w_out = (const float*)d_in[13]; p.norm_ffn_w = (const float*)d_in[14];
    p.router_w = (const float*)d_in[15]; p.router_b = (const float*)d_in[16]; p.w1 = (const float*)d_in[17]; p.b1 = (const float*)d_in[18]; p.w2 = (const float*)d_in[19];
    p.b2 = (const float*)d_in[20]; p.norm_final_w = (const float*)d_in[21]; p.out = (float*)d_out; p.ws = (unsigned char*)d_ws;
    void* args[] = {&p};
    hipError_t e = hipLaunchCooperativeKernel((const void*)fwd_megakernel, dim3(grid), dim3(NTHREADS), args, LDS_BYTES, stream);
    if (e != hipSuccess) fprintf(stderr, "kernel_launch: cooperative launch failed: %s (grid %d)\n", hipGetErrorString(e), grid);
}
```

```cpp
#include <hip/hip_runtime.h>
#include <cstdio>
#include <cstdint>

#ifndef LEVEL
#define LEVEL 4
#endif

#ifndef DUP
#define DUP -1
#endif
#ifndef TSA
#define TSA -1
#define TSB -1
#endif
#define REP(k) for (int rep_ = 0; rep_ < ((DUP == (k)) ? 2 : 1); ++rep_)
#define LAS __attribute__((address_space(3)))
typedef unsigned short bf16_t;
typedef short bf16x8 __attribute__((ext_vector_type(8)));
typedef float f32x4 __attribute__((ext_vector_type(4)));
typedef float f32x16 __attribute__((ext_vector_type(16)));
typedef unsigned u32x4 __attribute__((ext_vector_type(4)));
typedef unsigned u32x2 __attribute__((ext_vector_type(2)));

constexpr int NB = 4, SEQ = 4096, T = NB * SEQ, D = 1024, DIN = 2728, DINP = 2816;
constexpr int GH = 4, NCH = SEQ / 64;
constexpr int MH = 8, DQK = 96, QL = 384, KVL = 256;
constexpr int NE = 32, DFF = 1024;
constexpr int C_Z = 1536, C_CQ = 2056, C_CKV = 2440, C_KR = 2696;
constexpr float EPS = 1e-6f;
constexpr int NTHREADS = 512, NWAVES = 8;
constexpr int LDS_BYTES = 147456;
constexpr int LDS_MISC = 131072;
constexpr int MOE_MAXROWS = 73728;

constexpr size_t MiB = 1u << 20;
constexpr size_t WS_CTL = 0, CTL_BYTES = 65536;
constexpr size_t WS_WIN = 1 * MiB, WS_WUQ = 7 * MiB, WS_WUKV = 8 * MiB, WS_WOUT = 9 * MiB, WS_W1 = 11 * MiB, WS_W2 = 139 * MiB;
constexpr size_t WS_X1 = 203 * MiB, WS_H = 267 * MiB, WS_AB = 299 * MiB, WS_TAB = 300 * MiB;
constexpr size_t WS_TOKE = 302 * MiB, WS_TOKR = WS_TOKE + 256 * 1024, WS_GATE = WS_TOKR + 256 * 1024, WS_LIST = 303 * MiB;
constexpr size_t WS_R = 306 * MiB;
constexpr size_t WS_PROJ = WS_R, WS_CQN = WS_R + 88 * MiB, WS_CKVN = WS_R + 100 * MiB, WS_Q = WS_R + 108 * MiB, WS_K = WS_R + 132 * MiB, WS_VT = WS_R + 156 * MiB;
constexpr size_t WS_GP = WS_R + 172 * MiB;
constexpr size_t GP_ITEM = 90112, GP_U = 0, GP_W = 32768, GP_QD = 49152, GP_KDT = 65536, GP_QK = 81920;
constexpr size_t WS_GT = WS_R + 260 * MiB, WS_OA = WS_R + 261 * MiB, WS_OB = WS_R + 293 * MiB, WS_OCAT = WS_R + 309 * MiB;
constexpr size_t WS_ACT = WS_R, WS_Y = WS_R + 144 * MiB, WS_XG = WS_R + 288 * MiB;
constexpr size_t WS_SB = WS_R + 341 * MiB;
constexpr size_t WS_END = WS_R + 373 * MiB;
constexpr int CW_BAR = 4096, CW_CNT = 8192  , CW_AQ = 8320  , CW_TS = 12288  ;

struct Params {
    const float* x; const int* pos; const float* norm_mix_w; const float* w_in; const float* conv_w; const float* a_log; const float* dt_bias;
    const float* gdn_norm_w; const float* q_norm_w; const float* w_uq; const float* kv_norm_w; const float* w_ukv; const float* mla_out_norm_w;
    const float* w_out; const float* norm_ffn_w; const float* router_w; const float* router_b; const float* w1; const float* b1; const float* w2;
    const float* b2; const float* norm_final_w; float* out; unsigned char* ws;
};

typedef float f32x2v __attribute__((ext_vector_type(2)));
typedef __bf16 bf16x2v __attribute__((ext_vector_type(2)));
__device__ __forceinline__ unsigned pk2(float lo, float hi) { const f32x2v v = {lo, hi}; return __builtin_bit_cast(unsigned, __builtin_convertvector(v, bf16x2v)); }
__device__ __forceinline__ unsigned f2bf(float f) { return pk2(f, 0.f) & 0xffffu; }
__device__ __forceinline__ unsigned pk4_fp8(float a, float b, float c, float d) { unsigned w = 0u; w = __builtin_amdgcn_cvt_pk_fp8_f32(a, b, w, false); w = __builtin_amdgcn_cvt_pk_fp8_f32(c, d, w, true); return w; }
typedef int v4i_t __attribute__((ext_vector_type(4)));
typedef int v8i_t __attribute__((ext_vector_type(8)));
__device__ __forceinline__ float bflo(unsigned u) { return __builtin_bit_cast(float, u << 16); }
__device__ __forceinline__ float bfhi(unsigned u) { return __builtin_bit_cast(float, u & 0xffff0000u); }
__device__ __forceinline__ float bf1(bf16_t b) { return __builtin_bit_cast(float, (unsigned)b << 16); }
__device__ __forceinline__ float wave_sum(float v) {
#pragma unroll
    for (int o = 1; o < 64; o <<= 1) v += __shfl_xor(v, o);
    return v;
}
__device__ __forceinline__ int opaque_tid() { int t = threadIdx.x; asm volatile("" : "+v"(t)); return t; }
__device__ __forceinline__ float sigmoidf_(float x) { return 1.f / (1.f + __expf(-x)); }
__device__ __forceinline__ bf16x8 pack8(f32x4 a, f32x4 b) {
    u32x4 r; r.x = pk2(a.x, a.y); r.y = pk2(a.z, a.w); r.z = pk2(b.x, b.y); r.w = pk2(b.z, b.w);
    return __builtin_bit_cast(bf16x8, r);
}
__device__ __forceinline__ int perm32k(int d) { return (d & ~31) | (((d >> 2) & 3) << 3) | (((d >> 4) & 1) << 2) | (d & 3); }
__device__ __forceinline__ int perm16v(int s) { return (s & ~15) | (((s >> 2) & 1) << 3) | (((s >> 3) & 1) << 2) | (s & 3); }

#define XB_TMO      128
#define XB_XCNT(j)  (256  + 64 * (j))
#define XB_XSUB(j)  (1280 + 64 * (j))
#define XB_XGEN(j)  (2304 + 64 * (j))
#define XB_TOP      3328
#define XB_TOPGEN   3392
#define XCD_BAR_WORDS 3456
#define XB_SPIN_CAP (1u << 18)
__device__ __forceinline__ unsigned xb_ld(unsigned* p)              { return __hip_atomic_load(p, __ATOMIC_RELAXED, __HIP_MEMORY_SCOPE_AGENT); }
__device__ __forceinline__ unsigned xb_add(unsigned* p, unsigned v) { return __hip_atomic_fetch_add(p, v, __ATOMIC_RELAXED, __HIP_MEMORY_SCOPE_AGENT); }
__device__ __forceinline__ unsigned xb_xcc_id() { return (unsigned)__builtin_amdgcn_s_getreg((3 << 11) | 20) & 0xFu; }
#define XB_SPIN(cond, bar) do { unsigned _sp = 0; while (cond) { __builtin_amdgcn_s_sleep(1); \
    if ((++_sp & 255u) == 0u) { if (xb_ld(&(bar)[XB_TMO])) break; if (_sp > XB_SPIN_CAP) { atomicAdd(&(bar)[XB_TMO], 1u); break; } } } } while (0)
struct XcdBarrier { unsigned* bar; unsigned x; volatile LAS unsigned* st; };
__device__ __forceinline__ XcdBarrier xcd_barrier_post(unsigned* bar, volatile LAS unsigned* st) {
    XcdBarrier b; b.bar = bar; b.x = xb_xcc_id(); b.st = st;
    if (threadIdx.x == 0) (void)xb_add(&bar[XB_XCNT(b.x)], 1u);
    return b;
}
__device__ __forceinline__ void xcd_barrier_complete(unsigned* bar, unsigned x, unsigned& nloc, unsigned& nx) {
    const unsigned G = gridDim.x * gridDim.y * gridDim.z;
    unsigned sum, cnt, mine, sp = 0u;
    for (;;) {
        sum = 0u; cnt = 0u; mine = 0u;
#pragma unroll
        for (unsigned j = 0; j < 16; ++j) { const unsigned c = xb_ld(&bar[XB_XCNT(j)]); sum += c; cnt += (c > 0u) ? 1u : 0u; mine = (j == x) ? c : mine; }
        if (sum == G) break;
        __builtin_amdgcn_s_sleep(1);
        if ((++sp & 255u) == 0u) { if (xb_ld(&bar[XB_TMO])) break; if (sp > XB_SPIN_CAP) { atomicAdd(&bar[XB_TMO], 1u); break; } }
    }
    nloc = mine > 0u ? mine : 1u; nx = cnt > 0u ? cnt : 1u;
}
__device__ __forceinline__ void xcd_barrier(const XcdBarrier& b) {
    asm volatile("s_waitcnt vmcnt(0)" ::: "memory");
    __syncthreads();
    if (threadIdx.x == 0) {
        unsigned* bar = b.bar;
        __builtin_amdgcn_s_waitcnt(0);
        unsigned nloc = b.st[0], nx = b.st[1];
        if (nloc == 0u) { xcd_barrier_complete(bar, b.x, nloc, nx); b.st[0] = nloc; b.st[1] = nx; }
        const unsigned old = xb_add(&bar[XB_XSUB(b.x)], 1u);
        const unsigned gen = old / nloc;
        if (old + 1u == (gen + 1u) * nloc) {
            __builtin_amdgcn_fence(__ATOMIC_RELEASE, "agent");
            asm volatile("s_waitcnt vmcnt(0)" ::: "memory");
            const unsigned og = xb_add(&bar[XB_TOP], 1u);
            const unsigned tg = og / nx;
            if (og + 1u == (tg + 1u) * nx) xb_add(&bar[XB_TOPGEN], 1u);
            else XB_SPIN(xb_ld(&bar[XB_TOPGEN]) == tg, bar);
            __builtin_amdgcn_fence(__ATOMIC_ACQUIRE, "agent");
            xb_add(&bar[XB_XGEN(b.x)], 1u);
            asm volatile("s_waitcnt vmcnt(0)" ::: "memory");
        } else {
            XB_SPIN(xb_ld(&bar[XB_XGEN(b.x)]) == gen, bar);
            __builtin_amdgcn_fence(__ATOMIC_ACQUIRE, "agent");
            asm volatile("s_waitcnt vmcnt(0)" ::: "memory");
        }
    }
    __syncthreads();
}

namespace pg8 {
constexpr int BM = 256, BK = 64, HALF = 128, HTB = HALF * BK * 2, NXCD = 8, WGM = 8;
__device__ __forceinline__ int lds_byte(int r, int c) { const int st = (r >> 4) * 2 + (c >> 5), rr = r & 15, cc = c & 31, ob = rr * 64 + cc * 2; return st * 1024 + (ob ^ (((ob >> 9) & 1) << 5)); }
__device__ __forceinline__ void stage_rc(int b, int& R, int& C) { const int st = b / 1024, sb = b % 1024, swz = sb ^ (((sb >> 9) & 1) << 5); R = (st >> 1) * 16 + swz / 64; C = (st & 1) * 32 + (swz % 64) / 2; }
__device__ __forceinline__ int perm32(int rho) { const int n = rho >> 4, i = rho & 15; return 8 * (i >> 2) + 4 * n + (i & 3); }

struct Unit { int pm, pn, e; const char* A; const char* B; };

__device__ __forceinline__ void tile_order(int L, int nM, int nN, int& pm, int& pn) {
    const int nwg = nM * nN; int wgid = L;
    { const int q = nwg / NXCD, r = nwg % NXCD, xcd = wgid % NXCD, off = wgid / NXCD; wgid = (xcd < r ? xcd * (q + 1) : r * (q + 1) + (xcd - r) * q) + off; }
    const int nig = WGM * nN, gid = wgid / nig, fm = gid * WGM, gsz = (nM - fm) < WGM ? (nM - fm) : WGM;
    pm = fm + ((wgid % nig) % gsz); pn = (wgid % nig) / gsz;
}

template <class Epi, class Sched, bool FP8 = false>
__device__ __forceinline__ void gemm_phase(LAS unsigned char* lds, const int K, const Sched& S, const Epi& E) {
    const int tid = opaque_tid(), wid = __builtin_amdgcn_readfirstlane(tid >> 6), lane = tid & 63, wr = wid >> 2, wc = wid & 3, fr = lane & 15, fq = lane >> 4;
    const int RB = FP8 ? K : 2 * K;
    const int nt = RB / 128;
    int Rr[2], Cc[2];
    unsigned voffB[2];
#pragma unroll
    for (int i = 0; i < 2; ++i) { stage_rc(tid * 16 + i * 8192, Rr[i], Cc[i]); const int Rb = Epi::PERM ? ((Rr[i] & ~31) + perm32(Rr[i] & 31)) : Rr[i]; voffB[i] = (unsigned)(Rb * RB + Cc[i] * 2); }
    const size_t kstep = (size_t)(BK * 2);
    const unsigned hstep = (unsigned)HALF * RB;
    const unsigned ldsw = (unsigned)wid * 1024u;
    const int aoff = lds_byte(wr * 64 + fr, fq * 8), boff = lds_byte(wc * 32 + fr, fq * 8);
#define PG8_SA(b, h) (((b) * 2 + (h)) * HTB)
#define PG8_SB(b, h) ((4 + (b) * 2 + (h)) * HTB)
#define PG8_RS(p) __builtin_amdgcn_make_buffer_rsrc((void*)(p), 0, 0x7fffffff, 0x00020000)
#define PG8_STAGE_A(bufoff, base, kb, h, VO) do { const auto rs_ = PG8_RS(base); _Pragma("unroll") for (int _i = 0; _i < 2; ++_i) \
        __builtin_amdgcn_raw_ptr_buffer_load_lds(rs_, (LAS void*)(lds + (bufoff) + ldsw + _i * 8192), 16, (int)(VO)[Sched::GATHER ? (h) : 0][_i], (int)((kb) + (Sched::GATHER ? 0u : (h) * hstep)), 0, 0); } while (0)
#define PG8_STAGE_B(bufoff, base, kb, h) do { const auto rs_ = PG8_RS(base); _Pragma("unroll") for (int _i = 0; _i < 2; ++_i) \
        __builtin_amdgcn_raw_ptr_buffer_load_lds(rs_, (LAS void*)(lds + (bufoff) + ldsw + _i * 8192), 16, (int)voffB[_i], (int)((kb) + (h) * hstep), 0, 0); } while (0)
#define PG8_LDA(dst, b, h) do { if constexpr (FP8) { _Pragma("unroll") for (int m = 0; m < 4; ++m) { const v4i_t x0_ = *(const LAS v4i_t*)(lds + PG8_SA(b, h) + aoff + m * 2048), x1_ = *(const LAS v4i_t*)(lds + PG8_SA(b, h) + aoff + m * 2048 + 1024); \
            dst##8[m] = __builtin_shufflevector(x0_, x1_, 0, 1, 2, 3, 4, 5, 6, 7); } } \
        else { _Pragma("unroll") for (int m = 0; m < 4; ++m) _Pragma("unroll") for (int k = 0; k < 2; ++k) dst[m][k] = *(const LAS bf16x8*)(lds + PG8_SA(b, h) + aoff + m * 2048 + k * 1024); } } while (0)
#define PG8_LDB(dst, b, h) do { if constexpr (FP8) { _Pragma("unroll") for (int n = 0; n < 2; ++n) { const v4i_t x0_ = *(const LAS v4i_t*)(lds + PG8_SB(b, h) + boff + n * 2048), x1_ = *(const LAS v4i_t*)(lds + PG8_SB(b, h) + boff + n * 2048 + 1024); \
            dst##8[n] = __builtin_shufflevector(x0_, x1_, 0, 1, 2, 3, 4, 5, 6, 7); } } \
        else { _Pragma("unroll") for (int n = 0; n < 2; ++n) _Pragma("unroll") for (int k = 0; k < 2; ++k) dst[n][k] = *(const LAS bf16x8*)(lds + PG8_SB(b, h) + boff + n * 2048 + k * 1024); } } while (0)
#define PG8_MMA(ai, bj, At, Bt) do { __builtin_amdgcn_s_setprio(1); \
        if constexpr (FP8) { _Pragma("unroll") for (int m = 0; m < 4; ++m) _Pragma("unroll") for (int n = 0; n < 2; ++n) \
            asm volatile("v_mfma_f32_16x16x128_f8f6f4 %0, %1, %2, %0" : "+v"(acc[ai][bj][m][n]) : "v"(Bt##8[n]), "v"(At##8[m])); } \
        else { _Pragma("unroll") for (int m = 0; m < 4; ++m) _Pragma("unroll") for (int n = 0; n < 2; ++n) _Pragma("unroll") for (int k = 0; k < 2; ++k) \
            acc[ai][bj][m][n] = __builtin_amdgcn_mfma_f32_16x16x32_bf16(Bt[n][k], At[m][k], acc[ai][bj][m][n], 0, 0, 0); } \
        __builtin_amdgcn_s_setprio(0); } while (0)
#define PG8_WAIT_V(n) asm volatile("s_waitcnt vmcnt(" #n ")" ::: "memory")
#define PG8_WAIT_L(n) asm volatile("s_waitcnt lgkmcnt(" #n ")" ::: "memory")
#define PG8_BAR __builtin_amdgcn_s_barrier()
#define PG8_SCHED __builtin_amdgcn_sched_barrier(0)
#define PG8_AOFFS(VO, u) do { _Pragma("unroll") for (int _h = 0; _h < 2; ++_h) _Pragma("unroll") for (int _i = 0; _i < 2; ++_i) { \
        if constexpr (Sched::GATHER) VO[_h][_i] = (unsigned)S.row_src(u, _h * HALF + Rr[_i]) * (unsigned)RB + (unsigned)(Cc[_i] * 2); \
        else VO[_h][_i] = (unsigned)(Rr[_i] * RB + Cc[_i] * 2); } } while (0)
    Unit cur, nxt; int ui = 0;
    if (!S.next(0, cur)) return;
    unsigned voc[2][2], von[2][2];
    PG8_AOFFS(voc, cur);
    f32x4 acc[2][2][4][2];
#pragma unroll
    for (int a = 0; a < 2; ++a)
#pragma unroll
        for (int b = 0; b < 2; ++b)
#pragma unroll
            for (int m = 0; m < 4; ++m)
#pragma unroll
                for (int n = 0; n < 2; ++n) acc[a][b][m][n] = (f32x4){0.f, 0.f, 0.f, 0.f};
    bf16x8 At[4][2], B0[2][2], B1[2][2]; v8i_t At8[4], B08[2], B18[2];
    const char* cA = cur.A; const char* cB = cur.B;
    PG8_STAGE_B(PG8_SB(0, 0), cB, 0, 0); PG8_STAGE_A(PG8_SA(0, 0), cA, 0, 0, voc); PG8_STAGE_B(PG8_SB(0, 1), cB, 0, 1); PG8_STAGE_A(PG8_SA(0, 1), cA, 0, 1, voc);
    if (wr == 1) PG8_BAR;
    PG8_WAIT_V(4); PG8_BAR;
    PG8_STAGE_B(PG8_SB(1, 0), cB, kstep, 0); PG8_STAGE_A(PG8_SA(1, 0), cA, kstep, 0, voc); PG8_STAGE_B(PG8_SB(1, 1), cB, kstep, 1);
    PG8_WAIT_V(6); PG8_BAR;
    for (;;) {
        const bool has_next = S.next(ui + 1, nxt);
        if constexpr (Sched::GATHER) {
            if (has_next) { PG8_AOFFS(von, nxt); }
            else {
#pragma unroll
                for (int _h = 0; _h < 2; ++_h)
#pragma unroll
                    for (int _i = 0; _i < 2; ++_i) von[_h][_i] = voc[_h][_i];
            }
        }
        const char* nA = has_next ? nxt.A : cA; const char* nB = has_next ? nxt.B : cB;
        for (int t = 0; t < nt; t += 2) {
            const bool last = (t == nt - 2);
            const size_t k1 = (size_t)(t + 1) * kstep;
            const char* a2 = last ? nA : cA; const char* b2 = last ? nB : cB;
            const size_t k2 = last ? 0 : (size_t)(t + 2) * kstep, k3 = k2 + kstep;
            unsigned vo2[2][2];
#pragma unroll
            for (int _h = 0; _h < 2; ++_h)
#pragma unroll
                for (int _i = 0; _i < 2; ++_i) { if constexpr (Sched::GATHER) vo2[_h][_i] = last ? von[_h][_i] : voc[_h][_i]; else vo2[_h][_i] = voc[_h][_i]; }
            PG8_LDB(B0, 0, 0); PG8_SCHED; PG8_LDA(At, 0, 0); PG8_STAGE_A(PG8_SA(1, 1), cA, k1, 1, voc);
            PG8_WAIT_L(8); PG8_BAR; PG8_WAIT_L(0); PG8_MMA(0, 0, At, B0); PG8_BAR; PG8_SCHED;
            PG8_LDB(B1, 0, 1); PG8_STAGE_B(PG8_SB(0, 0), b2, k2, 0);
            PG8_BAR; PG8_WAIT_L(0); PG8_MMA(0, 1, At, B1); PG8_BAR;
            PG8_LDA(At, 0, 1); PG8_STAGE_A(PG8_SA(0, 0), a2, k2, 0, vo2);
            PG8_BAR; PG8_WAIT_L(0); PG8_MMA(1, 0, At, B0); PG8_BAR; PG8_SCHED;
            PG8_STAGE_B(PG8_SB(0, 1), b2, k2, 1);
            PG8_WAIT_V(6); PG8_BAR; PG8_MMA(1, 1, At, B1); PG8_BAR;
            PG8_LDB(B0, 1, 0); PG8_SCHED; PG8_LDA(At, 1, 0); PG8_STAGE_A(PG8_SA(0, 1), a2, k2, 1, vo2);
            PG8_WAIT_L(8); PG8_BAR; PG8_WAIT_L(0); PG8_MMA(0, 0, At, B0); PG8_BAR; PG8_SCHED;
            PG8_LDB(B1, 1, 1); PG8_STAGE_B(PG8_SB(1, 0), b2, k3, 0);
            PG8_BAR; PG8_WAIT_L(0); PG8_MMA(0, 1, At, B1); PG8_BAR;
            PG8_LDA(At, 1, 1); PG8_STAGE_A(PG8_SA(1, 0), a2, k3, 0, vo2);
            PG8_BAR; PG8_WAIT_L(0); PG8_MMA(1, 0, At, B0); PG8_BAR; PG8_SCHED;
            PG8_STAGE_B(PG8_SB(1, 1), b2, k3, 1);
            PG8_WAIT_V(6); PG8_BAR; PG8_MMA(1, 1, At, B1); PG8_BAR;
        }
        if constexpr (FP8) asm volatile("s_nop 15\n\ts_nop 15" ::: "memory");
        E(acc, cur, wr, wc, fr, fq);
        if (!has_next) break;
#pragma unroll
        for (int a = 0; a < 2; ++a)
#pragma unroll
            for (int b = 0; b < 2; ++b)
#pragma unroll
                for (int m = 0; m < 4; ++m)
#pragma unroll
                    for (int n = 0; n < 2; ++n) acc[a][b][m][n] = (f32x4){0.f, 0.f, 0.f, 0.f};
        cur = nxt; cA = nA; cB = nB; ++ui;
        if constexpr (Sched::GATHER) {
#pragma unroll
            for (int _h = 0; _h < 2; ++_h)
#pragma unroll
                for (int _i = 0; _i < 2; ++_i) voc[_h][_i] = von[_h][_i];
        }
    }
    PG8_WAIT_V(0);
    if (wr == 0) PG8_BAR;
    PG8_BAR;
#undef PG8_SA
#undef PG8_SB
#undef PG8_STAGE_A
#undef PG8_RS
#undef PG8_STAGE_B
#undef PG8_LDA
#undef PG8_LDB
#undef PG8_MMA
#undef PG8_WAIT_V
#undef PG8_WAIT_L
#undef PG8_BAR
#undef PG8_SCHED
#undef PG8_AOFFS
}

struct DenseOrder {
    static constexpr bool GATHER = false;
    const char* A; const char* Bt; int nM, nN, K, G, c;
    __device__ __forceinline__ bool next(int i, Unit& u) const {
        const int L = i * G + c; if (L >= nM * nN) return false;
        tile_order(L, nM, nN, u.pm, u.pn); u.e = 0;
        u.A = A + (size_t)u.pm * BM * K * 2; u.B = Bt + (size_t)u.pn * BM * K * 2; return true;
    }
    __device__ __forceinline__ int row_src(const Unit&, int) const { return 0; }
};
}
using pg8::Unit;

struct EpiProj {
    static constexpr bool PERM = true;
    bf16_t* O;
    __device__ __forceinline__ void operator()(const f32x4 (&acc)[2][2][4][2], const Unit& u, int wr, int wc, int fr, int fq) const {
#pragma unroll
        for (int ai = 0; ai < 2; ++ai)
#pragma unroll
            for (int m = 0; m < 4; ++m) { const int row = u.pm * 256 + ai * 128 + wr * 64 + m * 16 + fr;
#pragma unroll
                for (int bj = 0; bj < 2; ++bj) { const int col = u.pn * 256 + bj * 128 + wc * 32 + 8 * fq; const f32x4 v0 = acc[ai][bj][m][0], v1 = acc[ai][bj][m][1];
                    u32x4 o; o.x = pk2(v0.x, v0.y); o.y = pk2(v0.z, v0.w); o.z = pk2(v1.x, v1.y); o.w = pk2(v1.z, v1.w);
                    *(u32x4*)(O + (size_t)row * DINP + col) = o; } }
    }
};
struct EpiQ {
    static constexpr bool PERM = false;
    bf16_t* Q; const float* tab;
    __device__ __forceinline__ void operator()(const f32x4 (&acc)[2][2][4][2], const Unit& u, int wr, int wc, int fr, int fq) const {
        const float sc = 0.10206207261596577f * 1.4426950408889634f;
#pragma unroll
        for (int ai = 0; ai < 2; ++ai)
#pragma unroll
            for (int m = 0; m < 4; ++m) { const int row = u.pm * 256 + ai * 128 + wr * 64 + m * 16 + fr; const int b = row / SEQ, s = row % SEQ;
#pragma unroll
                for (int bj = 0; bj < 2; ++bj) { const int c0 = u.pn * 256 + bj * 128 + wc * 32; const int g32 = c0 >> 5; const int head = c0 / 96;
                    f32x4 v0 = acc[ai][bj][m][0], v1 = acc[ai][bj][m][1];
                    if (g32 % 3 == 2) {
                        const f32x4 cs = *(const f32x4*)(tab + (unsigned)(row * 32 + 4 * fq)), sn = *(const f32x4*)(tab + (unsigned)(row * 32 + 16 + 4 * fq));
                        const f32x4 r0 = v0 * cs - v1 * sn, r1 = v1 * cs + v0 * sn; v0 = r0; v1 = r1;
                    }
                    v0 = v0 * sc; v1 = v1 * sc;
                    bf16_t* base = Q + (unsigned)(((b * MH + head) * SEQ + s) * DQK + (c0 - head * 96) + 4 * fq);
                    u32x2 o0; o0.x = pk2(v0.x, v0.y); o0.y = pk2(v0.z, v0.w); *(u32x2*)(base) = o0;
                    u32x2 o1; o1.x = pk2(v1.x, v1.y); o1.y = pk2(v1.z, v1.w); *(u32x2*)(base + 16) = o1; }
                __builtin_amdgcn_sched_barrier(0); }
    }
};
struct EpiKV {
    static constexpr bool PERM = false;
    bf16_t* Kp; bf16_t* VT;
    __device__ __forceinline__ void operator()(const f32x4 (&acc)[2][2][4][2], const Unit& u, int wr, int wc, int fr, int fq) const {
#pragma unroll
        for (int ai = 0; ai < 2; ++ai)
#pragma unroll
            for (int m = 0; m < 4; ++m) { const int row = u.pm * 256 + ai * 128 + wr * 64 + m * 16 + fr; const int b = row / SEQ, s = row % SEQ;
#pragma unroll
                for (int bj = 0; bj < 2; ++bj) { const int c0 = u.pn * 256 + bj * 128 + wc * 32; const int head = c0 >> 7; const int w0 = c0 & 127;
#pragma unroll
                    for (int n = 0; n < 2; ++n) { const f32x4 v = acc[ai][bj][m][n]; const int within = w0 + 16 * n + 4 * fq;
                        if (within < 64) { u32x2 o; o.x = pk2(v.x, v.y); o.y = pk2(v.z, v.w); *(u32x2*)(Kp + ((size_t)(b * MH + head) * SEQ + s) * DQK + within) = o; }
                        else { bf16_t* vb = VT + ((size_t)(b * MH + head) * 64 + (within - 64)) * SEQ + perm16v(s);
                            vb[0] = (bf16_t)f2bf(v.x); vb[SEQ] = (bf16_t)f2bf(v.y); vb[2 * SEQ] = (bf16_t)f2bf(v.z); vb[3 * SEQ] = (bf16_t)f2bf(v.w); } } } }
    }
};
struct EpiX1 {
    static constexpr bool PERM = false;
    const float* x; float* X1;
    __device__ __forceinline__ void operator()(const f32x4 (&acc)[2][2][4][2], const Unit& u, int wr, int wc, int fr, int fq) const {
#pragma unroll
        for (int ai = 0; ai < 2; ++ai)
#pragma unroll
            for (int m = 0; m < 4; ++m) { const int row = u.pm * 256 + ai * 128 + wr * 64 + m * 16 + fr;
#pragma unroll
                for (int bj = 0; bj < 2; ++bj)
#pragma unroll
                    for (int n = 0; n < 2; ++n) { const size_t o = (size_t)row * D + u.pn * 256 + bj * 128 + wc * 32 + 16 * n + 4 * fq;
                        *(f32x4*)(X1 + o) = *(const f32x4*)(x + o) + acc[ai][bj][m][n]; } }
    }
};
struct EpiAct {
    static constexpr bool PERM = true;
    unsigned char* ACT; const float* b1;
    __device__ __forceinline__ void operator()(const f32x4 (&acc)[2][2][4][2], const Unit& u, int wr, int wc, int fr, int fq) const {
        const float* bb = b1 + (size_t)u.e * 2048;
#pragma unroll
        for (int bj = 0; bj < 2; ++bj) { const int col = u.pn * 256 + bj * 128 + wc * 32 + 8 * fq;
            const f32x4 bv0 = *(const f32x4*)(bb + col), bv1 = *(const f32x4*)(bb + col + 4);
#pragma unroll
            for (int ai = 0; ai < 2; ++ai)
#pragma unroll
                for (int m = 0; m < 4; ++m) { const int row = u.pm * 256 + ai * 128 + wr * 64 + m * 16 + fr;
                    const f32x4 v0 = acc[ai][bj][m][0] * 0.03125f + bv0, v1 = acc[ai][bj][m][1] * 0.03125f + bv1;
                    float g[4] = {v0.x, v0.z, v1.x, v1.z}, l[4] = {v0.y, v0.w, v1.y, v1.w}, a[4];
#pragma unroll
                    for (int i = 0; i < 4; ++i) { const float xg = fminf(g[i], 7.f), xl = fminf(fmaxf(l[i], -7.f), 7.f); a[i] = xg * sigmoidf_(1.702f * xg) * (xl + 1.f); }
                    *(unsigned*)(ACT + (unsigned)(row * DFF + (col >> 1))) = pk4_fp8(a[0], a[1], a[2], a[3]);
                    __builtin_amdgcn_sched_barrier(0); } }
    }
};
struct EpiY {
    static constexpr bool PERM = true;
    bf16_t* Y; const float* b2;
    __device__ __forceinline__ void operator()(const f32x4 (&acc)[2][2][4][2], const Unit& u, int wr, int wc, int fr, int fq) const {
        const float* bb = b2 + (size_t)u.e * 1024;
#pragma unroll
        for (int bj = 0; bj < 2; ++bj) { const int col = u.pn * 256 + bj * 128 + wc * 32 + 8 * fq;
            const f32x4 bv0 = *(const f32x4*)(bb + col), bv1 = *(const f32x4*)(bb + col + 4);
#pragma unroll
            for (int ai = 0; ai < 2; ++ai)
#pragma unroll
                for (int m = 0; m < 4; ++m) { const int row = u.pm * 256 + ai * 128 + wr * 64 + m * 16 + fr;
                    const f32x4 v0 = acc[ai][bj][m][0] * 0.03125f + bv0, v1 = acc[ai][bj][m][1] * 0.03125f + bv1;
                    u32x4 o; o.x = pk2(v0.x, v0.y); o.y = pk2(v0.z, v0.w); o.z = pk2(v1.x, v1.y); o.w = pk2(v1.z, v1.w);
                    *(u32x4*)(Y + (size_t)row * D + col) = o;
                    __builtin_amdgcn_sched_barrier(0); } }
    }
};

struct MoeOrder1 {
    static constexpr bool GATHER = false;
    const char* XG; const char* W1T; const LAS int* tstart; const LAS int* xs; int G, c;
    __device__ __forceinline__ bool next(int i, Unit& u) const {
        const int x = c & 7, j = i * (G >> 3) + (c >> 3); const int t = j >> 3;
        const int x1 = __builtin_amdgcn_readfirstlane(xs[1]), x2 = __builtin_amdgcn_readfirstlane(xs[2]), x3 = __builtin_amdgcn_readfirstlane(xs[3]), x4 = __builtin_amdgcn_readfirstlane(xs[4]);
        if (t >= x4) return false;
        const int jj = (t >= x3) ? 3 : ((t >= x2) ? 2 : ((t >= x1) ? 1 : 0)); const int base = (jj == 3) ? x3 : ((jj == 2) ? x2 : ((jj == 1) ? x1 : 0));
        const int e = x + 8 * jj;
        u.pm = __builtin_amdgcn_readfirstlane(tstart[e]) + (t - base); u.pn = j & 7; u.e = e;
        u.A = XG + (size_t)u.pm * 256 * 1024; u.B = W1T + ((size_t)e * 2048 + (size_t)u.pn * 256) * 1024; return true;
    }
    __device__ __forceinline__ int row_src(const Unit&, int) const { return 0; }
};
struct MoeOrder2 {
    static constexpr bool GATHER = false;
    const char* ACT; const char* W2T; const LAS int* tstart; const LAS int* xs; int G, c;
    __device__ __forceinline__ bool next(int i, Unit& u) const {
        const int x = c & 7, j = i * (G >> 3) + (c >> 3); const int t = j >> 2;
        const int x1 = __builtin_amdgcn_readfirstlane(xs[1]), x2 = __builtin_amdgcn_readfirstlane(xs[2]), x3 = __builtin_amdgcn_readfirstlane(xs[3]), x4 = __builtin_amdgcn_readfirstlane(xs[4]);
        if (t >= x4) return false;
        const int jj = (t >= x3) ? 3 : ((t >= x2) ? 2 : ((t >= x1) ? 1 : 0)); const int base = (jj == 3) ? x3 : ((jj == 2) ? x2 : ((jj == 1) ? x1 : 0));
        const int e = x + 8 * jj;
        u.pm = __builtin_amdgcn_readfirstlane(tstart[e]) + (t - base); u.pn = j & 3; u.e = e;
        u.A = ACT + (size_t)u.pm * 256 * 1024; u.B = W2T + ((size_t)e * 1024 + (size_t)u.pn * 256) * 1024; return true;
    }
    __device__ __forceinline__ int row_src(const Unit&, int) const { return 0; }
};

__device__ __forceinline__ void transpose_tile(const float* W, int K, int N, bf16_t* WT, int kb, int nb, unsigned char* smem, int tid) {
    float* tile = (float*)smem;
    const int k0 = 64 * kb, n0 = 256 * nb, n4 = tid & 63, kr = tid >> 6;
    f32x4 v[8];
#pragma unroll
    for (int i = 0; i < 8; ++i) { const int k = kr + 8 * i; v[i] = (n0 + 4 * n4 < N) ? *(const f32x4*)(W + (size_t)(k0 + k) * N + n0 + 4 * n4) : (f32x4){0.f, 0.f, 0.f, 0.f}; }
    __syncthreads();
#pragma unroll
    for (int i = 0; i < 8; ++i) { const int k = kr + 8 * i; *(f32x4*)(tile + k * 260 + ((4 * n4) ^ (8 * (k >> 3)))) = v[i]; }
    __syncthreads();
#pragma unroll
    for (int j = 0; j < 4; ++j) { const int c = tid + 512 * j, n = c >> 3, kc = c & 7; const float* src = tile + (8 * kc) * 260 + (n ^ (8 * kc));
        u32x4 o; o.x = pk2(src[0], src[260]); o.y = pk2(src[2 * 260], src[3 * 260]); o.z = pk2(src[4 * 260], src[5 * 260]); o.w = pk2(src[6 * 260], src[7 * 260]);
        *(u32x4*)(WT + (size_t)(n0 + n) * K + k0 + 8 * kc) = o; }
}
__device__ __forceinline__ void transpose_tile_fp8(const float* W, int K, int N, unsigned char* WT, int kb, int nb, float scale, unsigned char* smem, int tid) {
    float* tile = (float*)smem;
    const int k0 = 64 * kb, n0 = 256 * nb, n4 = tid & 63, kr = tid >> 6;
    f32x4 v[8];
#pragma unroll
    for (int i = 0; i < 8; ++i) { const int k = kr + 8 * i; v[i] = *(const f32x4*)(W + (size_t)(k0 + k) * N + n0 + 4 * n4) * scale; }
    __syncthreads();
#pragma unroll
    for (int i = 0; i < 8; ++i) { const int k = kr + 8 * i; *(f32x4*)(tile + k * 260 + ((4 * n4) ^ (8 * (k >> 3)))) = v[i]; }
    __syncthreads();
#pragma unroll
    for (int j = 0; j < 2; ++j) { const int c = tid + 512 * j, n = c >> 2, kc = c & 3;
        const float* s0 = tile + (16 * kc) * 260 + (n ^ (8 * (2 * kc))); const float* s1 = tile + (16 * kc + 8) * 260 + (n ^ (8 * (2 * kc + 1)));
        u32x4 o; o.x = pk4_fp8(s0[0], s0[260], s0[2 * 260], s0[3 * 260]); o.y = pk4_fp8(s0[4 * 260], s0[5 * 260], s0[6 * 260], s0[7 * 260]);
        o.z = pk4_fp8(s1[0], s1[260], s1[2 * 260], s1[3 * 260]); o.w = pk4_fp8(s1[4 * 260], s1[5 * 260], s1[6 * 260], s1[7 * 260]);
        *(u32x4*)(WT + (size_t)(n0 + n) * K + k0 + 16 * kc) = o; }
}
constexpr int TT_W1 = 128, TT_W2 = 64, TT_TOTAL = NE * TT_W1 + NE * TT_W2;
struct TTile { const float* src; unsigned char* dst; int N; };
__device__ __forceinline__ TTile tt_decode(const Params& P, int it, int n4, int kr) {
    TTile t;
    if (it < NE * TT_W1) { const int e = it >> 7, r = it & 127, kb = r >> 3, nb = r & 7; t.N = 2048;
        t.src = P.w1 + (size_t)e * D * 2048 + (size_t)(64 * kb + kr) * 2048 + 256 * nb + 4 * n4; t.dst = P.ws + WS_W1 + (size_t)e * 2048 * D + (size_t)(256 * nb) * D + 64 * kb; }
    else { const int i2 = it - NE * TT_W1, e = i2 >> 6, r = i2 & 63, kb = r >> 2, nb = r & 3; t.N = 1024;
        t.src = P.w2 + (size_t)e * DFF * D + (size_t)(64 * kb + kr) * 1024 + 256 * nb + 4 * n4; t.dst = P.ws + WS_W2 + (size_t)e * D * DFF + (size_t)(256 * nb) * DFF + 64 * kb; }
    return t;
}
__device__ __forceinline__ void late_transposes(const Params& P, unsigned char* smem, unsigned* qh, volatile LAS unsigned* misc, int tid) {
    float* tile = (float*)smem;
    const int n4 = tid & 63, kr = tid >> 6;
    __syncthreads();
    if (tid == 0) misc[8] = atomicAdd(qh, 1u);
    __syncthreads();
    int cur = (int)misc[8];
    if (cur >= TT_TOTAL) return;
    f32x4 v[8]; TTile tc = tt_decode(P, cur, n4, kr);
#pragma unroll
    for (int i = 0; i < 8; ++i) v[i] = *(const f32x4*)(tc.src + (size_t)(8 * i) * tc.N);
    for (;;) {
        if (tid == 0) misc[8] = atomicAdd(qh, 1u);
        __syncthreads();
        const int nxt = (int)misc[8];
#pragma unroll
        for (int i = 0; i < 8; ++i) { const int k = kr + 8 * i; *(f32x4*)(tile + k * 260 + ((4 * n4) ^ (8 * (k >> 3)))) = v[i] * 32.f; }
        TTile tn = tc;
        if (nxt < TT_TOTAL) { tn = tt_decode(P, nxt, n4, kr);
#pragma unroll
            for (int i = 0; i < 8; ++i) v[i] = *(const f32x4*)(tn.src + (size_t)(8 * i) * tn.N); }
        __syncthreads();
#pragma unroll
        for (int j = 0; j < 2; ++j) { const int c = tid + 512 * j, n = c >> 2, kc = c & 3;
            const float* s0 = tile + (16 * kc) * 260 + (n ^ (8 * (2 * kc))); const float* s1 = tile + (16 * kc + 8) * 260 + (n ^ (8 * (2 * kc + 1)));
            u32x4 o; o.x = pk4_fp8(s0[0], s0[260], s0[2 * 260], s0[3 * 260]); o.y = pk4_fp8(s0[4 * 260], s0[5 * 260], s0[6 * 260], s0[7 * 260]);
            o.z = pk4_fp8(s1[0], s1[260], s1[2 * 260], s1[3 * 260]); o.w = pk4_fp8(s1[4 * 260], s1[5 * 260], s1[6 * 260], s1[7 * 260]);
            *(u32x4*)(tc.dst + (size_t)n * 1024 + 16 * kc) = o; }
        if (nxt >= TT_TOTAL) break;
        cur = nxt; tc = tn;
    }
}

__device__ __forceinline__ void phase0(const Params& P, unsigned char* smem) {
    unsigned char* ws = P.ws;
    const int tid_ = opaque_tid(), lane = tid_ & 63, wave = tid_ >> 6, gw = blockIdx.x * NWAVES + wave, ngw = gridDim.x * NWAVES;
    float* slab = (float*)(smem + 73728);
    for (int i = tid_; i < 1024 * 8; i += NTHREADS) slab[i] = P.w_in[(size_t)(i >> 3) * DIN + 2048 + (i & 7)];
    __syncthreads();
    bf16_t* H = (bf16_t*)(ws + WS_H); float* AB = (float*)(ws + WS_AB);
    for (int row = gw; row < T; row += ngw) {
        const f32x4* xr = (const f32x4*)(P.x + (size_t)row * D) + lane;
        f32x4 v[4]; float ss = 0.f;
#pragma unroll
        for (int j = 0; j < 4; ++j) { v[j] = xr[64 * j]; ss += v[j].x * v[j].x + v[j].y * v[j].y + v[j].z * v[j].z + v[j].w * v[j].w; }
        const float rstd = rsqrtf(wave_sum(ss) * (1.f / D) + EPS);
        float acc[8];
#pragma unroll
        for (int c = 0; c < 8; ++c) acc[c] = 0.f;
#pragma unroll
        for (int j = 0; j < 4; ++j) {
            const f32x4 w = *((const f32x4*)P.norm_mix_w + lane + 64 * j);
            v[j] = v[j] * rstd * w;
            u32x2 o; o.x = pk2(v[j].x, v[j].y); o.y = pk2(v[j].z, v[j].w);
            *((u32x2*)(H + (size_t)row * D) + lane + 64 * j) = o;
#pragma unroll
            for (int i = 0; i < 4; ++i) { const float* sw = slab + (size_t)(4 * lane + 256 * j + i) * 8; const f32x4 w0 = *(const f32x4*)sw, w1 = *(const f32x4*)(sw + 4); const float hv = v[j][i];
                acc[0] += hv * w0.x; acc[1] += hv * w0.y; acc[2] += hv * w0.z; acc[3] += hv * w0.w; acc[4] += hv * w1.x; acc[5] += hv * w1.y; acc[6] += hv * w1.z; acc[7] += hv * w1.w; }
        }
#pragma unroll
        for (int c = 0; c < 8; ++c) acc[c] = wave_sum(acc[c]);
        if (lane == 0) { *(f32x4*)(AB + (size_t)row * 8) = (f32x4){acc[0], acc[1], acc[2], acc[3]}; *(f32x4*)(AB + (size_t)row * 8 + 4) = (f32x4){acc[4], acc[5], acc[6], acc[7]}; }
    }
    __syncthreads();
    for (int it = blockIdx.x; it < 274; it += gridDim.x) {
        if (it >= 210) transpose_tile(P.w_out, D, D, (bf16_t*)(ws + WS_WOUT), (it - 210) >> 2, (it - 210) & 3, smem, tid_);
        else if (it < 176) transpose_tile(P.w_in, D, DIN, (bf16_t*)(ws + WS_WIN), it / 11, it % 11, smem, tid_);
        else if (it < 194) transpose_tile(P.w_uq, QL, 768, (bf16_t*)(ws + WS_WUQ), (it - 176) / 3, (it - 176) % 3, smem, tid_);
        else transpose_tile(P.w_ukv, KVL, 1024, (bf16_t*)(ws + WS_WUKV), (it - 194) >> 2, (it - 194) & 3, smem, tid_);
    }
}

__constant__ float c_inv_freq[16] = {1.0f, 0.5623413324356079f, 0.3162277638912201f, 0.17782793939113617f, 0.10000000149011612f, 0.05623413249850273f, 0.03162277489900589f,
    0.017782794311642647f, 0.009999999776482582f, 0.005623413249850273f, 0.003162277629598975f, 0.0017782794311642647f, 0.0010000000474974513f, 0.000562341301701963f,
    0.0003162277571391314f, 0.00017782794020604342f};
__device__ __forceinline__ void phase2a(const Params& P) {
    unsigned char* ws = P.ws;
    const int tid_ = opaque_tid(), lane = tid_ & 63, gw = blockIdx.x * NWAVES + (tid_ >> 6), ngw = gridDim.x * NWAVES;
    const bf16_t* PROJ = (const bf16_t*)(ws + WS_PROJ); bf16_t* CQN = (bf16_t*)(ws + WS_CQN); bf16_t* CKVN = (bf16_t*)(ws + WS_CKVN);
    bf16_t* Kp = (bf16_t*)(ws + WS_K); float* tab = (float*)(ws + WS_TAB);
    for (int row = gw; row < T; row += ngw) {
        const bf16_t* pr = PROJ + (size_t)row * DINP; const int b = row / SEQ, s = row % SEQ;
        {
            unsigned a[3]; float ss = 0.f;
#pragma unroll
            for (int j = 0; j < 3; ++j) { a[j] = *(const unsigned*)(pr + C_CQ + 2 * (lane + 64 * j)); const float lo = bflo(a[j]), hi = bfhi(a[j]); ss += lo * lo + hi * hi; }
            const float rstd = rsqrtf(wave_sum(ss) * (1.f / QL) + EPS);
#pragma unroll
            for (int j = 0; j < 3; ++j) { const int idx = 2 * (lane + 64 * j); *(unsigned*)(CQN + (size_t)row * QL + idx) = pk2(bflo(a[j]) * rstd * P.q_norm_w[idx], bfhi(a[j]) * rstd * P.q_norm_w[idx + 1]); }
        }
        {
            unsigned a[2]; float ss = 0.f;
#pragma unroll
            for (int j = 0; j < 2; ++j) { a[j] = *(const unsigned*)(pr + C_CKV + 2 * (lane + 64 * j)); const float lo = bflo(a[j]), hi = bfhi(a[j]); ss += lo * lo + hi * hi; }
            const float rstd = rsqrtf(wave_sum(ss) * (1.f / KVL) + EPS);
#pragma unroll
            for (int j = 0; j < 2; ++j) { const int idx = 2 * (lane + 64 * j); *(unsigned*)(CKVN + (size_t)row * KVL + idx) = pk2(bflo(a[j]) * rstd * P.kv_norm_w[idx], bfhi(a[j]) * rstd * P.kv_norm_w[idx + 1]); }
        }
        if (lane < 16) {
            const float x1 = bf1(pr[C_KR + lane]), x2 = bf1(pr[C_KR + 16 + lane]);
            const float ang = (float)P.pos[row] * c_inv_freq[lane];
            double tt = (double)ang * 0.15915494309189535; tt -= floor(tt);
            if (tt > 0.5) tt -= 1.0;
            const float ar = (float)(tt * 6.283185307179586);
            const float cs = __cosf(ar), sn = __sinf(ar);
            tab[(size_t)row * 32 + lane] = cs; tab[(size_t)row * 32 + 16 + lane] = sn;
            const bf16_t o1 = (bf16_t)f2bf(x1 * cs - x2 * sn), o2 = (bf16_t)f2bf(x2 * cs + x1 * sn);
#pragma unroll
            for (int h = 0; h < MH; ++h) { bf16_t* kp = Kp + ((size_t)(b * MH + h) * SEQ + s) * DQK + 64; kp[lane] = o1; kp[16 + lane] = o2; }
        }
    }
}

__device__ __forceinline__ float softplusf_(float x) { return fmaxf(x, 0.f) + log1pf(__expf(-fabsf(x))); }
__device__ __forceinline__ void gdn_prep_item(const Params& P, unsigned char* smem, int item) {
    unsigned char* ws = P.ws;
    const int tid = opaque_tid(), wave = tid >> 6, lane = tid & 63;
    const int n = item % NCH, hh = (item / NCH) % GH, b = item / (NCH * GH);
    const bf16_t* PROJ = (const bf16_t*)(ws + WS_PROJ); const float* AB = (const float*)(ws + WS_AB);
    unsigned char* gp = ws + WS_GP + (size_t)item * GP_ITEM;
    float* Ug = (float*)(gp + GP_U); bf16_t* Wg = (bf16_t*)(gp + GP_W); bf16_t* QDg = (bf16_t*)(gp + GP_QD); bf16_t* KDTg = (bf16_t*)(gp + GP_KDT); bf16_t* QKg = (bf16_t*)(gp + GP_QK);
    float* qs = (float*)smem; float* ks = qs + 64 * 132; float* vs = ks + 64 * 132; float* Am = vs + 64 * 132;
    float* sbeta = Am + 64 * 68; float* sG = sbeta + 64; float* seG = sG + 64; float* sekd = seG + 64;
    __syncthreads();
    if (tid < 384) {
        const int rg = tid / 48, c8 = tid % 48, which = c8 >> 4, cc = (c8 & 15) * 8, gc = which * 512 + hh * 128 + cc;
        float wv[4][8];
#pragma unroll
        for (int j = 0; j < 4; ++j) { const f32x4 a = *(const f32x4*)(P.conv_w + j * 1536 + gc), c = *(const f32x4*)(P.conv_w + j * 1536 + gc + 4);
            wv[j][0] = a.x; wv[j][1] = a.y; wv[j][2] = a.z; wv[j][3] = a.w; wv[j][4] = c.x; wv[j][5] = c.y; wv[j][6] = c.z; wv[j][7] = c.w; }
        u32x4 raw[11];
#pragma unroll
        for (int i = 0; i < 11; ++i) { const int t = 64 * n + 8 * rg - 3 + i;
            raw[i] = (t >= 0) ? *(const u32x4*)(PROJ + (size_t)(b * SEQ + t) * DINP + gc) : (u32x4){0u, 0u, 0u, 0u}; }
        float* dst = qs + which * (64 * 132) + (8 * rg) * 132 + cc;
#pragma unroll
        for (int rr = 0; rr < 8; ++rr) {
            float y[8];
#pragma unroll
            for (int d = 0; d < 4; ++d) { float ya = 0.f, yb = 0.f;
#pragma unroll
                for (int j = 0; j < 4; ++j) { const unsigned u = raw[rr + j][d]; ya += wv[j][2 * d] * bflo(u); yb += wv[j][2 * d + 1] * bfhi(u); }
                y[2 * d] = ya * sigmoidf_(ya); y[2 * d + 1] = yb * sigmoidf_(yb); }
            *(f32x4*)(dst + rr * 132) = (f32x4){y[0], y[1], y[2], y[3]}; *(f32x4*)(dst + rr * 132 + 4) = (f32x4){y[4], y[5], y[6], y[7]};
        }
    } else if (tid >= 448) {
        const int r = lane; const size_t tok = (size_t)b * SEQ + 64 * n + r;
        const float a = AB[tok * 8 + hh], bb = AB[tok * 8 + 4 + hh];
        const float g = -__expf(P.a_log[hh]) * softplusf_(a + P.dt_bias[hh]);
        float G = g;
#pragma unroll
        for (int o = 1; o < 64; o <<= 1) { const float up = __shfl_up(G, o); if (lane >= o) G += up; }
        const float Gl = __shfl(G, 63);
        sbeta[r] = sigmoidf_(bb); sG[r] = G; seG[r] = __expf(G); sekd[r] = __expf(Gl - G);
        if (lane == 0) ((float*)(ws + WS_GT))[item] = __expf(Gl);
    }
    __syncthreads();
    for (int p = wave; p < 128; p += NWAVES) {
        const int which = p >> 6, r = p & 63; float* row = qs + which * (64 * 132) + r * 132;
        const float a0 = row[2 * lane], a1 = row[2 * lane + 1];
        const float ss = wave_sum(a0 * a0 + a1 * a1);
        const float sc = rsqrtf(ss + EPS) * (which == 0 ? 0.08838834764831845f : 1.f);
        row[2 * lane] = a0 * sc; row[2 * lane + 1] = a1 * sc;
    }
    for (int idx = tid; idx < 6 * 256; idx += NTHREADS) {
        const int u = idx >> 8, w = idx & 255; const int I = (u < 3) ? 0 : (u < 5 ? 1 : 2), J = (u < 3) ? u + 1 : (u < 5 ? u - 1 : 3);
        QKg[(16 * I + (w >> 4)) * 64 + perm32k(16 * J + (w & 15))] = 0;
    }
    __syncthreads();
    for (int job = wave; job < 20; job += NWAVES) {
        const int kind = job / 10, p = job % 10; const int I = (p < 1) ? 0 : (p < 3 ? 1 : (p < 6 ? 2 : 3)); const int J = p - (I * (I + 1)) / 2;
        const float* Ar = (kind ? qs : ks) + (16 * I + (lane & 15)) * 132 + (lane >> 4);
        const float* Br = ks + (16 * J + (lane & 15)) * 132 + (lane >> 4);
        f32x4 acc = {0.f, 0.f, 0.f, 0.f};
#pragma unroll 8
        for (int s = 0; s < 32; ++s) acc = __builtin_amdgcn_mfma_f32_16x16x4f32(Ar[4 * s], Br[4 * s], acc, 0, 0, 0);
        const int j = 16 * J + (lane & 15);
#pragma unroll
        for (int r = 0; r < 4; ++r) { const int i = 16 * I + 4 * (lane >> 4) + r;
            const float dec = (i >= j) ? __expf(sG[i] - sG[j]) : 0.f;
            if (kind == 0) Am[i * 68 + j] = (i > j) ? sbeta[i] * acc[r] * dec : 0.f;
            else QKg[i * 64 + perm32k(j)] = (bf16_t)f2bf((i >= j) ? acc[r] * dec : 0.f); }
    }
    __syncthreads();
    if (wave < 4) {
        if (lane < 16) {
            const int i0_ = 16 * wave, c = lane; float Tc[16];
            const LAS float* AmL = (const LAS float*)Am + i0_ * 68 + i0_; asm volatile("" : "+v"(AmL));
#pragma unroll
            for (int i = 0; i < 16; ++i) { float a = (i == c) ? 1.f : 0.f;
#pragma unroll
                for (int j = 0; j < i; ++j) a -= AmL[i * 68 + j] * Tc[j];
                Tc[i] = a; asm volatile("" : "+v"(Tc[i])); }
#pragma unroll
            for (int i = 0; i < 16; ++i) Am[(i0_ + i) * 68 + i0_ + c] = Tc[i];
        }
    } else {
        const int t2 = tid - 256;
        for (int idx = t2; idx < 64 * 64; idx += 256) { const int i = idx >> 6, d = (idx & 63) * 2; *(unsigned*)(QDg + i * 128 + perm32k(d)) = pk2(qs[i * 132 + d] * seG[i], qs[i * 132 + d + 1] * seG[i]); }
        for (int idx = t2; idx < 128 * 32; idx += 256) { const int d = idx >> 5, cc = (idx & 31) * 2; *(unsigned*)(KDTg + d * 64 + perm32k(cc)) = pk2(ks[cc * 132 + d] * sekd[cc], ks[(cc + 1) * 132 + d] * sekd[cc + 1]); }
    }
    __syncthreads();
    for (int idx = tid; idx < 64 * 32; idx += NTHREADS) { const int i = idx >> 5, c4 = (idx & 31) * 4; const float bi = sbeta[i], bw = bi * seG[i];
        f32x4* pv = (f32x4*)(vs + i * 132 + c4); *pv = *pv * bi; f32x4* pk = (f32x4*)(ks + i * 132 + c4); *pk = *pk * bw; }
    __syncthreads();
    {
        const int rl = lane & 15, kk = lane >> 4;
        float* arr0 = (wave < 4 ? vs : ks) + ((2 * wave) & 7) * 16; float* arr1 = arr0 + 16;
#pragma unroll
        for (int i = 0; i < 4; ++i) {
            f32x4 acc0, acc1;
#pragma unroll
            for (int r = 0; r < 4; ++r) { acc0[r] = arr0[(16 * i + 4 * kk + r) * 132 + rl]; acc1[r] = arr1[(16 * i + 4 * kk + r) * 132 + rl]; }
#pragma unroll
            for (int j = 0; j < i; ++j)
#pragma unroll
                for (int sx = 0; sx < 4; ++sx) { const float a = -Am[(16 * i + rl) * 68 + 16 * j + 4 * sx + kk];
                    acc0 = __builtin_amdgcn_mfma_f32_16x16x4f32(a, arr0[(16 * j + 4 * sx + kk) * 132 + rl], acc0, 0, 0, 0);
                    acc1 = __builtin_amdgcn_mfma_f32_16x16x4f32(a, arr1[(16 * j + 4 * sx + kk) * 132 + rl], acc1, 0, 0, 0); }
#pragma unroll
            for (int r = 0; r < 4; ++r) { arr0[(16 * i + 4 * kk + r) * 132 + rl] = acc0[r]; arr1[(16 * i + 4 * kk + r) * 132 + rl] = acc1[r]; }
            asm volatile("s_waitcnt lgkmcnt(0)" ::: "memory");
            f32x4 o0 = {0.f, 0.f, 0.f, 0.f}, o1 = {0.f, 0.f, 0.f, 0.f};
#pragma unroll
            for (int sx = 0; sx < 4; ++sx) { const float a = Am[(16 * i + rl) * 68 + 16 * i + 4 * sx + kk];
                o0 = __builtin_amdgcn_mfma_f32_16x16x4f32(a, arr0[(16 * i + 4 * sx + kk) * 132 + rl], o0, 0, 0, 0);
                o1 = __builtin_amdgcn_mfma_f32_16x16x4f32(a, arr1[(16 * i + 4 * sx + kk) * 132 + rl], o1, 0, 0, 0); }
#pragma unroll
            for (int r = 0; r < 4; ++r) { arr0[(16 * i + 4 * kk + r) * 132 + rl] = o0[r]; arr1[(16 * i + 4 * kk + r) * 132 + rl] = o1[r]; }
            asm volatile("s_waitcnt lgkmcnt(0)" ::: "memory");
        }
    }
    __syncthreads();
    for (int idx = tid; idx < 2048; idx += NTHREADS) { const int e = idx & 15, g = (idx >> 4) & 3, m = (idx >> 6) & 3, w = idx >> 8; const float* src = vs + (16 * m + 4 * g) * 132 + 16 * w + e;
        u32x2 o; o.x = pk2(src[0], src[132]); o.y = pk2(src[2 * 132], src[3 * 132]); ((u32x2*)Ug)[idx] = o; }
    for (int idx = tid; idx < 64 * 64; idx += NTHREADS) { const int i = idx >> 6, d = (idx & 63) * 2; *(unsigned*)(Wg + i * 128 + perm32k(d)) = pk2(-ks[i * 132 + d], -ks[i * 132 + d + 1]); }
}

__device__ __forceinline__ void gdn_scan(const Params& P, unsigned char* smem, int bh) {
    unsigned char* ws = P.ws;
    const int tid = opaque_tid(), wave = tid >> 6, lane = tid & 63, e = lane & 15, g = lane >> 4;
    const float* GT = (const float*)(ws + WS_GT);
    constexpr int BUF = 36864, OW = 0, OKD = 18432;
    f32x4 S[8];
#pragma unroll
    for (int t = 0; t < 8; ++t) S[t] = (f32x4){0.f, 0.f, 0.f, 0.f};
    u32x4 st[2][4]; u32x2 un[2][4]; float gtn[2];
#define SCAN_GLOAD(p, n) do { const unsigned char* gp_ = ws + WS_GP + (size_t)(bh * NCH + (n)) * GP_ITEM; \
        _Pragma("unroll") for (int k = 0; k < 2; ++k) st[p][k] = *(const u32x4*)(gp_ + GP_W + (size_t)(tid + 512 * k) * 16); \
        _Pragma("unroll") for (int k = 0; k < 2; ++k) st[p][2 + k] = *(const u32x4*)(gp_ + GP_KDT + (size_t)(tid + 512 * k) * 16); \
        const u32x2* ug_ = (const u32x2*)(gp_ + GP_U) + wave * 256 + lane; \
        _Pragma("unroll") for (int m = 0; m < 4; ++m) un[p][m] = ug_[m * 64]; \
        gtn[p] = GT[bh * NCH + (n)]; } while (0)
#define SCAN_LWRITE(p, buf) do { unsigned char* L_ = smem + (buf) * BUF; \
        _Pragma("unroll") for (int k = 0; k < 2; ++k) { const int c = tid + 512 * k; *(u32x4*)(L_ + OW + (c >> 4) * 288 + (c & 15) * 16) = st[p][k]; } \
        _Pragma("unroll") for (int k = 0; k < 2; ++k) { const int c = tid + 512 * k; *(u32x4*)(L_ + OKD + (c >> 3) * 144 + (c & 7) * 16) = st[p][2 + k]; } } while (0)
    __syncthreads();
    SCAN_GLOAD(0, 0); SCAN_LWRITE(0, 0); SCAN_GLOAD(1, 1);
    __syncthreads();
    for (int n2 = 0; n2 < NCH; n2 += 2) {
#pragma unroll
      for (int p = 0; p < 2; ++p) {
        const int n = n2 + p;
        f32x4 av[4];
#pragma unroll
        for (int m = 0; m < 4; ++m) av[m] = (f32x4){bflo(un[p][m].x), bfhi(un[p][m].x), bflo(un[p][m].y), bfhi(un[p][m].y)};
        const float gt = gtn[p];
        if (n + 2 < NCH) SCAN_GLOAD(p, n + 2);
        const unsigned char* L = smem + p * BUF;
        bf16x8 Sb[4];
#pragma unroll
        for (int s = 0; s < 4; ++s) Sb[s] = pack8(S[2 * s], S[2 * s + 1]);
        {
            bf16x8* sb = (bf16x8*)(ws + WS_SB) + ((size_t)(bh * NCH + n) * 8 + wave) * 256 + lane;
#pragma unroll
            for (int s = 0; s < 4; ++s) sb[s * 64] = Sb[s];
        }
#pragma unroll
        for (int s = 0; s < 4; ++s)
#pragma unroll
            for (int m = 0; m < 4; ++m) {
                const bf16x8 wf = *(const bf16x8*)(L + OW + (16 * m + e) * 288 + (32 * s + 8 * g) * 2);
                av[m] = __builtin_amdgcn_mfma_f32_16x16x32_bf16(wf, Sb[s], av[m], 0, 0, 0);
            }
        bf16x8 Vb[2];
#pragma unroll
        for (int s = 0; s < 2; ++s) Vb[s] = pack8(av[2 * s], av[2 * s + 1]);
#pragma unroll
        for (int t = 0; t < 8; ++t) { S[t] = S[t] * gt;
#pragma unroll
            for (int s = 0; s < 2; ++s) {
                const bf16x8 df = *(const bf16x8*)(L + OKD + (16 * t + e) * 144 + (32 * s + 8 * g) * 2);
                S[t] = __builtin_amdgcn_mfma_f32_16x16x32_bf16(df, Vb[s], S[t], 0, 0, 0);
            } }
        if (n + 1 < NCH) SCAN_LWRITE(p ^ 1, p ^ 1);
        __syncthreads();
      }
    }
#undef SCAN_GLOAD
#undef SCAN_LWRITE
}

__device__ __forceinline__ void gdn_out_item(const Params& P, unsigned char* smem, int item) {
    unsigned char* ws = P.ws;
    const int tid = opaque_tid(), wave = tid >> 6, lane = tid & 63, e = lane & 15, g = lane >> 4;
    const int n = item % NCH, hh = (item / NCH) % GH, b = item / (NCH * GH);
    const unsigned char* gp = ws + WS_GP + (size_t)item * GP_ITEM;
    constexpr int OW = 0, OQD = 18432, OQK = 36864, OSS = 46080, ORS = OSS + 2048, OT = 49152;
    float* ssq = (float*)(smem + OSS); float* rs = (float*)(smem + ORS);
    u32x4 st[5];
#pragma unroll
    for (int k = 0; k < 2; ++k) st[k] = *(const u32x4*)(gp + GP_W + (size_t)(tid + 512 * k) * 16);
#pragma unroll
    for (int k = 0; k < 2; ++k) st[2 + k] = *(const u32x4*)(gp + GP_QD + (size_t)(tid + 512 * k) * 16);
    st[4] = *(const u32x4*)(gp + GP_QK + (size_t)tid * 16);
    bf16x8 Sb[4]; u32x2 un[4];
    {
        const bf16x8* sb = (const bf16x8*)(ws + WS_SB) + ((size_t)item * 8 + wave) * 256 + lane;
#pragma unroll
        for (int s = 0; s < 4; ++s) Sb[s] = sb[s * 64];
        const u32x2* ug = (const u32x2*)(gp + GP_U) + wave * 256 + lane;
#pragma unroll
        for (int m = 0; m < 4; ++m) un[m] = ug[m * 64];
    }
    __syncthreads();
#pragma unroll
    for (int k = 0; k < 2; ++k) { const int c = tid + 512 * k; *(u32x4*)(smem + OW + (c >> 4) * 288 + (c & 15) * 16) = st[k]; }
#pragma unroll
    for (int k = 0; k < 2; ++k) { const int c = tid + 512 * k; *(u32x4*)(smem + OQD + (c >> 4) * 288 + (c & 15) * 16) = st[2 + k]; }
    { const int c = tid; *(u32x4*)(smem + OQK + (c >> 3) * 144 + (c & 7) * 16) = st[4]; }
    __syncthreads();
    f32x4 av[4], ao[4];
#pragma unroll
    for (int m = 0; m < 4; ++m) { av[m] = (f32x4){bflo(un[m].x), bfhi(un[m].x), bflo(un[m].y), bfhi(un[m].y)}; ao[m] = (f32x4){0.f, 0.f, 0.f, 0.f}; }
#pragma unroll
    for (int s = 0; s < 4; ++s)
#pragma unroll
        for (int m = 0; m < 4; ++m) {
            const bf16x8 wf = *(const bf16x8*)(smem + OW + (16 * m + e) * 288 + (32 * s + 8 * g) * 2);
            const bf16x8 qf = *(const bf16x8*)(smem + OQD + (16 * m + e) * 288 + (32 * s + 8 * g) * 2);
            av[m] = __builtin_amdgcn_mfma_f32_16x16x32_bf16(wf, Sb[s], av[m], 0, 0, 0);
            ao[m] = __builtin_amdgcn_mfma_f32_16x16x32_bf16(qf, Sb[s], ao[m], 0, 0, 0);
        }
    bf16x8 Vb[2];
#pragma unroll
    for (int s = 0; s < 2; ++s) Vb[s] = pack8(av[2 * s], av[2 * s + 1]);
#pragma unroll
    for (int m = 0; m < 4; ++m)
#pragma unroll
        for (int s = 0; s < 2; ++s) {
            const bf16x8 kf = *(const bf16x8*)(smem + OQK + (16 * m + e) * 144 + (32 * s + 8 * g) * 2);
            ao[m] = __builtin_amdgcn_mfma_f32_16x16x32_bf16(kf, Vb[s], ao[m], 0, 0, 0);
        }
#pragma unroll
    for (int m = 0; m < 4; ++m)
#pragma unroll
        for (int r = 0; r < 4; ++r) { float q = ao[m][r] * ao[m][r];
            q += __shfl_xor(q, 1); q += __shfl_xor(q, 2); q += __shfl_xor(q, 4); q += __shfl_xor(q, 8);
            if (e == 0) ssq[wave * 64 + 16 * m + 4 * g + r] = q;
            *(bf16_t*)(smem + OT + (16 * m + 4 * g + r) * 272 + (16 * wave + e) * 2) = (bf16_t)f2bf(ao[m][r]); }
    __syncthreads();
    if (tid < 64) { float q = 0.f;
#pragma unroll
        for (int w = 0; w < 8; ++w) q += ssq[w * 64 + tid];
        rs[tid] = rsqrtf(q * (1.f / 128.f) + EPS); }
    __syncthreads();
    {
        const int row = tid >> 3, seg = tid & 7; const size_t tok = (size_t)b * SEQ + 64 * n + row;
        const u32x4* tp = (const u32x4*)(smem + OT + row * 272 + seg * 32);
        const u32x4 o0 = tp[0], o1 = tp[1];
        const u32x4* zp = (const u32x4*)((const bf16_t*)(ws + WS_PROJ) + tok * DINP + C_Z + hh * 128 + seg * 16);
        const u32x4 z0 = zp[0], z1 = zp[1];
        const float r_ = rs[row]; const float* gwp = P.gdn_norm_w + seg * 16;
        unsigned ov[8]; const unsigned oo[8] = {o0.x, o0.y, o0.z, o0.w, o1.x, o1.y, o1.z, o1.w}, zz[8] = {z0.x, z0.y, z0.z, z0.w, z1.x, z1.y, z1.z, z1.w};
#pragma unroll
        for (int i = 0; i < 8; ++i) { const float za = bflo(zz[i]), zb = bfhi(zz[i]);
            ov[i] = pk2(bflo(oo[i]) * r_ * gwp[2 * i] * za * sigmoidf_(za), bfhi(oo[i]) * r_ * gwp[2 * i + 1] * zb * sigmoidf_(zb)); }
        u32x4* op = (u32x4*)((bf16_t*)(ws + WS_OCAT) + tok * D + hh * 128 + seg * 16);
        op[0] = (u32x4){ov[0], ov[1], ov[2], ov[3]}; op[1] = (u32x4){ov[4], ov[5], ov[6], ov[7]};
    }
}

__device__ __forceinline__ void attn_item(const Params& P, unsigned char* smem, int item) {
    unsigned char* ws = P.ws;
    const int tid = opaque_tid(), wave = tid >> 6, lane = tid & 63, ql = lane & 31, hf = lane >> 5;
    const int qt = 15 - (item >> 5), bh = item & 31;
    const bf16_t* Qg = (const bf16_t*)(ws + WS_Q) + (size_t)bh * SEQ * DQK;
    const unsigned char* Kg = (const unsigned char*)((const bf16_t*)(ws + WS_K) + (size_t)bh * SEQ * DQK);
    const bf16_t* VTg = (const bf16_t*)(ws + WS_VT) + (size_t)bh * 64 * SEQ;
    bf16_t* OB = (bf16_t*)(ws + WS_OB);
    const int q0 = qt * 256 + 32 * wave;
    const int nkt_w = (q0 >> 6) + 1, nkt_b = 4 * qt + 4;
    constexpr int KB_ = 13312, VB_ = 9216, OK0 = 0, OV0 = 2 * KB_;
    bf16x8 qf[6];
#pragma unroll
    for (int ks = 0; ks < 6; ++ks) qf[ks] = *(const bf16x8*)(Qg + (size_t)(q0 + ql) * DQK + 16 * ks + 8 * hf);
    f32x16 o0, o1;
#pragma unroll
    for (int i = 0; i < 16; ++i) { o0[i] = 0.f; o1[i] = 0.f; }
    float mrun = -1e30f, lsum = 0.f;
    u32x4 sk0, sk1, sv;
    auto gload = [&](int kt) {
        const unsigned char* kp = Kg + (size_t)kt * 64 * DQK * 2;
        sk0 = *(const u32x4*)(kp + (size_t)tid * 16);
        if (tid < 256) sk1 = *(const u32x4*)(kp + (size_t)(tid + 512) * 16);
        sv = *(const u32x4*)(VTg + (size_t)(tid >> 3) * SEQ + kt * 64 + (tid & 7) * 8);
    };
    auto lwrite = [&](int buf) {
        { const int c = tid; *(u32x4*)(smem + OK0 + buf * KB_ + (c / 12) * 208 + (c % 12) * 16) = sk0; }
        if (tid < 256) { const int c = tid + 512; *(u32x4*)(smem + OK0 + buf * KB_ + (c / 12) * 208 + (c % 12) * 16) = sk1; }
        *(u32x4*)(smem + OV0 + buf * VB_ + (tid >> 3) * 144 + (tid & 7) * 16) = sv;
    };
    __syncthreads();
    gload(0); lwrite(0);
    __syncthreads();
    for (int kt = 0; kt < nkt_b; ++kt) {
        if (kt + 1 < nkt_b) gload(kt + 1);
        if (kt < nkt_w) {
            const unsigned char* Kl = smem + OK0 + (kt & 1) * KB_; const unsigned char* Vl = smem + OV0 + (kt & 1) * VB_;
            f32x16 s0, s1;
#pragma unroll
            for (int i = 0; i < 16; ++i) { s0[i] = 0.f; s1[i] = 0.f; }
#pragma unroll
            for (int ks = 0; ks < 6; ++ks) {
                const bf16x8 k0 = *(const bf16x8*)(Kl + ql * 208 + (16 * ks + 8 * hf) * 2);
                const bf16x8 k1 = *(const bf16x8*)(Kl + (32 + ql) * 208 + (16 * ks + 8 * hf) * 2);
                s0 = __builtin_amdgcn_mfma_f32_32x32x16_bf16(k0, qf[ks], s0, 0, 0, 0);
                s1 = __builtin_amdgcn_mfma_f32_32x32x16_bf16(k1, qf[ks], s1, 0, 0, 0);
            }
            float mx = s0[0];
#pragma unroll
            for (int i = 1; i < 16; ++i) mx = fmaxf(mx, s0[i]);
#pragma unroll
            for (int i = 0; i < 16; ++i) mx = fmaxf(mx, s1[i]);
            mx = fmaxf(mx, __shfl_xor(mx, 32));
            const float mnew = fmaxf(mrun, mx), alpha = __builtin_amdgcn_exp2f(mrun - mnew);
            mrun = mnew;
            float ps = 0.f;
#pragma unroll
            for (int i = 0; i < 16; ++i) { s0[i] = __builtin_amdgcn_exp2f(s0[i] - mnew); s1[i] = __builtin_amdgcn_exp2f(s1[i] - mnew); ps += s0[i] + s1[i]; }
            lsum = lsum * alpha + ps;
#pragma unroll
            for (int i = 0; i < 16; ++i) { o0[i] *= alpha; o1[i] *= alpha; }
            bf16x8 pb[2][2];
#pragma unroll
            for (int sp = 0; sp < 2; ++sp) {
                pb[0][sp] = pack8((f32x4){s0[8 * sp], s0[8 * sp + 1], s0[8 * sp + 2], s0[8 * sp + 3]}, (f32x4){s0[8 * sp + 4], s0[8 * sp + 5], s0[8 * sp + 6], s0[8 * sp + 7]});
                pb[1][sp] = pack8((f32x4){s1[8 * sp], s1[8 * sp + 1], s1[8 * sp + 2], s1[8 * sp + 3]}, (f32x4){s1[8 * sp + 4], s1[8 * sp + 5], s1[8 * sp + 6], s1[8 * sp + 7]});
            }
#pragma unroll
            for (int u = 0; u < 2; ++u)
#pragma unroll
                for (int sp = 0; sp < 2; ++sp) {
                    const bf16x8 v0 = *(const bf16x8*)(Vl + ql * 144 + (32 * u + 16 * sp + 8 * hf) * 2);
                    const bf16x8 v1 = *(const bf16x8*)(Vl + (32 + ql) * 144 + (32 * u + 16 * sp + 8 * hf) * 2);
                    o0 = __builtin_amdgcn_mfma_f32_32x32x16_bf16(v0, pb[u][sp], o0, 0, 0, 0);
                    o1 = __builtin_amdgcn_mfma_f32_32x32x16_bf16(v1, pb[u][sp], o1, 0, 0, 0);
                }
        }
        if (kt + 1 < nkt_b) lwrite((kt + 1) & 1);
        __syncthreads();
    }
    lsum += __shfl_xor(lsum, 32);
    const float inv = 1.f / lsum;
    const int b = bh >> 3, h = bh & 7;
    bf16_t* orow = OB + ((size_t)b * SEQ + q0 + ql) * 512 + h * 64;
#pragma unroll
    for (int r = 0; r < 16; ++r) { const int dv = (r & 3) + 8 * (r >> 2) + 4 * hf; orow[dv] = (bf16_t)f2bf(o0[r] * inv); orow[32 + dv] = (bf16_t)f2bf(o1[r] * inv); }
}

__device__ __forceinline__ void phase5(const Params& P) {
    unsigned char* ws = P.ws;
    const int tid_ = opaque_tid(), lane = tid_ & 63, gw = blockIdx.x * NWAVES + (tid_ >> 6), ngw = gridDim.x * NWAVES;
    const bf16_t* OB = (const bf16_t*)(ws + WS_OB); bf16_t* OCAT = (bf16_t*)(ws + WS_OCAT);
    for (int tq = gw; tq < T / 4; tq += ngw) {
        const int t0 = 4 * tq;
#pragma unroll
        for (int r = 0; r < 4; ++r) {
            const size_t row = (size_t)t0 + r;
            const u32x4 v = *((const u32x4*)(OB + row * 512) + lane);
            float f[8] = {bflo(v.x), bfhi(v.x), bflo(v.y), bfhi(v.y), bflo(v.z), bfhi(v.z), bflo(v.w), bfhi(v.w)};
            float ss = 0.f;
#pragma unroll
            for (int i = 0; i < 8; ++i) ss += f[i] * f[i];
            const float rstd = rsqrtf(wave_sum(ss) * (1.f / 512.f) + EPS);
            const float* wn = P.mla_out_norm_w + 8 * lane;
            u32x4 o; o.x = pk2(f[0] * rstd * wn[0], f[1] * rstd * wn[1]); o.y = pk2(f[2] * rstd * wn[2], f[3] * rstd * wn[3]); o.z = pk2(f[4] * rstd * wn[4], f[5] * rstd * wn[5]); o.w = pk2(f[6] * rstd * wn[6], f[7] * rstd * wn[7]);
            *((u32x4*)(OCAT + row * D + 512) + lane) = o;
        }
    }
}

__device__ __forceinline__ void phase7(const Params& P, unsigned char* smem) {
    unsigned char* ws = P.ws;
    const int tid = opaque_tid(), wave = tid >> 6, lane = tid & 63;
    float* rw = (float*)smem;
    int* lctl = (int*)(smem + LDS_MISC + 256);
    float* lgs = (float*)(smem + LDS_MISC + 256 + 2560);
    for (int i = tid; i < 1024 * 8; i += NTHREADS) { const int k = i >> 3, c = i & 7; const f32x4 v = *(const f32x4*)(P.router_w + (size_t)k * 32 + 4 * c) * P.norm_ffn_w[k];
        *(f32x4*)(rw + k * 32 + ((4 * c + 16 * ((k >> 2) & 1)) & 31)) = v; }
    const float* X1 = (const float*)(ws + WS_X1); unsigned char* H2 = ws + WS_H;
    int* tok_e = (int*)(ws + WS_TOKE); int* tok_r = (int*)(ws + WS_TOKR); float* gate = (float*)(ws + WS_GATE);
    unsigned* cnt = (unsigned*)(ws + WS_CTL) + CW_CNT;
    for (int tg = blockIdx.x; tg < T / 64; tg += gridDim.x) {
    __syncthreads();
    if (tid < 64) lctl[tid] = 0;
    __syncthreads();
    if (wave < 4) {
        const int ti = lane & 15, kk = lane >> 4; const int row = tg * 64 + wave * 16 + ti;
        const f32x4* xr = (const f32x4*)(X1 + (size_t)row * D) + kk;
        const float* bw = rw + (4 * kk) * 32 + (((lane & 15) + 16 * (kk & 1)) & 31);
        f32x4 a0 = {0.f, 0.f, 0.f, 0.f}, a1 = {0.f, 0.f, 0.f, 0.f}; float ss = 0.f;
#pragma unroll 1
        for (int sb = 0; sb < 64; sb += 8) {
            f32x4 xv[8];
#pragma unroll
            for (int u = 0; u < 8; ++u) xv[u] = xr[4 * (sb + u)];
#pragma unroll
            for (int u = 0; u < 8; ++u) { ss += xv[u].x * xv[u].x + xv[u].y * xv[u].y + xv[u].z * xv[u].z + xv[u].w * xv[u].w;
#pragma unroll
                for (int j = 0; j < 4; ++j) { const float* bp = bw + (16 * (sb + u) + j) * 32; const float b0 = bp[0], b1 = *(const float*)((const char*)bp + ((((lane & 15) + 16 * (kk & 1)) & 16) ? -64 : 64));
                    a0 = __builtin_amdgcn_mfma_f32_16x16x4f32(xv[u][j], b0, a0, 0, 0, 0);
                    a1 = __builtin_amdgcn_mfma_f32_16x16x4f32(xv[u][j], b1, a1, 0, 0, 0); } }
        }
        ss += __shfl_xor(ss, 16); ss += __shfl_xor(ss, 32);
        const float rstd = rsqrtf(ss * (1.f / D) + EPS);
        float* lg = lgs + wave * (16 * 33);
#pragma unroll
        for (int r = 0; r < 4; ++r) { const int t = 4 * kk + r; const float rs = __shfl(rstd, t);
            lg[t * 33 + (lane & 15)] = a0[r] * rs + P.router_b[lane & 15]; lg[t * 33 + 16 + (lane & 15)] = a1[r] * rs + P.router_b[16 + (lane & 15)]; }
        asm volatile("s_waitcnt lgkmcnt(0)" ::: "memory");
        if (lane < 16) {
            const float* l = lg + lane * 33; const int trow = tg * 64 + wave * 16 + lane;
            int ei[4]; float ev[4];
#pragma unroll
            for (int k = 0; k < 4; ++k) { float best = -3.0e38f; int bi = 0;
                for (int j = 0; j < 32; ++j) { const float v = l[j]; const bool taken = (k > 0 && ei[0] == j) || (k > 1 && ei[1] == j) || (k > 2 && ei[2] == j); if (!taken && v > best) { best = v; bi = j; } }
                ei[k] = bi; ev[k] = best; }
            float gs = 0.f, gv[4];
#pragma unroll
            for (int k = 0; k < 4; ++k) { gv[k] = __expf(ev[k] - ev[0]); gs += gv[k]; }
            const float ig = 1.f / gs;
#pragma unroll
            for (int k = 0; k < 4; ++k) { const int lr = atomicAdd(&lctl[ei[k]], 1);
                lctl[64 + ((wave * 16 + lane) * 4 + k) * 2] = ei[k]; lctl[64 + ((wave * 16 + lane) * 4 + k) * 2 + 1] = lr; }
            *(f32x4*)(gate + (size_t)trow * 4) = (f32x4){gv[0] * ig, gv[1] * ig, gv[2] * ig, gv[3] * ig};
        }
    } else {
        for (int ti = 0; ti < 16; ++ti) { const int row = tg * 64 + (wave - 4) * 16 + ti;
            f32x4 v[4]; float ss = 0.f;
#pragma unroll
            for (int j = 0; j < 4; ++j) { v[j] = *((const f32x4*)(X1 + (size_t)row * D) + lane + 64 * j); ss += v[j].x * v[j].x + v[j].y * v[j].y + v[j].z * v[j].z + v[j].w * v[j].w; }
            const float rstd = rsqrtf(wave_sum(ss) * (1.f / D) + EPS);
#pragma unroll
            for (int j = 0; j < 4; ++j) { const f32x4 h = v[j] * rstd * *((const f32x4*)P.norm_ffn_w + lane + 64 * j);
                *((unsigned*)(H2 + (size_t)row * D) + lane + 64 * j) = pk4_fp8(h.x, h.y, h.z, h.w); }
        }
    }
    __syncthreads();
    if (tid < 32) lctl[32 + tid] = (int)atomicAdd(&cnt[tid], (unsigned)lctl[tid]);
    __syncthreads();
    if (tid < 256) { const int e = lctl[64 + tid * 2], lr = lctl[64 + tid * 2 + 1]; const int row = tg * 64 + (tid >> 2); const int rank = lctl[32 + e] + lr;
        tok_e[(size_t)row * 4 + (tid & 3)] = e; tok_r[(size_t)row * 4 + (tid & 3)] = rank; }
    }
}

__device__ __forceinline__ void moe_tiles(const Params& P, unsigned char* smem) {
    int* tstart = (int*)(smem + LDS_MISC + 256); int* cntl = tstart + 64;
    const unsigned* cnt = (const unsigned*)(P.ws + WS_CTL) + CW_CNT;
    __syncthreads();
    if (threadIdx.x == 0) { int acc = 0; for (int e = 0; e < NE; ++e) { const int c = (int)__hip_atomic_load(&cnt[e], __ATOMIC_RELAXED, __HIP_MEMORY_SCOPE_AGENT); cntl[e] = c; tstart[e] = acc; acc += (c + 255) >> 8; } tstart[NE] = acc;
        int* xs = tstart + 100; const int x = blockIdx.x & 7; int a2 = 0; for (int j = 0; j < 4; ++j) { xs[j] = a2; a2 += (cntl[x + 8 * j] + 255) >> 8; } xs[4] = a2; }
    __syncthreads();
}

__device__ __forceinline__ void phase8(const Params& P, unsigned char* smem) {
    unsigned char* ws = P.ws;
    const int tid_ = opaque_tid(), lane = tid_ & 63, gw = blockIdx.x * NWAVES + (tid_ >> 6), ngw = gridDim.x * NWAVES;
    const int* tstart = (const int*)(smem + LDS_MISC + 256);
    const int* tok_e = (const int*)(ws + WS_TOKE); const int* tok_r = (const int*)(ws + WS_TOKR);
    const unsigned char* H2 = ws + WS_H; unsigned char* XG = ws + WS_XG;
    for (int row = gw; row < T; row += ngw) {
        const u32x4 v = *((const u32x4*)(H2 + (size_t)row * D) + lane);
#pragma unroll
        for (int k = 0; k < 4; ++k) { const int e = tok_e[(size_t)row * 4 + k], rk = tok_r[(size_t)row * 4 + k];
            *((u32x4*)(XG + (size_t)(tstart[e] * 256 + rk) * D) + lane) = v; }
    }
}

__device__ __forceinline__ void phase11(const Params& P, unsigned char* smem) {
    unsigned char* ws = P.ws;
    const int tid_ = opaque_tid(), lane = tid_ & 63, gw = blockIdx.x * NWAVES + (tid_ >> 6), ngw = gridDim.x * NWAVES;
#if LEVEL >= 2
    const float* X1 = (const float*)(ws + WS_X1);
#else
    const float* X1 = P.x;
#endif
#if LEVEL >= 4
    const int* tstart = (const int*)(smem + LDS_MISC + 256);
    const int* tok_e = (const int*)(ws + WS_TOKE); const int* tok_r = (const int*)(ws + WS_TOKR); const float* gate = (const float*)(ws + WS_GATE); const bf16_t* Y = (const bf16_t*)(ws + WS_Y);
#endif
    for (int row = gw; row < T; row += ngw) {
        f32x4 v[4];
#pragma unroll
        for (int j = 0; j < 4; ++j) v[j] = *((const f32x4*)(X1 + (size_t)row * D) + lane + 64 * j);
#if LEVEL >= 4
#pragma unroll
        for (int k = 0; k < 4; ++k) { const int e = tok_e[(size_t)row * 4 + k], rk = tok_r[(size_t)row * 4 + k]; const float gg = gate[(size_t)row * 4 + k];
            const bf16_t* yr = Y + (size_t)(tstart[e] * 256 + rk) * D;
#pragma unroll
            for (int j = 0; j < 4; ++j) { const u32x2 yy = *((const u32x2*)yr + lane + 64 * j); v[j].x += gg * bflo(yy.x); v[j].y += gg * bfhi(yy.x); v[j].z += gg * bflo(yy.y); v[j].w += gg * bfhi(yy.y); } }
#endif
        float ss = 0.f;
#pragma unroll
        for (int j = 0; j < 4; ++j) ss += v[j].x * v[j].x + v[j].y * v[j].y + v[j].z * v[j].z + v[j].w * v[j].w;
        const float rstd = rsqrtf(wave_sum(ss) * (1.f / D) + EPS);
#pragma unroll
        for (int j = 0; j < 4; ++j) *((f32x4*)(P.out + (size_t)row * D) + lane + 64 * j) = v[j] * rstd * *((const f32x4*)P.norm_final_w + lane + 64 * j);
    }
}

extern "C" __global__ void __launch_bounds__(NTHREADS) fwd_megakernel(Params P) {
    extern __shared__ __attribute__((aligned(16))) unsigned char smem[];
    LAS unsigned char* lds = (LAS unsigned char*)smem;
    unsigned char* ws = P.ws;
    const int tid = threadIdx.x;
    const int G = gridDim.x, bid = blockIdx.x;
    volatile LAS unsigned* misc = (volatile LAS unsigned*)(lds + LDS_MISC);
    if (tid < 64) misc[tid] = 0u;
    __syncthreads();
    XcdBarrier bar = xcd_barrier_post((unsigned*)(ws + WS_CTL) + CW_BAR, misc);
#if TSA >= 0
    unsigned long long* tsw = (unsigned long long*)((unsigned*)(ws + WS_CTL) + CW_TS); int tsi = 0;
#define STAMP() do { if (bid == 0 && tid == 0) tsw[tsi] = __builtin_amdgcn_s_memrealtime(); ++tsi; } while (0)
#else
#define STAMP() do { } while (0)
#endif
#define GRID_BAR() do { xcd_barrier(bar); STAMP(); } while (0)
    STAMP();

    REP(0) phase0(P, smem);
    GRID_BAR();
#if LEVEL >= 2
    REP(1) {
        pg8::DenseOrder S{(const char*)(ws + WS_H), (const char*)(ws + WS_WIN), T / 256, DINP / 256, D, G, bid};
        EpiProj E{(bf16_t*)(ws + WS_PROJ)};
        pg8::gemm_phase<EpiProj, pg8::DenseOrder>(lds, D, S, E);
    }
    GRID_BAR();
    REP(2) phase2a(P);
#if LEVEL >= 3
    REP(12) for (int item = bid; item < NB * GH * NCH; item += G) gdn_prep_item(P, smem, item);
#endif
    GRID_BAR();
    REP(3) {
        pg8::DenseOrder S{(const char*)(ws + WS_CQN), (const char*)(ws + WS_WUQ), T / 256, 768 / 256, QL, G, bid};
        EpiQ E{(bf16_t*)(ws + WS_Q), (const float*)(ws + WS_TAB)};
        pg8::gemm_phase<EpiQ, pg8::DenseOrder>(lds, QL, S, E);
        pg8::DenseOrder S2{(const char*)(ws + WS_CKVN), (const char*)(ws + WS_WUKV), T / 256, 1024 / 256, KVL, G, (bid + 64) % G};
        EpiKV E2{(bf16_t*)(ws + WS_K), (bf16_t*)(ws + WS_VT)};
        pg8::gemm_phase<EpiKV, pg8::DenseOrder>(lds, KVL, S2, E2);
    }
    GRID_BAR();
    {
        REP(14) if (bid < NB * GH) gdn_scan(P, smem, bid);
#if TSA >= 0
        if (bid == 0 && tid == 0) { tsw[20] = tsw[tsi - 1]; tsw[21] = __builtin_amdgcn_s_memrealtime(); }
#endif
        const int tidq = opaque_tid();
        const bool tfirst = ((bid & 7) >= 5);
        for (int rep_ = 0; rep_ < ((DUP == 4 || DUP == 15) ? 2 : 1); ++rep_)
#pragma unroll 1
        for (int pass = 0; pass < 2; ++pass) {
            unsigned* aq = (unsigned*)(ws + WS_CTL) + CW_AQ + 128 * rep_;
            const bool do_t = (pass == 0) == tfirst;
            unsigned* qh = aq + (do_t ? 64 : 0);
            const int qn = do_t ? 0 : ((rep_ == 1 && DUP == 15) ? 0 : 512);
            if (do_t) { if (!(rep_ == 1 && DUP == 4)) late_transposes(P, smem, qh, misc, tidq); continue; }
            for (;;) {
                __syncthreads();
                if (tidq == 0) misc[8] = atomicAdd(qh, 1u);
                __syncthreads();
                const int item = (int)misc[8];
                if (item >= qn) break;
                attn_item(P, smem, item);
            }
        }
    }
    GRID_BAR();
    REP(5) { phase5(P); for (int item = bid; item < NB * GH * NCH; item += G) gdn_out_item(P, smem, item); }
    GRID_BAR();
    REP(6) {
        pg8::DenseOrder S{(const char*)(ws + WS_OCAT), (const char*)(ws + WS_WOUT), T / 256, D / 256, D, G, bid};
        EpiX1 E{P.x, (float*)(ws + WS_X1)};
        pg8::gemm_phase<EpiX1, pg8::DenseOrder>(lds, D, S, E);
    }
    GRID_BAR();
#endif
#if LEVEL >= 4
    phase7(P, smem);
    GRID_BAR();
    moe_tiles(P, smem);
    phase8(P, smem);
    GRID_BAR();
    REP(9) {
        const LAS int* ts = (const LAS int*)(lds + LDS_MISC + 256);
        MoeOrder1 S{(const char*)(ws + WS_XG), (const char*)(ws + WS_W1), ts, ts + 100, G, bid};
        EpiAct E{ws + WS_ACT, P.b1};
        pg8::gemm_phase<EpiAct, MoeOrder1, true>(lds, D, S, E);
    }
    GRID_BAR();
    REP(10) {
        const LAS int* ts = (const LAS int*)(lds + LDS_MISC + 256);
        MoeOrder2 S{(const char*)(ws + WS_ACT), (const char*)(ws + WS_W2), ts, ts + 100, G, bid};
        EpiY E{(bf16_t*)(ws + WS_Y), P.b2};
        pg8::gemm_phase<EpiY, MoeOrder2, true>(lds, DFF, S, E);
    }
    GRID_BAR();
#endif
    REP(11) phase11(P, smem);
#if TSA >= 0
    if (bid == 0) {
        __syncthreads();
        if (tid == 0) { const unsigned long long dt = tsw[TSA + 1] - tsw[TSA], t0 = __builtin_amdgcn_s_memrealtime();
            while (__builtin_amdgcn_s_memrealtime() - t0 < dt) __builtin_amdgcn_s_sleep(8); }
        __syncthreads();
    }
#endif
}

extern "C" void kernel_launch(void* const* d_in, const int* in_sizes, int n_in, void* d_out, int out_size, void* d_ws, size_t ws_size, hipStream_t stream) {
    static int grid = 0;
    if (grid == 0) {
        if (n_in != 22 || in_sizes[0] != T * D || out_size != T * D || ws_size < WS_END) {
            fprintf(stderr, "kernel_launch: unexpected shapes (n_in %d, in0 %d, out %d, ws %zu < %zu)\n", n_in, n_in > 0 ? in_sizes[0] : -1, out_size, ws_size, (size_t)WS_END); grid = -1; return; }
        int dev = 0, cus = 0, per_cu = 0;
        if (hipGetDevice(&dev) != hipSuccess || hipDeviceGetAttribute(&cus, hipDeviceAttributeMultiprocessorCount, dev) != hipSuccess) { grid = -1; return; }
        if (hipFuncSetAttribute((const void*)fwd_megakernel, hipFuncAttributeMaxDynamicSharedMemorySize, LDS_BYTES) != hipSuccess) { fprintf(stderr, "kernel_launch: hipFuncSetAttribute failed\n"); grid = -1; return; }
        if (hipOccupancyMaxActiveBlocksPerMultiprocessor(&per_cu, (const void*)fwd_megakernel, NTHREADS, LDS_BYTES) != hipSuccess || per_cu < 1) { fprintf(stderr, "kernel_launch: occupancy query says %d\n", per_cu); (void)hipGetLastError(); grid = -1; return; }
        grid = cus;
        if (grid != 256) fprintf(stderr, "kernel_launch: note: %d CUs\n", grid);
    }
    if (grid < 0) return;
    (void)hipMemsetAsync((char*)d_ws + WS_CTL, 0, CTL_BYTES, stream);
    Params p{};
    p.x = (const float*)d_in[0]; p.pos = (const int*)d_in[1]; p.norm_mix_w = (const float*)d_in[2]; p.w_in = (const float*)d_in[3]; p.conv_w = (const float*)d_in[4];
    p.a_log = (const float*)d_in[5]; p.dt_bias = (const float*)d_in[6]; p.gdn_norm_w = (const float*)d_in[7]; p.q_norm_w = (const float*)d_in[8]; p.w_uq = (const float*)d_in[9];
    p.kv_norm_w = (const float*)d_in[10]; p.w_ukv = (const float*)d_in[11]; p.mla_out_norm_w = (const float*)d_in[12]; p.w_out = (const float*)d_in[13]; p.norm_ffn_w = (const float*)d_in[14];
    p.router_w = (const float*)d_in[15]; p.router_b = (const float*)d_in[16]; p.w1 = (const float*)d_in[17]; p.b1 = (const float*)d_in[18]; p.w2 = (const float*)d_in[19];
    p.b2 = (const float*)d_in[20]; p.norm_final_w = (const float*)d_in[21]; p.out = (float*)d_out; p.ws = (unsigned char*)d_ws;
    void* args[] = {&p};
    hipError_t e = hipLaunchCooperativeKernel((const void*)fwd_megakernel, dim3(grid), dim3(NTHREADS), args, LDS_BYTES, stream);
    if (e != hipSuccess) fprintf(stderr, "kernel_launch: cooperative launch failed: %s (grid %d)\n", hipGetErrorString(e), grid);
}
```

```cpp
#include <hip/hip_runtime.h>
#include <cstdio>
#include <cstdint>

#ifndef LEVEL
#define LEVEL 4
#endif

#ifndef DUP
#define DUP -1
#endif
#ifndef TSA
#define TSA -1
#define TSB -1
#endif
#define REP(k) for (int rep_ = 0; rep_ < ((DUP == (k)) ? 2 : 1); ++rep_)
#define LAS __attribute__((address_space(3)))
typedef unsigned short bf16_t;
typedef short bf16x8 __attribute__((ext_vector_type(8)));
typedef float f32x4 __attribute__((ext_vector_type(4)));
typedef float f32x16 __attribute__((ext_vector_type(16)));
typedef unsigned u32x4 __attribute__((ext_vector_type(4)));
typedef unsigned u32x2 __attribute__((ext_vector_type(2)));

constexpr int NB = 4, SEQ = 4096, T = NB * SEQ, D = 1024, DIN = 2728, DINP = 2816;
constexpr int GH = 4, NCH = SEQ / 64;
constexpr int MH = 8, DQK = 96, QL = 384, KVL = 256;
constexpr int NE = 32, DFF = 1024;
constexpr int C_Z = 1536, C_CQ = 2056, C_CKV = 2440, C_KR = 2696;
constexpr float EPS = 1e-6f;
constexpr int NTHREADS = 512, NWAVES = 8;
constexpr int LDS_BYTES = 147456;
constexpr int LDS_MISC = 131072;
constexpr int MOE_MAXROWS = 73728;

constexpr size_t MiB = 1u << 20;
constexpr size_t WS_CTL = 0, CTL_BYTES = 65536;
constexpr size_t WS_WIN = 1 * MiB, WS_WUQ = 7 * MiB, WS_WUKV = 8 * MiB, WS_WOUT = 9 * MiB, WS_W1 = 11 * MiB, WS_W2 = 139 * MiB;
constexpr size_t WS_X1 = 203 * MiB, WS_H = 267 * MiB, WS_AB = 299 * MiB, WS_TAB = 300 * MiB;
constexpr size_t WS_TOKE = 302 * MiB, WS_TOKR = WS_TOKE + 256 * 1024, WS_GATE = WS_TOKR + 256 * 1024, WS_LIST = 303 * MiB;
constexpr size_t WS_R = 306 * MiB;
constexpr size_t WS_PROJ = WS_R, WS_CQN = WS_R + 88 * MiB, WS_CKVN = WS_R + 100 * MiB, WS_Q = WS_R + 108 * MiB, WS_K = WS_R + 132 * MiB, WS_VT = WS_R + 156 * MiB;
constexpr size_t WS_GP = WS_R + 172 * MiB;
constexpr size_t GP_ITEM = 90112, GP_U = 0, GP_W = 32768, GP_QD = 49152, GP_KDT = 65536, GP_QK = 81920;
constexpr size_t WS_GT = WS_R + 260 * MiB, WS_OA = WS_R + 261 * MiB, WS_OB = WS_R + 293 * MiB, WS_OCAT = WS_R + 309 * MiB;
constexpr size_t WS_ACT = WS_R, WS_Y = WS_R + 144 * MiB, WS_XG = WS_R + 288 * MiB;
constexpr size_t WS_SB = WS_R + 341 * MiB;
constexpr size_t WS_END = WS_R + 373 * MiB;
constexpr int CW_BAR = 4096, CW_CNT = 8192  , CW_AQ = 8320  , CW_TS = 12288  ;

struct Params {
    const float* x; const int* pos; const float* norm_mix_w; const float* w_in; const float* conv_w; const float* a_log; const float* dt_bias;
    const float* gdn_norm_w; const float* q_norm_w; const float* w_uq; const float* kv_norm_w; const float* w_ukv; const float* mla_out_norm_w;
    const float* w_out; const float* norm_ffn_w; const float* router_w; const float* router_b; const float* w1; const float* b1; const float* w2;
    const float* b2; const float* norm_final_w; float* out; unsigned char* ws;
};

typedef float f32x2v __attribute__((ext_vector_type(2)));
typedef __bf16 bf16x2v __attribute__((ext_vector_type(2)));
__device__ __forceinline__ unsigned pk2(float lo, float hi) { const f32x2v v = {lo, hi}; return __builtin_bit_cast(unsigned, __builtin_convertvector(v, bf16x2v)); }
__device__ __forceinline__ unsigned f2bf(float f) { return pk2(f, 0.f) & 0xffffu; }
__device__ __forceinline__ unsigned pk4_fp8(float a, float b, float c, float d) { unsigned w = 0u; w = __builtin_amdgcn_cvt_pk_fp8_f32(a, b, w, false); w = __builtin_amdgcn_cvt_pk_fp8_f32(c, d, w, true); return w; }
typedef int v4i_t __attribute__((ext_vector_type(4)));
typedef int v8i_t __attribute__((ext_vector_type(8)));
__device__ __forceinline__ float bflo(unsigned u) { return __builtin_bit_cast(float, u << 16); }
__device__ __forceinline__ float bfhi(unsigned u) { return __builtin_bit_cast(float, u & 0xffff0000u); }
__device__ __forceinline__ float bf1(bf16_t b) { return __builtin_bit_cast(float, (unsigned)b << 16); }
__device__ __forceinline__ float wave_sum(float v) {
#pragma unroll
    for (int o = 1; o < 64; o <<= 1) v += __shfl_xor(v, o);
    return v;
}
__device__ __forceinline__ int opaque_tid() { int t = threadIdx.x; asm volatile("" : "+v"(t)); return t; }
__device__ __forceinline__ float sigmoidf_(float x) { return __builtin_amdgcn_rcpf(1.f + __builtin_amdgcn_exp2f(-1.4426950408889634f * x)); }
__device__ __forceinline__ bf16x8 pack8(f32x4 a, f32x4 b) {
    u32x4 r; r.x = pk2(a.x, a.y); r.y = pk2(a.z, a.w); r.z = pk2(b.x, b.y); r.w = pk2(b.z, b.w);
    return __builtin_bit_cast(bf16x8, r);
}
__device__ __forceinline__ int perm32k(int d) { return (d & ~31) | (((d >> 2) & 3) << 3) | (((d >> 4) & 1) << 2) | (d & 3); }
__device__ __forceinline__ int perm16v(int s) { return (s & ~15) | (((s >> 2) & 1) << 3) | (((s >> 3) & 1) << 2) | (s & 3); }

#define XB_TMO      128
#define XB_XCNT(j)  (256  + 64 * (j))
#define XB_XSUB(j)  (1280 + 64 * (j))
#define XB_XGEN(j)  (2304 + 64 * (j))
#define XB_TOP      3328
#define XB_TOPGEN   3392
#define XCD_BAR_WORDS 3456
#define XB_SPIN_CAP (1u << 18)
__device__ __forceinline__ unsigned xb_ld(unsigned* p)              { return __hip_atomic_load(p, __ATOMIC_RELAXED, __HIP_MEMORY_SCOPE_AGENT); }
__device__ __forceinline__ unsigned xb_add(unsigned* p, unsigned v) { return __hip_atomic_fetch_add(p, v, __ATOMIC_RELAXED, __HIP_MEMORY_SCOPE_AGENT); }
__device__ __forceinline__ unsigned xb_xcc_id() { return (unsigned)__builtin_amdgcn_s_getreg((3 << 11) | 20) & 0xFu; }
#define XB_SPIN(cond, bar) do { unsigned _sp = 0; while (cond) { __builtin_amdgcn_s_sleep(1); \
    if ((++_sp & 255u) == 0u) { if (xb_ld(&(bar)[XB_TMO])) break; if (_sp > XB_SPIN_CAP) { atomicAdd(&(bar)[XB_TMO], 1u); break; } } } } while (0)
struct XcdBarrier { unsigned* bar; unsigned x; volatile LAS unsigned* st; };
__device__ __forceinline__ XcdBarrier xcd_barrier_post(unsigned* bar, volatile LAS unsigned* st) {
    XcdBarrier b; b.bar = bar; b.x = xb_xcc_id(); b.st = st;
    if (threadIdx.x == 0) (void)xb_add(&bar[XB_XCNT(b.x)], 1u);
    return b;
}
__device__ __forceinline__ void xcd_barrier_complete(unsigned* bar, unsigned x, unsigned& nloc, unsigned& nx) {
    const unsigned G = gridDim.x * gridDim.y * gridDim.z;
    unsigned sum, cnt, mine, sp = 0u;
    for (;;) {
        sum = 0u; cnt = 0u; mine = 0u;
#pragma unroll
        for (unsigned j = 0; j < 16; ++j) { const unsigned c = xb_ld(&bar[XB_XCNT(j)]); sum += c; cnt += (c > 0u) ? 1u : 0u; mine = (j == x) ? c : mine; }
        if (sum == G) break;
        __builtin_amdgcn_s_sleep(1);
        if ((++sp & 255u) == 0u) { if (xb_ld(&bar[XB_TMO])) break; if (sp > XB_SPIN_CAP) { atomicAdd(&bar[XB_TMO], 1u); break; } }
    }
    nloc = mine > 0u ? mine : 1u; nx = cnt > 0u ? cnt : 1u;
}
__device__ __forceinline__ void xcd_barrier(const XcdBarrier& b) {
    asm volatile("s_waitcnt vmcnt(0)" ::: "memory");
    __syncthreads();
    if (threadIdx.x == 0) {
        unsigned* bar = b.bar;
        __builtin_amdgcn_s_waitcnt(0);
        unsigned nloc = b.st[0], nx = b.st[1];
        if (nloc == 0u) { xcd_barrier_complete(bar, b.x, nloc, nx); b.st[0] = nloc; b.st[1] = nx; }
        const unsigned old = xb_add(&bar[XB_XSUB(b.x)], 1u);
        const unsigned gen = old / nloc;
        if (old + 1u == (gen + 1u) * nloc) {
            __builtin_amdgcn_fence(__ATOMIC_RELEASE, "agent");
            asm volatile("s_waitcnt vmcnt(0)" ::: "memory");
            const unsigned og = xb_add(&bar[XB_TOP], 1u);
            const unsigned tg = og / nx;
            if (og + 1u == (tg + 1u) * nx) xb_add(&bar[XB_TOPGEN], 1u);
            else XB_SPIN(xb_ld(&bar[XB_TOPGEN]) == tg, bar);
            __builtin_amdgcn_fence(__ATOMIC_ACQUIRE, "agent");
            xb_add(&bar[XB_XGEN(b.x)], 1u);
            asm volatile("s_waitcnt vmcnt(0)" ::: "memory");
        } else {
            XB_SPIN(xb_ld(&bar[XB_XGEN(b.x)]) == gen, bar);
            __builtin_amdgcn_fence(__ATOMIC_ACQUIRE, "agent");
            asm volatile("s_waitcnt vmcnt(0)" ::: "memory");
        }
    }
    __syncthreads();
}

namespace pg8 {
constexpr int BM = 256, BK = 64, HALF = 128, HTB = HALF * BK * 2, NXCD = 8, WGM = 8;
__device__ __forceinline__ int lds_byte(int r, int c) { const int st = (r >> 4) * 2 + (c >> 5), rr = r & 15, cc = c & 31, ob = rr * 64 + cc * 2; return st * 1024 + (ob ^ (((ob >> 9) & 1) << 5)); }
__device__ __forceinline__ void stage_rc(int b, int& R, int& C) { const int st = b / 1024, sb = b % 1024, swz = sb ^ (((sb >> 9) & 1) << 5); R = (st >> 1) * 16 + swz / 64; C = (st & 1) * 32 + (swz % 64) / 2; }
__device__ __forceinline__ int perm32(int rho) { const int n = rho >> 4, i = rho & 15; return 8 * (i >> 2) + 4 * n + (i & 3); }

struct Unit { int pm, pn, e; const char* A; const char* B; };

__device__ __forceinline__ void tile_order(int L, int nM, int nN, int& pm, int& pn) {
    const int nwg = nM * nN; int wgid = L;
    { const int q = nwg / NXCD, r = nwg % NXCD, xcd = wgid % NXCD, off = wgid / NXCD; wgid = (xcd < r ? xcd * (q + 1) : r * (q + 1) + (xcd - r) * q) + off; }
    const int nig = WGM * nN, gid = wgid / nig, fm = gid * WGM, gsz = (nM - fm) < WGM ? (nM - fm) : WGM;
    pm = fm + ((wgid % nig) % gsz); pn = (wgid % nig) / gsz;
}

template <class Epi, class Sched, bool FP8 = false>
__device__ __forceinline__ void gemm_phase(LAS unsigned char* lds, const int K, const Sched& S, const Epi& E) {
    const int tid = opaque_tid(), wid = __builtin_amdgcn_readfirstlane(tid >> 6), lane = tid & 63, wr = wid >> 2, wc = wid & 3, fr = lane & 15, fq = lane >> 4;
    const int RB = FP8 ? K : 2 * K;
    const int nt = RB / 128;
    int Rr[2], Cc[2];
    unsigned voffB[2];
#pragma unroll
    for (int i = 0; i < 2; ++i) { stage_rc(tid * 16 + i * 8192, Rr[i], Cc[i]); const int Rb = Epi::PERM ? ((Rr[i] & ~31) + perm32(Rr[i] & 31)) : Rr[i]; voffB[i] = (unsigned)(Rb * RB + Cc[i] * 2); }
    const size_t kstep = (size_t)(BK * 2);
    const unsigned hstep = (unsigned)HALF * RB;
    const unsigned ldsw = (unsigned)wid * 1024u;
    const int aoff = lds_byte(wr * 64 + fr, fq * 8), boff = lds_byte(wc * 32 + fr, fq * 8);
#define PG8_SA(b, h) (((b) * 2 + (h)) * HTB)
#define PG8_SB(b, h) ((4 + (b) * 2 + (h)) * HTB)
#define PG8_RS(p) __builtin_amdgcn_make_buffer_rsrc((void*)(p), 0, 0x7fffffff, 0x00020000)
#define PG8_STAGE_A(bufoff, base, kb, h, VO) do { const auto rs_ = PG8_RS(base); _Pragma("unroll") for (int _i = 0; _i < 2; ++_i) \
        __builtin_amdgcn_raw_ptr_buffer_load_lds(rs_, (LAS void*)(lds + (bufoff) + ldsw + _i * 8192), 16, (int)(VO)[Sched::GATHER ? (h) : 0][_i], (int)((kb) + (Sched::GATHER ? 0u : (h) * hstep)), 0, 0); } while (0)
#define PG8_STAGE_B(bufoff, base, kb, h) do { const auto rs_ = PG8_RS(base); _Pragma("unroll") for (int _i = 0; _i < 2; ++_i) \
        __builtin_amdgcn_raw_ptr_buffer_load_lds(rs_, (LAS void*)(lds + (bufoff) + ldsw + _i * 8192), 16, (int)voffB[_i], (int)((kb) + (h) * hstep), 0, 0); } while (0)
#define PG8_LDA(dst, b, h) do { if constexpr (FP8) { _Pragma("unroll") for (int m = 0; m < 4; ++m) { const v4i_t x0_ = *(const LAS v4i_t*)(lds + PG8_SA(b, h) + aoff + m * 2048), x1_ = *(const LAS v4i_t*)(lds + PG8_SA(b, h) + aoff + m * 2048 + 1024); \
            dst##8[m] = __builtin_shufflevector(x0_, x1_, 0, 1, 2, 3, 4, 5, 6, 7); } } \
        else { _Pragma("unroll") for (int m = 0; m < 4; ++m) _Pragma("unroll") for (int k = 0; k < 2; ++k) dst[m][k] = *(const LAS bf16x8*)(lds + PG8_SA(b, h) + aoff + m * 2048 + k * 1024); } } while (0)
#define PG8_LDB(dst, b, h) do { if constexpr (FP8) { _Pragma("unroll") for (int n = 0; n < 2; ++n) { const v4i_t x0_ = *(const LAS v4i_t*)(lds + PG8_SB(b, h) + boff + n * 2048), x1_ = *(const LAS v4i_t*)(lds + PG8_SB(b, h) + boff + n * 2048 + 1024); \
            dst##8[n] = __builtin_shufflevector(x0_, x1_, 0, 1, 2, 3, 4, 5, 6, 7); } } \
        else { _Pragma("unroll") for (int n = 0; n < 2; ++n) _Pragma("unroll") for (int k = 0; k < 2; ++k) dst[n][k] = *(const LAS bf16x8*)(lds + PG8_SB(b, h) + boff + n * 2048 + k * 1024); } } while (0)
#define PG8_MMA(ai, bj, At, Bt) do { __builtin_amdgcn_s_setprio(1); \
        if constexpr (FP8) { _Pragma("unroll") for (int m = 0; m < 4; ++m) _Pragma("unroll") for (int n = 0; n < 2; ++n) \
            asm volatile("v_mfma_f32_16x16x128_f8f6f4 %0, %1, %2, %0" : "+v"(acc[ai][bj][m][n]) : "v"(Bt##8[n]), "v"(At##8[m])); } \
        else { _Pragma("unroll") for (int m = 0; m < 4; ++m) _Pragma("unroll") for (int n = 0; n < 2; ++n) _Pragma("unroll") for (int k = 0; k < 2; ++k) \
            acc[ai][bj][m][n] = __builtin_amdgcn_mfma_f32_16x16x32_bf16(Bt[n][k], At[m][k], acc[ai][bj][m][n], 0, 0, 0); } \
        __builtin_amdgcn_s_setprio(0); } while (0)
#define PG8_WAIT_V(n) asm volatile("s_waitcnt vmcnt(" #n ")" ::: "memory")
#define PG8_WAIT_L(n) asm volatile("s_waitcnt lgkmcnt(" #n ")" ::: "memory")
#define PG8_BAR __builtin_amdgcn_s_barrier()
#define PG8_SCHED __builtin_amdgcn_sched_barrier(0)
#define PG8_AOFFS(VO, u) do { _Pragma("unroll") for (int _h = 0; _h < 2; ++_h) _Pragma("unroll") for (int _i = 0; _i < 2; ++_i) { \
        if constexpr (Sched::GATHER) VO[_h][_i] = (unsigned)S.row_src(u, _h * HALF + Rr[_i]) * (unsigned)RB + (unsigned)(Cc[_i] * 2); \
        else VO[_h][_i] = (unsigned)(Rr[_i] * RB + Cc[_i] * 2); } } while (0)
    Unit cur, nxt; int ui = 0;
    if (!S.next(0, cur)) return;
    unsigned voc[2][2], von[2][2];
    PG8_AOFFS(voc, cur);
    f32x4 acc[2][2][4][2];
#pragma unroll
    for (int a = 0; a < 2; ++a)
#pragma unroll
        for (int b = 0; b < 2; ++b)
#pragma unroll
            for (int m = 0; m < 4; ++m)
#pragma unroll
                for (int n = 0; n < 2; ++n) acc[a][b][m][n] = (f32x4){0.f, 0.f, 0.f, 0.f};
    bf16x8 At[4][2], B0[2][2], B1[2][2]; v8i_t At8[4], B08[2], B18[2];
    const char* cA = cur.A; const char* cB = cur.B;
    PG8_STAGE_B(PG8_SB(0, 0), cB, 0, 0); PG8_STAGE_A(PG8_SA(0, 0), cA, 0, 0, voc); PG8_STAGE_B(PG8_SB(0, 1), cB, 0, 1); PG8_STAGE_A(PG8_SA(0, 1), cA, 0, 1, voc);
    if (wr == 1) PG8_BAR;
    PG8_WAIT_V(4); PG8_BAR;
    PG8_STAGE_B(PG8_SB(1, 0), cB, kstep, 0); PG8_STAGE_A(PG8_SA(1, 0), cA, kstep, 0, voc); PG8_STAGE_B(PG8_SB(1, 1), cB, kstep, 1);
    PG8_WAIT_V(6); PG8_BAR;
    for (;;) {
        const bool has_next = S.next(ui + 1, nxt);
        if constexpr (Sched::GATHER) {
            if (has_next) { PG8_AOFFS(von, nxt); }
            else {
#pragma unroll
                for (int _h = 0; _h < 2; ++_h)
#pragma unroll
                    for (int _i = 0; _i < 2; ++_i) von[_h][_i] = voc[_h][_i];
            }
        }
        const char* nA = has_next ? nxt.A : cA; const char* nB = has_next ? nxt.B : cB;
        for (int t = 0; t < nt; t += 2) {
            const bool last = (t == nt - 2);
            const size_t k1 = (size_t)(t + 1) * kstep;
            const char* a2 = last ? nA : cA; const char* b2 = last ? nB : cB;
            const size_t k2 = last ? 0 : (size_t)(t + 2) * kstep, k3 = k2 + kstep;
            unsigned vo2[2][2];
#pragma unroll
            for (int _h = 0; _h < 2; ++_h)
#pragma unroll
                for (int _i = 0; _i < 2; ++_i) { if constexpr (Sched::GATHER) vo2[_h][_i] = last ? von[_h][_i] : voc[_h][_i]; else vo2[_h][_i] = voc[_h][_i]; }
            PG8_LDB(B0, 0, 0); PG8_SCHED; PG8_LDA(At, 0, 0); PG8_STAGE_A(PG8_SA(1, 1), cA, k1, 1, voc);
            PG8_WAIT_L(8); PG8_BAR; PG8_WAIT_L(0); PG8_MMA(0, 0, At, B0); PG8_BAR; PG8_SCHED;
            PG8_LDB(B1, 0, 1); PG8_STAGE_B(PG8_SB(0, 0), b2, k2, 0);
            PG8_BAR; PG8_WAIT_L(0); PG8_MMA(0, 1, At, B1); PG8_BAR;
            PG8_LDA(At, 0, 1); PG8_STAGE_A(PG8_SA(0, 0), a2, k2, 0, vo2);
            PG8_BAR; PG8_WAIT_L(0); PG8_MMA(1, 0, At, B0); PG8_BAR; PG8_SCHED;
            PG8_STAGE_B(PG8_SB(0, 1), b2, k2, 1);
            PG8_WAIT_V(6); PG8_BAR; PG8_MMA(1, 1, At, B1); PG8_BAR;
            PG8_LDB(B0, 1, 0); PG8_SCHED; PG8_LDA(At, 1, 0); PG8_STAGE_A(PG8_SA(0, 1), a2, k2, 1, vo2);
            PG8_WAIT_L(8); PG8_BAR; PG8_WAIT_L(0); PG8_MMA(0, 0, At, B0); PG8_BAR; PG8_SCHED;
            PG8_LDB(B1, 1, 1); PG8_STAGE_B(PG8_SB(1, 0), b2, k3, 0);
            PG8_BAR; PG8_WAIT_L(0); PG8_MMA(0, 1, At, B1); PG8_BAR;
            PG8_LDA(At, 1, 1); PG8_STAGE_A(PG8_SA(1, 0), a2, k3, 0, vo2);
            PG8_BAR; PG8_WAIT_L(0); PG8_MMA(1, 0, At, B0); PG8_BAR; PG8_SCHED;
            PG8_STAGE_B(PG8_SB(1, 1), b2, k3, 1);
            PG8_WAIT_V(6); PG8_BAR; PG8_MMA(1, 1, At, B1); PG8_BAR;
        }
        if constexpr (FP8) asm volatile("s_nop 15\n\ts_nop 15" ::: "memory");
        E(acc, cur, wr, wc, fr, fq);
        if (!has_next) break;
#pragma unroll
        for (int a = 0; a < 2; ++a)
#pragma unroll
            for (int b = 0; b < 2; ++b)
#pragma unroll
                for (int m = 0; m < 4; ++m)
#pragma unroll
                    for (int n = 0; n < 2; ++n) acc[a][b][m][n] = (f32x4){0.f, 0.f, 0.f, 0.f};
        cur = nxt; cA = nA; cB = nB; ++ui;
        if constexpr (Sched::GATHER) {
#pragma unroll
            for (int _h = 0; _h < 2; ++_h)
#pragma unroll
                for (int _i = 0; _i < 2; ++_i) voc[_h][_i] = von[_h][_i];
        }
    }
    PG8_WAIT_V(0);
    if (wr == 0) PG8_BAR;
    PG8_BAR;
#undef PG8_SA
#undef PG8_SB
#undef PG8_STAGE_A
#undef PG8_RS
#undef PG8_STAGE_B
#undef PG8_LDA
#undef PG8_LDB
#undef PG8_MMA
#undef PG8_WAIT_V
#undef PG8_WAIT_L
#undef PG8_BAR
#undef PG8_SCHED
#undef PG8_AOFFS
}

struct DenseOrder {
    static constexpr bool GATHER = false;
    const char* A; const char* Bt; int nM, nN, K, G, c;
    __device__ __forceinline__ bool next(int i, Unit& u) const {
        const int L = i * G + c; if (L >= nM * nN) return false;
        tile_order(L, nM, nN, u.pm, u.pn); u.e = 0;
        u.A = A + (size_t)u.pm * BM * K * 2; u.B = Bt + (size_t)u.pn * BM * K * 2; return true;
    }
    __device__ __forceinline__ int row_src(const Unit&, int) const { return 0; }
};
}
using pg8::Unit;

struct EpiProj {
    static constexpr bool PERM = true;
    bf16_t* O;
    __device__ __forceinline__ void operator()(const f32x4 (&acc)[2][2][4][2], const Unit& u, int wr, int wc, int fr, int fq) const {
#pragma unroll
        for (int ai = 0; ai < 2; ++ai)
#pragma unroll
            for (int m = 0; m < 4; ++m) { const int row = u.pm * 256 + ai * 128 + wr * 64 + m * 16 + fr;
#pragma unroll
                for (int bj = 0; bj < 2; ++bj) { const int col = u.pn * 256 + bj * 128 + wc * 32 + 8 * fq; const f32x4 v0 = acc[ai][bj][m][0], v1 = acc[ai][bj][m][1];
                    u32x4 o; o.x = pk2(v0.x, v0.y); o.y = pk2(v0.z, v0.w); o.z = pk2(v1.x, v1.y); o.w = pk2(v1.z, v1.w);
                    *(u32x4*)(O + (size_t)row * DINP + col) = o; } }
    }
};
struct EpiQ {
    static constexpr bool PERM = false;
    bf16_t* Q; const float* tab;
    __device__ __forceinline__ void operator()(const f32x4 (&acc)[2][2][4][2], const Unit& u, int wr, int wc, int fr, int fq) const {
        const float sc = 0.10206207261596577f * 1.4426950408889634f;
#pragma unroll
        for (int ai = 0; ai < 2; ++ai)
#pragma unroll
            for (int m = 0; m < 4; ++m) { const int row = u.pm * 256 + ai * 128 + wr * 64 + m * 16 + fr; const int b = row / SEQ, s = row % SEQ;
#pragma unroll
                for (int bj = 0; bj < 2; ++bj) { const int c0 = u.pn * 256 + bj * 128 + wc * 32; const int g32 = c0 >> 5; const int head = c0 / 96;
                    f32x4 v0 = acc[ai][bj][m][0], v1 = acc[ai][bj][m][1];
                    if (g32 % 3 == 2) {
                        const f32x4 cs = *(const f32x4*)(tab + (unsigned)(row * 32 + 4 * fq)), sn = *(const f32x4*)(tab + (unsigned)(row * 32 + 16 + 4 * fq));
                        const f32x4 r0 = v0 * cs - v1 * sn, r1 = v1 * cs + v0 * sn; v0 = r0; v1 = r1;
                    }
                    v0 = v0 * sc; v1 = v1 * sc;
                    bf16_t* base = Q + (unsigned)(((b * MH + head) * SEQ + s) * DQK + (c0 - head * 96) + 4 * fq);
                    u32x2 o0; o0.x = pk2(v0.x, v0.y); o0.y = pk2(v0.z, v0.w); *(u32x2*)(base) = o0;
                    u32x2 o1; o1.x = pk2(v1.x, v1.y); o1.y = pk2(v1.z, v1.w); *(u32x2*)(base + 16) = o1; }
                __builtin_amdgcn_sched_barrier(0); }
    }
};
struct EpiKV {
    static constexpr bool PERM = false;
    bf16_t* Kp; bf16_t* VT;
    __device__ __forceinline__ void operator()(const f32x4 (&acc)[2][2][4][2], const Unit& u, int wr, int wc, int fr, int fq) const {
#pragma unroll
        for (int ai = 0; ai < 2; ++ai)
#pragma unroll
            for (int m = 0; m < 4; ++m) { const int row = u.pm * 256 + ai * 128 + wr * 64 + m * 16 + fr; const int b = row / SEQ, s = row % SEQ;
#pragma unroll
                for (int bj = 0; bj < 2; ++bj) { const int c0 = u.pn * 256 + bj * 128 + wc * 32; const int head = c0 >> 7; const int w0 = c0 & 127;
#pragma unroll
                    for (int n = 0; n < 2; ++n) { const f32x4 v = acc[ai][bj][m][n]; const int within = w0 + 16 * n + 4 * fq;
                        if (within < 64) { u32x2 o; o.x = pk2(v.x, v.y); o.y = pk2(v.z, v.w); *(u32x2*)(Kp + ((size_t)(b * MH + head) * SEQ + s) * DQK + within) = o; }
                        else { bf16_t* vb = VT + ((size_t)(b * MH + head) * 64 + (within - 64)) * SEQ + perm16v(s);
                            vb[0] = (bf16_t)f2bf(v.x); vb[SEQ] = (bf16_t)f2bf(v.y); vb[2 * SEQ] = (bf16_t)f2bf(v.z); vb[3 * SEQ] = (bf16_t)f2bf(v.w); } } } }
    }
};
struct EpiX1 {
    static constexpr bool PERM = false;
    const float* x; float* X1;
    __device__ __forceinline__ void operator()(const f32x4 (&acc)[2][2][4][2], const Unit& u, int wr, int wc, int fr, int fq) const {
#pragma unroll
        for (int ai = 0; ai < 2; ++ai)
#pragma unroll
            for (int m = 0; m < 4; ++m) { const int row = u.pm * 256 + ai * 128 + wr * 64 + m * 16 + fr;
#pragma unroll
                for (int bj = 0; bj < 2; ++bj)
#pragma unroll
                    for (int n = 0; n < 2; ++n) { const size_t o = (size_t)row * D + u.pn * 256 + bj * 128 + wc * 32 + 16 * n + 4 * fq;
                        *(f32x4*)(X1 + o) = *(const f32x4*)(x + o) + acc[ai][bj][m][n]; } }
    }
};
struct EpiAct {
    static constexpr bool PERM = true;
    unsigned char* ACT; const float* b1;
    __device__ __forceinline__ void operator()(const f32x4 (&acc)[2][2][4][2], const Unit& u, int wr, int wc, int fr, int fq) const {
        const float* bb = b1 + (size_t)u.e * 2048;
#pragma unroll
        for (int bj = 0; bj < 2; ++bj) { const int col = u.pn * 256 + bj * 128 + wc * 32 + 8 * fq;
            const f32x4 bv0 = *(const f32x4*)(bb + col), bv1 = *(const f32x4*)(bb + col + 4);
#pragma unroll
            for (int ai = 0; ai < 2; ++ai)
#pragma unroll
                for (int m = 0; m < 4; ++m) { const int row = u.pm * 256 + ai * 128 + wr * 64 + m * 16 + fr;
                    const f32x4 v0 = acc[ai][bj][m][0] * 0.03125f + bv0, v1 = acc[ai][bj][m][1] * 0.03125f + bv1;
                    float g[4] = {v0.x, v0.z, v1.x, v1.z}, l[4] = {v0.y, v0.w, v1.y, v1.w}, a[4];
#pragma unroll
                    for (int i = 0; i < 4; ++i) { const float xg = fminf(g[i], 7.f), xl = fminf(fmaxf(l[i], -7.f), 7.f); a[i] = xg * sigmoidf_(1.702f * xg) * (xl + 1.f); }
                    *(unsigned*)(ACT + (unsigned)(row * DFF + (col >> 1))) = pk4_fp8(a[0], a[1], a[2], a[3]);
                    __builtin_amdgcn_sched_barrier(0); } }
    }
};
struct EpiY {
    static constexpr bool PERM = true;
    bf16_t* Y; const float* b2;
    __device__ __forceinline__ void operator()(const f32x4 (&acc)[2][2][4][2], const Unit& u, int wr, int wc, int fr, int fq) const {
        const float* bb = b2 + (size_t)u.e * 1024;
#pragma unroll
        for (int bj = 0; bj < 2; ++bj) { const int col = u.pn * 256 + bj * 128 + wc * 32 + 8 * fq;
            const f32x4 bv0 = *(const f32x4*)(bb + col), bv1 = *(const f32x4*)(bb + col + 4);
#pragma unroll
            for (int ai = 0; ai < 2; ++ai)
#pragma unroll
                for (int m = 0; m < 4; ++m) { const int row = u.pm * 256 + ai * 128 + wr * 64 + m * 16 + fr;
                    const f32x4 v0 = acc[ai][bj][m][0] * 0.03125f + bv0, v1 = acc[ai][bj][m][1] * 0.03125f + bv1;
                    u32x4 o; o.x = pk2(v0.x, v0.y); o.y = pk2(v0.z, v0.w); o.z = pk2(v1.x, v1.y); o.w = pk2(v1.z, v1.w);
                    *(u32x4*)(Y + (size_t)row * D + col) = o;
                    __builtin_amdgcn_sched_barrier(0); } }
    }
};

struct MoeOrder1 {
    static constexpr bool GATHER = true;
    const char* H2; const char* W1T; const int* list; const LAS int* tstart; const LAS int* cnt; const LAS int* xs; int G, c;
    __device__ __forceinline__ bool next(int i, Unit& u) const {
        const int x = c & 7, j = i * (G >> 3) + (c >> 3); const int t = j >> 3;
        const int x1 = __builtin_amdgcn_readfirstlane(xs[1]), x2 = __builtin_amdgcn_readfirstlane(xs[2]), x3 = __builtin_amdgcn_readfirstlane(xs[3]), x4 = __builtin_amdgcn_readfirstlane(xs[4]);
        if (t >= x4) return false;
        const int jj = (t >= x3) ? 3 : ((t >= x2) ? 2 : ((t >= x1) ? 1 : 0)); const int base = (jj == 3) ? x3 : ((jj == 2) ? x2 : ((jj == 1) ? x1 : 0));
        const int e = x + 8 * jj;
        u.pm = __builtin_amdgcn_readfirstlane(tstart[e]) + (t - base); u.pn = j & 7; u.e = e;
        u.A = H2; u.B = W1T + ((size_t)e * 2048 + (size_t)u.pn * 256) * 1024; return true;
    }
    __device__ __forceinline__ int row_src(const Unit& u, int r) const {
        const int rank = (u.pm - tstart[u.e]) * 256 + r; return rank < cnt[u.e] ? list[u.e * T + rank] : 0;
    }
};
struct MoeOrder2 {
    static constexpr bool GATHER = false;
    const char* ACT; const char* W2T; const LAS int* tstart; const LAS int* xs; int G, c;
    __device__ __forceinline__ bool next(int i, Unit& u) const {
        const int x = c & 7, j = i * (G >> 3) + (c >> 3); const int t = j >> 2;
        const int x1 = __builtin_amdgcn_readfirstlane(xs[1]), x2 = __builtin_amdgcn_readfirstlane(xs[2]), x3 = __builtin_amdgcn_readfirstlane(xs[3]), x4 = __builtin_amdgcn_readfirstlane(xs[4]);
        if (t >= x4) return false;
        const int jj = (t >= x3) ? 3 : ((t >= x2) ? 2 : ((t >= x1) ? 1 : 0)); const int base = (jj == 3) ? x3 : ((jj == 2) ? x2 : ((jj == 1) ? x1 : 0));
        const int e = x + 8 * jj;
        u.pm = __builtin_amdgcn_readfirstlane(tstart[e]) + (t - base); u.pn = j & 3; u.e = e;
        u.A = ACT + (size_t)u.pm * 256 * 1024; u.B = W2T + ((size_t)e * 1024 + (size_t)u.pn * 256) * 1024; return true;
    }
    __device__ __forceinline__ int row_src(const Unit&, int) const { return 0; }
};

__device__ __forceinline__ void transpose_tile(const float* W, int K, int N, bf16_t* WT, int kb, int nb, unsigned char* smem, int tid) {
    float* tile = (float*)smem;
    const int k0 = 64 * kb, n0 = 256 * nb, n4 = tid & 63, kr = tid >> 6;
    f32x4 v[8];
#pragma unroll
    for (int i = 0; i < 8; ++i) { const int k = kr + 8 * i; v[i] = (n0 + 4 * n4 < N) ? *(const f32x4*)(W + (size_t)(k0 + k) * N + n0 + 4 * n4) : (f32x4){0.f, 0.f, 0.f, 0.f}; }
    __syncthreads();
#pragma unroll
    for (int i = 0; i < 8; ++i) { const int k = kr + 8 * i; *(f32x4*)(tile + k * 260 + ((4 * n4) ^ (8 * (k >> 3)))) = v[i]; }
    __syncthreads();
#pragma unroll
    for (int j = 0; j < 4; ++j) { const int c = tid + 512 * j, n = c >> 3, kc = c & 7; const float* src = tile + (8 * kc) * 260 + (n ^ (8 * kc));
        u32x4 o; o.x = pk2(src[0], src[260]); o.y = pk2(src[2 * 260], src[3 * 260]); o.z = pk2(src[4 * 260], src[5 * 260]); o.w = pk2(src[6 * 260], src[7 * 260]);
        *(u32x4*)(WT + (size_t)(n0 + n) * K + k0 + 8 * kc) = o; }
}
__device__ __forceinline__ void transpose_tile_fp8(const float* W, int K, int N, unsigned char* WT, int kb, int nb, float scale, unsigned char* smem, int tid) {
    float* tile = (float*)smem;
    const int k0 = 64 * kb, n0 = 256 * nb, n4 = tid & 63, kr = tid >> 6;
    f32x4 v[8];
#pragma unroll
    for (int i = 0; i < 8; ++i) { const int k = kr + 8 * i; v[i] = *(const f32x4*)(W + (size_t)(k0 + k) * N + n0 + 4 * n4) * scale; }
    __syncthreads();
#pragma unroll
    for (int i = 0; i < 8; ++i) { const int k = kr + 8 * i; *(f32x4*)(tile + k * 260 + ((4 * n4) ^ (8 * (k >> 3)))) = v[i]; }
    __syncthreads();
#pragma unroll
    for (int j = 0; j < 2; ++j) { const int c = tid + 512 * j, n = c >> 2, kc = c & 3;
        const float* s0 = tile + (16 * kc) * 260 + (n ^ (8 * (2 * kc))); const float* s1 = tile + (16 * kc + 8) * 260 + (n ^ (8 * (2 * kc + 1)));
        u32x4 o; o.x = pk4_fp8(s0[0], s0[260], s0[2 * 260], s0[3 * 260]); o.y = pk4_fp8(s0[4 * 260], s0[5 * 260], s0[6 * 260], s0[7 * 260]);
        o.z = pk4_fp8(s1[0], s1[260], s1[2 * 260], s1[3 * 260]); o.w = pk4_fp8(s1[4 * 260], s1[5 * 260], s1[6 * 260], s1[7 * 260]);
        *(u32x4*)(WT + (size_t)(n0 + n) * K + k0 + 16 * kc) = o; }
}
constexpr int TT_W1 = 128, TT_W2 = 64, TT_TOTAL = NE * TT_W1 + NE * TT_W2;
struct TTile { const float* src; unsigned char* dst; int N; };
__device__ __forceinline__ TTile tt_decode(const Params& P, int it, int n4, int kr) {
    TTile t;
    if (it < NE * TT_W1) { const int e = it >> 7, r = it & 127, kb = r >> 3, nb = r & 7; t.N = 2048;
        t.src = P.w1 + (size_t)e * D * 2048 + (size_t)(64 * kb + kr) * 2048 + 256 * nb + 4 * n4; t.dst = P.ws + WS_W1 + (size_t)e * 2048 * D + (size_t)(256 * nb) * D + 64 * kb; }
    else { const int i2 = it - NE * TT_W1, e = i2 >> 6, r = i2 & 63, kb = r >> 2, nb = r & 3; t.N = 1024;
        t.src = P.w2 + (size_t)e * DFF * D + (size_t)(64 * kb + kr) * 1024 + 256 * nb + 4 * n4; t.dst = P.ws + WS_W2 + (size_t)e * D * DFF + (size_t)(256 * nb) * DFF + 64 * kb; }
    return t;
}
__device__ __forceinline__ void late_transposes(const Params& P, unsigned char* smem, unsigned* qh, volatile LAS unsigned* misc, int tid) {
    float* tile = (float*)smem;
    const int n4 = tid & 63, kr = tid >> 6;
    __syncthreads();
    if (tid == 0) misc[8] = atomicAdd(qh, 1u);
    __syncthreads();
    int cur = (int)misc[8];
    if (cur >= TT_TOTAL) return;
    f32x4 v[8]; TTile tc = tt_decode(P, cur, n4, kr);
#pragma unroll
    for (int i = 0; i < 8; ++i) v[i] = *(const f32x4*)(tc.src + (size_t)(8 * i) * tc.N);
    for (;;) {
        if (tid == 0) misc[8] = atomicAdd(qh, 1u);
        __syncthreads();
        const int nxt = (int)misc[8];
#pragma unroll
        for (int i = 0; i < 8; ++i) { const int k = kr + 8 * i; *(f32x4*)(tile + k * 260 + ((4 * n4) ^ (8 * (k >> 3)))) = v[i] * 32.f; }
        TTile tn = tc;
        if (nxt < TT_TOTAL) { tn = tt_decode(P, nxt, n4, kr);
#pragma unroll
            for (int i = 0; i < 8; ++i) v[i] = *(const f32x4*)(tn.src + (size_t)(8 * i) * tn.N); }
        __syncthreads();
#pragma unroll
        for (int j = 0; j < 2; ++j) { const int c = tid + 512 * j, n = c >> 2, kc = c & 3;
            const float* s0 = tile + (16 * kc) * 260 + (n ^ (8 * (2 * kc))); const float* s1 = tile + (16 * kc + 8) * 260 + (n ^ (8 * (2 * kc + 1)));
            u32x4 o; o.x = pk4_fp8(s0[0], s0[260], s0[2 * 260], s0[3 * 260]); o.y = pk4_fp8(s0[4 * 260], s0[5 * 260], s0[6 * 260], s0[7 * 260]);
            o.z = pk4_fp8(s1[0], s1[260], s1[2 * 260], s1[3 * 260]); o.w = pk4_fp8(s1[4 * 260], s1[5 * 260], s1[6 * 260], s1[7 * 260]);
            *(u32x4*)(tc.dst + (size_t)n * 1024 + 16 * kc) = o; }
        if (nxt >= TT_TOTAL) break;
        cur = nxt; tc = tn;
    }
}

__device__ __forceinline__ void phase0(const Params& P, unsigned char* smem) {
    unsigned char* ws = P.ws;
    const int tid_ = opaque_tid(), lane = tid_ & 63, wave = tid_ >> 6, gw = blockIdx.x * NWAVES + wave, ngw = gridDim.x * NWAVES;
    float* slab = (float*)(smem + 73728);
    for (int i = tid_; i < 1024 * 8; i += NTHREADS) { const int k = i >> 3, c = i & 7, pos = (k & 3) * 256 + (k >> 2); slab[(c >> 2) * 4096 + pos * 4 + (c & 3)] = P.w_in[(size_t)k * DIN + 2048 + c]; }
    __syncthreads();
    bf16_t* H = (bf16_t*)(ws + WS_H); float* AB = (float*)(ws + WS_AB);
    f32x4 vnx[4];
    if (gw < T) {
#pragma unroll
        for (int j = 0; j < 4; ++j) vnx[j] = *((const f32x4*)(P.x + (size_t)gw * D) + lane + 64 * j); }
    for (int row = gw; row < T; row += ngw) {
        f32x4 v[4]; float ss = 0.f;
#pragma unroll
        for (int j = 0; j < 4; ++j) { v[j] = vnx[j]; ss += v[j].x * v[j].x + v[j].y * v[j].y + v[j].z * v[j].z + v[j].w * v[j].w; }
        if (row + ngw < T) {
#pragma unroll
            for (int j = 0; j < 4; ++j) vnx[j] = *((const f32x4*)(P.x + (size_t)(row + ngw) * D) + lane + 64 * j); }
        const float rstd = rsqrtf(wave_sum(ss) * (1.f / D) + EPS);
        float acc[8];
#pragma unroll
        for (int c = 0; c < 8; ++c) acc[c] = 0.f;
#pragma unroll
        for (int j = 0; j < 4; ++j) {
            const f32x4 w = *((const f32x4*)P.norm_mix_w + lane + 64 * j);
            v[j] = v[j] * rstd * w;
            u32x2 o; o.x = pk2(v[j].x, v[j].y); o.y = pk2(v[j].z, v[j].w);
            *((u32x2*)(H + (size_t)row * D) + lane + 64 * j) = o;
#pragma unroll
            for (int i = 0; i < 4; ++i) { const float* sw = slab + (size_t)(i * 256 + lane + 64 * j) * 4; const f32x4 w0 = *(const f32x4*)sw, w1 = *(const f32x4*)(sw + 4096); const float hv = v[j][i];
                acc[0] += hv * w0.x; acc[1] += hv * w0.y; acc[2] += hv * w0.z; acc[3] += hv * w0.w; acc[4] += hv * w1.x; acc[5] += hv * w1.y; acc[6] += hv * w1.z; acc[7] += hv * w1.w; }
        }
#pragma unroll
        for (int c = 0; c < 8; ++c) acc[c] = wave_sum(acc[c]);
        if (lane == 0) { *(f32x4*)(AB + (size_t)row * 8) = (f32x4){acc[0], acc[1], acc[2], acc[3]}; *(f32x4*)(AB + (size_t)row * 8 + 4) = (f32x4){acc[4], acc[5], acc[6], acc[7]}; }
    }
    __syncthreads();
    for (int it = blockIdx.x; it < 274; it += gridDim.x) {
        if (it >= 210) transpose_tile(P.w_out, D, D, (bf16_t*)(ws + WS_WOUT), (it - 210) >> 2, (it - 210) & 3, smem, tid_);
        else if (it < 176) transpose_tile(P.w_in, D, DIN, (bf16_t*)(ws + WS_WIN), it / 11, it % 11, smem, tid_);
        else if (it < 194) transpose_tile(P.w_uq, QL, 768, (bf16_t*)(ws + WS_WUQ), (it - 176) / 3, (it - 176) % 3, smem, tid_);
        else transpose_tile(P.w_ukv, KVL, 1024, (bf16_t*)(ws + WS_WUKV), (it - 194) >> 2, (it - 194) & 3, smem, tid_);
    }
}

__constant__ float c_inv_freq[16] = {1.0f, 0.5623413324356079f, 0.3162277638912201f, 0.17782793939113617f, 0.10000000149011612f, 0.05623413249850273f, 0.03162277489900589f,
    0.017782794311642647f, 0.009999999776482582f, 0.005623413249850273f, 0.003162277629598975f, 0.0017782794311642647f, 0.0010000000474974513f, 0.000562341301701963f,
    0.0003162277571391314f, 0.00017782794020604342f};
__device__ __forceinline__ void phase2a(const Params& P) {
    unsigned char* ws = P.ws;
    const int tid_ = opaque_tid(), lane = tid_ & 63, gw = blockIdx.x * NWAVES + (tid_ >> 6), ngw = gridDim.x * NWAVES;
    const bf16_t* PROJ = (const bf16_t*)(ws + WS_PROJ); bf16_t* CQN = (bf16_t*)(ws + WS_CQN); bf16_t* CKVN = (bf16_t*)(ws + WS_CKVN);
    bf16_t* Kp = (bf16_t*)(ws + WS_K); float* tab = (float*)(ws + WS_TAB);
    for (int row = gw; row < T; row += ngw) {
        const bf16_t* pr = PROJ + (size_t)row * DINP; const int b = row / SEQ, s = row % SEQ;
        {
            unsigned a[3]; float ss = 0.f;
#pragma unroll
            for (int j = 0; j < 3; ++j) { a[j] = *(const unsigned*)(pr + C_CQ + 2 * (lane + 64 * j)); const float lo = bflo(a[j]), hi = bfhi(a[j]); ss += lo * lo + hi * hi; }
            const float rstd = rsqrtf(wave_sum(ss) * (1.f / QL) + EPS);
#pragma unroll
            for (int j = 0; j < 3; ++j) { const int idx = 2 * (lane + 64 * j); *(unsigned*)(CQN + (size_t)row * QL + idx) = pk2(bflo(a[j]) * rstd * P.q_norm_w[idx], bfhi(a[j]) * rstd * P.q_norm_w[idx + 1]); }
        }
        {
            unsigned a[2]; float ss = 0.f;
#pragma unroll
            for (int j = 0; j < 2; ++j) { a[j] = *(const unsigned*)(pr + C_CKV + 2 * (lane + 64 * j)); const float lo = bflo(a[j]), hi = bfhi(a[j]); ss += lo * lo + hi * hi; }
            const float rstd = rsqrtf(wave_sum(ss) * (1.f / KVL) + EPS);
#pragma unroll
            for (int j = 0; j < 2; ++j) { const int idx = 2 * (lane + 64 * j); *(unsigned*)(CKVN + (size_t)row * KVL + idx) = pk2(bflo(a[j]) * rstd * P.kv_norm_w[idx], bfhi(a[j]) * rstd * P.kv_norm_w[idx + 1]); }
        }
        if (lane < 16) {
            const float x1 = bf1(pr[C_KR + lane]), x2 = bf1(pr[C_KR + 16 + lane]);
            const float ang = (float)P.pos[row] * c_inv_freq[lane];
            double tt = (double)ang * 0.15915494309189535; tt -= floor(tt);
            if (tt > 0.5) tt -= 1.0;
            const float ar = (float)(tt * 6.283185307179586);
            const float cs = __cosf(ar), sn = __sinf(ar);
            tab[(size_t)row * 32 + lane] = cs; tab[(size_t)row * 32 + 16 + lane] = sn;
            const bf16_t o1 = (bf16_t)f2bf(x1 * cs - x2 * sn), o2 = (bf16_t)f2bf(x2 * cs + x1 * sn);
#pragma unroll
            for (int h = 0; h < MH; ++h) { bf16_t* kp = Kp + ((size_t)(b * MH + h) * SEQ + s) * DQK + 64; kp[lane] = o1; kp[16 + lane] = o2; }
        }
    }
}

__device__ __forceinline__ float softplusf_(float x) { return fmaxf(x, 0.f) + log1pf(__expf(-fabsf(x))); }
__device__ __forceinline__ void prep_conv_load(const Params& P, int item, int tid, u32x4 (&raw)[11]) {
    const int n = item % NCH, hh = (item / NCH) % GH, b = item / (NCH * GH);
    const int rg = tid / 48, c8 = tid % 48, which = c8 >> 4, cc = (c8 & 15) * 8, gc = which * 512 + hh * 128 + cc;
    const bf16_t* PROJ = (const bf16_t*)(P.ws + WS_PROJ);
#pragma unroll
    for (int i = 0; i < 11; ++i) { const int t = 64 * n + 8 * rg - 3 + i;
        raw[i] = (t >= 0) ? *(const u32x4*)(PROJ + (size_t)(b * SEQ + t) * DINP + gc) : (u32x4){0u, 0u, 0u, 0u}; }
}
__device__ __forceinline__ void gdn_prep_item(const Params& P, unsigned char* smem, int item, int next_item, u32x4 (&raw)[11]) {
    unsigned char* ws = P.ws;
    const int tid = opaque_tid(), wave = tid >> 6, lane = tid & 63;
    const int n = item % NCH, hh = (item / NCH) % GH, b = item / (NCH * GH);
    const bf16_t* PROJ = (const bf16_t*)(ws + WS_PROJ); const float* AB = (const float*)(ws + WS_AB);
    unsigned char* gp = ws + WS_GP + (size_t)item * GP_ITEM;
    float* Ug = (float*)(gp + GP_U); bf16_t* Wg = (bf16_t*)(gp + GP_W); bf16_t* QDg = (bf16_t*)(gp + GP_QD); bf16_t* KDTg = (bf16_t*)(gp + GP_KDT); bf16_t* QKg = (bf16_t*)(gp + GP_QK);
    float* qs = (float*)smem; float* ks = qs + 64 * 132; float* vs = ks + 64 * 132; float* Am = vs + 64 * 132;
    float* sbeta = Am + 64 * 68; float* sG = sbeta + 64; float* seG = sG + 64; float* sekd = seG + 64;
    __syncthreads();
    if (tid < 384) {
        const int rg = tid / 48, c8 = tid % 48, which = c8 >> 4, cc = (c8 & 15) * 8, gc = which * 512 + hh * 128 + cc;
        float wv[4][8];
#pragma unroll
        for (int j = 0; j < 4; ++j) { const f32x4 a = *(const f32x4*)(P.conv_w + j * 1536 + gc), c = *(const f32x4*)(P.conv_w + j * 1536 + gc + 4);
            wv[j][0] = a.x; wv[j][1] = a.y; wv[j][2] = a.z; wv[j][3] = a.w; wv[j][4] = c.x; wv[j][5] = c.y; wv[j][6] = c.z; wv[j][7] = c.w; }
        float* dst = qs + which * (64 * 132) + (8 * rg) * 132 + cc;
#pragma unroll
        for (int rr = 0; rr < 8; ++rr) {
            float y[8];
#pragma unroll
            for (int d = 0; d < 4; ++d) { float ya = 0.f, yb = 0.f;
#pragma unroll
                for (int j = 0; j < 4; ++j) { const unsigned u = raw[rr + j][d]; ya += wv[j][2 * d] * bflo(u); yb += wv[j][2 * d + 1] * bfhi(u); }
                y[2 * d] = ya * sigmoidf_(ya); y[2 * d + 1] = yb * sigmoidf_(yb); }
            *(f32x4*)(dst + rr * 132) = (f32x4){y[0], y[1], y[2], y[3]}; *(f32x4*)(dst + rr * 132 + 4) = (f32x4){y[4], y[5], y[6], y[7]};
        }
        if (next_item >= 0) prep_conv_load(P, next_item, tid, raw);
    } else if (tid >= 448) {
        const int r = lane; const size_t tok = (size_t)b * SEQ + 64 * n + r;
        const float a = AB[tok * 8 + hh], bb = AB[tok * 8 + 4 + hh];
        const float g = -__expf(P.a_log[hh]) * softplusf_(a + P.dt_bias[hh]);
        float G = g;
#pragma unroll
        for (int o = 1; o < 64; o <<= 1) { const float up = __shfl_up(G, o); if (lane >= o) G += up; }
        const float Gl = __shfl(G, 63);
        sbeta[r] = sigmoidf_(bb); sG[r] = G; seG[r] = __expf(G); sekd[r] = __expf(Gl - G);
        if (lane == 0) ((float*)(ws + WS_GT))[item] = __expf(Gl);
    }
    __syncthreads();
    for (int p = wave; p < 128; p += NWAVES) {
        const int which = p >> 6, r = p & 63; float* row = qs + which * (64 * 132) + r * 132;
        const float a0 = row[2 * lane], a1 = row[2 * lane + 1];
        const float ss = wave_sum(a0 * a0 + a1 * a1);
        const float sc = rsqrtf(ss + EPS) * (which == 0 ? 0.08838834764831845f : 1.f);
        row[2 * lane] = a0 * sc; row[2 * lane + 1] = a1 * sc;
    }
    for (int idx = tid; idx < 6 * 256; idx += NTHREADS) {
        const int u = idx >> 8, w = idx & 255; const int I = (u < 3) ? 0 : (u < 5 ? 1 : 2), J = (u < 3) ? u + 1 : (u < 5 ? u - 1 : 3);
        QKg[(16 * I + (w >> 4)) * 64 + perm32k(16 * J + (w & 15))] = 0;
    }
    __syncthreads();
    for (int job = wave; job < 20; job += NWAVES) {
        const int kind = job / 10, p = job % 10; const int I = (p < 1) ? 0 : (p < 3 ? 1 : (p < 6 ? 2 : 3)); const int J = p - (I * (I + 1)) / 2;
        const float* Ar = (kind ? qs : ks) + (16 * I + (lane & 15)) * 132 + (lane >> 4);
        const float* Br = ks + (16 * J + (lane & 15)) * 132 + (lane >> 4);
        f32x4 acc = {0.f, 0.f, 0.f, 0.f};
#pragma unroll 8
        for (int s = 0; s < 32; ++s) acc = __builtin_amdgcn_mfma_f32_16x16x4f32(Ar[4 * s], Br[4 * s], acc, 0, 0, 0);
        const int j = 16 * J + (lane & 15);
#pragma unroll
        for (int r = 0; r < 4; ++r) { const int i = 16 * I + 4 * (lane >> 4) + r;
            const float dec = (i >= j) ? __expf(sG[i] - sG[j]) : 0.f;
            if (kind == 0) Am[i * 68 + j] = (i > j) ? sbeta[i] * acc[r] * dec : 0.f;
            else QKg[i * 64 + perm32k(j)] = (bf16_t)f2bf((i >= j) ? acc[r] * dec : 0.f); }
    }
    __syncthreads();
    if (wave < 4) {
        if (lane < 16) {
            const int i0_ = 16 * wave, c = lane; float Tc[16];
            const LAS float* AmL = (const LAS float*)Am + i0_ * 68 + i0_; asm volatile("" : "+v"(AmL));
#pragma unroll
            for (int i = 0; i < 16; ++i) { float a = (i == c) ? 1.f : 0.f;
#pragma unroll
                for (int j = 0; j < i; ++j) a -= AmL[i * 68 + j] * Tc[j];
                Tc[i] = a; asm volatile("" : "+v"(Tc[i])); }
#pragma unroll
            for (int i = 0; i < 16; ++i) Am[(i0_ + i) * 68 + i0_ + c] = Tc[i];
        }
    } else {
        const int t2 = tid - 256;
        for (int idx = t2; idx < 64 * 64; idx += 256) { const int i = idx >> 6, d = (idx & 63) * 2; *(unsigned*)(QDg + i * 128 + perm32k(d)) = pk2(qs[i * 132 + d] * seG[i], qs[i * 132 + d + 1] * seG[i]); }
        for (int idx = t2; idx < 128 * 32; idx += 256) { const int d = idx >> 5, cc = (idx & 31) * 2; *(unsigned*)(KDTg + d * 64 + perm32k(cc)) = pk2(ks[cc * 132 + d] * sekd[cc], ks[(cc + 1) * 132 + d] * sekd[cc + 1]); }
    }
    __syncthreads();
    for (int idx = tid; idx < 64 * 32; idx += NTHREADS) { const int i = idx >> 5, c4 = (idx & 31) * 4; const float bi = sbeta[i], bw = bi * seG[i];
        f32x4* pv = (f32x4*)(vs + i * 132 + c4); *pv = *pv * bi; f32x4* pk = (f32x4*)(ks + i * 132 + c4); *pk = *pk * bw; }
    __syncthreads();
    {
        const int rl = lane & 15, kk = lane >> 4;
        float* arr0 = (wave < 4 ? vs : ks) + ((2 * wave) & 7) * 16; float* arr1 = arr0 + 16;
#pragma unroll
        for (int i = 0; i < 4; ++i) {
            f32x4 acc0, acc1;
#pragma unroll
            for (int r = 0; r < 4; ++r) { acc0[r] = arr0[(16 * i + 4 * kk + r) * 132 + rl]; acc1[r] = arr1[(16 * i + 4 * kk + r) * 132 + rl]; }
#pragma unroll
            for (int j = 0; j < i; ++j)
#pragma unroll
                for (int sx = 0; sx < 4; ++sx) { const float a = -Am[(16 * i + rl) * 68 + 16 * j + 4 * sx + kk];
                    acc0 = __builtin_amdgcn_mfma_f32_16x16x4f32(a, arr0[(16 * j + 4 * sx + kk) * 132 + rl], acc0, 0, 0, 0);
                    acc1 = __builtin_amdgcn_mfma_f32_16x16x4f32(a, arr1[(16 * j + 4 * sx + kk) * 132 + rl], acc1, 0, 0, 0); }
#pragma unroll
            for (int r = 0; r < 4; ++r) { arr0[(16 * i + 4 * kk + r) * 132 + rl] = acc0[r]; arr1[(16 * i + 4 * kk + r) * 132 + rl] = acc1[r]; }
            asm volatile("s_waitcnt lgkmcnt(0)" ::: "memory");
            f32x4 o0 = {0.f, 0.f, 0.f, 0.f}, o1 = {0.f, 0.f, 0.f, 0.f};
#pragma unroll
            for (int sx = 0; sx < 4; ++sx) { const float a = Am[(16 * i + rl) * 68 + 16 * i + 4 * sx + kk];
                o0 = __builtin_amdgcn_mfma_f32_16x16x4f32(a, arr0[(16 * i + 4 * sx + kk) * 132 + rl], o0, 0, 0, 0);
                o1 = __builtin_amdgcn_mfma_f32_16x16x4f32(a, arr1[(16 * i + 4 * sx + kk) * 132 + rl], o1, 0, 0, 0); }
#pragma unroll
            for (int r = 0; r < 4; ++r) { arr0[(16 * i + 4 * kk + r) * 132 + rl] = o0[r]; arr1[(16 * i + 4 * kk + r) * 132 + rl] = o1[r]; }
            asm volatile("s_waitcnt lgkmcnt(0)" ::: "memory");
        }
    }
    __syncthreads();
    for (int idx = tid; idx < 2048; idx += NTHREADS) { const int e = idx & 15, g = (idx >> 4) & 3, m = (idx >> 6) & 3, w = idx >> 8; const float* src = vs + (16 * m + 4 * g) * 132 + 16 * w + e;
        u32x2 o; o.x = pk2(src[0], src[132]); o.y = pk2(src[2 * 132], src[3 * 132]); ((u32x2*)Ug)[idx] = o; }
    for (int idx = tid; idx < 64 * 64; idx += NTHREADS) { const int i = idx >> 6, d = (idx & 63) * 2; *(unsigned*)(Wg + i * 128 + perm32k(d)) = pk2(-ks[i * 132 + d], -ks[i * 132 + d + 1]); }
}

__device__ __forceinline__ void gdn_scan(const Params& P, unsigned char* smem, int bh) {
    unsigned char* ws = P.ws;
    const int tid = opaque_tid(), wave = tid >> 6, lane = tid & 63, e = lane & 15, g = lane >> 4;
    const float* GT = (const float*)(ws + WS_GT);
    constexpr int BUF = 36864, OW = 0, OKD = 18432;
    f32x4 S[8];
#pragma unroll
    for (int t = 0; t < 8; ++t) S[t] = (f32x4){0.f, 0.f, 0.f, 0.f};
    u32x4 st[2][4]; u32x2 un[2][4]; float gtn[2];
#define SCAN_GLOAD(p, n) do { const unsigned char* gp_ = ws + WS_GP + (size_t)(bh * NCH + (n)) * GP_ITEM; \
        _Pragma("unroll") for (int k = 0; k < 2; ++k) st[p][k] = *(const u32x4*)(gp_ + GP_W + (size_t)(tid + 512 * k) * 16); \
        _Pragma("unroll") for (int k = 0; k < 2; ++k) st[p][2 + k] = *(const u32x4*)(gp_ + GP_KDT + (size_t)(tid + 512 * k) * 16); \
        const u32x2* ug_ = (const u32x2*)(gp_ + GP_U) + wave * 256 + lane; \
        _Pragma("unroll") for (int m = 0; m < 4; ++m) un[p][m] = ug_[m * 64]; \
        gtn[p] = GT[bh * NCH + (n)]; } while (0)
#define SCAN_LWRITE(p, buf) do { unsigned char* L_ = smem + (buf) * BUF; \
        _Pragma("unroll") for (int k = 0; k < 2; ++k) { const int c = tid + 512 * k; *(u32x4*)(L_ + OW + (c >> 4) * 288 + (c & 15) * 16) = st[p][k]; } \
        _Pragma("unroll") for (int k = 0; k < 2; ++k) { const int c = tid + 512 * k; *(u32x4*)(L_ + OKD + (c >> 3) * 144 + (c & 7) * 16) = st[p][2 + k]; } } while (0)
    __syncthreads();
    SCAN_GLOAD(0, 0); SCAN_LWRITE(0, 0); SCAN_GLOAD(1, 1);
    __syncthreads();
    for (int n2 = 0; n2 < NCH; n2 += 2) {
#pragma unroll
      for (int p = 0; p < 2; ++p) {
        const int n = n2 + p;
        f32x4 av[4];
#pragma unroll
        for (int m = 0; m < 4; ++m) av[m] = (f32x4){bflo(un[p][m].x), bfhi(un[p][m].x), bflo(un[p][m].y), bfhi(un[p][m].y)};
        const float gt = gtn[p];
        if (n + 2 < NCH) SCAN_GLOAD(p, n + 2);
        const unsigned char* L = smem + p * BUF;
        bf16x8 Sb[4];
#pragma unroll
        for (int s = 0; s < 4; ++s) Sb[s] = pack8(S[2 * s], S[2 * s + 1]);
        {
            bf16x8* sb = (bf16x8*)(ws + WS_SB) + ((size_t)(bh * NCH + n) * 8 + wave) * 256 + lane;
#pragma unroll
            for (int s = 0; s < 4; ++s) sb[s * 64] = Sb[s];
        }
#pragma unroll
        for (int s = 0; s < 4; ++s)
#pragma unroll
            for (int m = 0; m < 4; ++m) {
                const bf16x8 wf = *(const bf16x8*)(L + OW + (16 * m + e) * 288 + (32 * s + 8 * g) * 2);
                av[m] = __builtin_amdgcn_mfma_f32_16x16x32_bf16(wf, Sb[s], av[m], 0, 0, 0);
            }
        bf16x8 Vb[2];
#pragma unroll
        for (int s = 0; s < 2; ++s) Vb[s] = pack8(av[2 * s], av[2 * s + 1]);
#pragma unroll
        for (int t = 0; t < 8; ++t) { S[t] = S[t] * gt;
#pragma unroll
            for (int s = 0; s < 2; ++s) {
                const bf16x8 df = *(const bf16x8*)(L + OKD + (16 * t + e) * 144 + (32 * s + 8 * g) * 2);
                S[t] = __builtin_amdgcn_mfma_f32_16x16x32_bf16(df, Vb[s], S[t], 0, 0, 0);
            } }
        if (n + 1 < NCH) SCAN_LWRITE(p ^ 1, p ^ 1);
        __syncthreads();
      }
    }
#undef SCAN_GLOAD
#undef SCAN_LWRITE
}

struct GdnOutRegs { u32x4 st[5]; bf16x8 Sb[4]; u32x2 un[4]; };
__device__ __forceinline__ void gdn_out_load(const Params& P, int item, int tid, GdnOutRegs& R) {
    unsigned char* ws = P.ws; const int wave = tid >> 6, lane = tid & 63;
    const unsigned char* gp = ws + WS_GP + (size_t)item * GP_ITEM;
#pragma unroll
    for (int k = 0; k < 2; ++k) R.st[k] = *(const u32x4*)(gp + GP_W + (size_t)(tid + 512 * k) * 16);
#pragma unroll
    for (int k = 0; k < 2; ++k) R.st[2 + k] = *(const u32x4*)(gp + GP_QD + (size_t)(tid + 512 * k) * 16);
    R.st[4] = *(const u32x4*)(gp + GP_QK + (size_t)tid * 16);
    const bf16x8* sb = (const bf16x8*)(ws + WS_SB) + ((size_t)item * 8 + wave) * 256 + lane;
#pragma unroll
    for (int s = 0; s < 4; ++s) R.Sb[s] = sb[s * 64];
    const u32x2* ug = (const u32x2*)(gp + GP_U) + wave * 256 + lane;
#pragma unroll
    for (int m = 0; m < 4; ++m) R.un[m] = ug[m * 64];
}
__device__ __forceinline__ void gdn_out_item(const Params& P, unsigned char* smem, int item, int next_item, GdnOutRegs& R) {
    unsigned char* ws = P.ws;
    const int tid = opaque_tid(), wave = tid >> 6, lane = tid & 63, e = lane & 15, g = lane >> 4;
    const int n = item % NCH, hh = (item / NCH) % GH, b = item / (NCH * GH);
    constexpr int OW = 0, OQD = 18432, OQK = 36864, OSS = 46080, ORS = OSS + 2048, OT = 49152;
    float* ssq = (float*)(smem + OSS); float* rs = (float*)(smem + ORS);
    u32x4 st[5]; bf16x8 Sb[4]; u32x2 un[4];
#pragma unroll
    for (int k = 0; k < 5; ++k) st[k] = R.st[k];
#pragma unroll
    for (int k = 0; k < 4; ++k) { Sb[k] = R.Sb[k]; un[k] = R.un[k]; }
    __syncthreads();
#pragma unroll
    for (int k = 0; k < 2; ++k) { const int c = tid + 512 * k; *(u32x4*)(smem + OW + (c >> 4) * 288 + (c & 15) * 16) = st[k]; }
#pragma unroll
    for (int k = 0; k < 2; ++k) { const int c = tid + 512 * k; *(u32x4*)(smem + OQD + (c >> 4) * 288 + (c & 15) * 16) = st[2 + k]; }
    { const int c = tid; *(u32x4*)(smem + OQK + (c >> 3) * 144 + (c & 7) * 16) = st[4]; }
    __syncthreads();
    if (next_item >= 0) gdn_out_load(P, next_item, tid, R);
    f32x4 av[4], ao[4];
#pragma unroll
    for (int m = 0; m < 4; ++m) { av[m] = (f32x4){bflo(un[m].x), bfhi(un[m].x), bflo(un[m].y), bfhi(un[m].y)}; ao[m] = (f32x4){0.f, 0.f, 0.f, 0.f}; }
#pragma unroll
    for (int s = 0; s < 4; ++s)
#pragma unroll
        for (int m = 0; m < 4; ++m) {
            const bf16x8 wf = *(const bf16x8*)(smem + OW + (16 * m + e) * 288 + (32 * s + 8 * g) * 2);
            const bf16x8 qf = *(const bf16x8*)(smem + OQD + (16 * m + e) * 288 + (32 * s + 8 * g) * 2);
            av[m] = __builtin_amdgcn_mfma_f32_16x16x32_bf16(wf, Sb[s], av[m], 0, 0, 0);
            ao[m] = __builtin_amdgcn_mfma_f32_16x16x32_bf16(qf, Sb[s], ao[m], 0, 0, 0);
        }
    bf16x8 Vb[2];
#pragma unroll
    for (int s = 0; s < 2; ++s) Vb[s] = pack8(av[2 * s], av[2 * s + 1]);
#pragma unroll
    for (int m = 0; m < 4; ++m)
#pragma unroll
        for (int s = 0; s < 2; ++s) {
            const bf16x8 kf = *(const bf16x8*)(smem + OQK + (16 * m + e) * 144 + (32 * s + 8 * g) * 2);
            ao[m] = __builtin_amdgcn_mfma_f32_16x16x32_bf16(kf, Vb[s], ao[m], 0, 0, 0);
        }
#pragma unroll
    for (int m = 0; m < 4; ++m)
#pragma unroll
        for (int r = 0; r < 4; ++r) { float q = ao[m][r] * ao[m][r];
            q += __shfl_xor(q, 1); q += __shfl_xor(q, 2); q += __shfl_xor(q, 4); q += __shfl_xor(q, 8);
            if (e == 0) ssq[wave * 64 + 16 * m + 4 * g + r] = q;
            *(bf16_t*)(smem + OT + (16 * m + 4 * g + r) * 272 + (16 * wave + e) * 2) = (bf16_t)f2bf(ao[m][r]); }
    __syncthreads();
    if (tid < 64) { float q = 0.f;
#pragma unroll
        for (int w = 0; w < 8; ++w) q += ssq[w * 64 + tid];
        rs[tid] = rsqrtf(q * (1.f / 128.f) + EPS); }
    __syncthreads();
    {
        const int row = tid >> 3, seg = tid & 7; const size_t tok = (size_t)b * SEQ + 64 * n + row;
        const u32x4* tp = (const u32x4*)(smem + OT + row * 272 + seg * 32);
        const u32x4 o0 = tp[0], o1 = tp[1];
        const u32x4* zp = (const u32x4*)((const bf16_t*)(ws + WS_PROJ) + tok * DINP + C_Z + hh * 128 + seg * 16);
        const u32x4 z0 = zp[0], z1 = zp[1];
        const float r_ = rs[row]; const float* gwp = P.gdn_norm_w + seg * 16;
        unsigned ov[8]; const unsigned oo[8] = {o0.x, o0.y, o0.z, o0.w, o1.x, o1.y, o1.z, o1.w}, zz[8] = {z0.x, z0.y, z0.z, z0.w, z1.x, z1.y, z1.z, z1.w};
#pragma unroll
        for (int i = 0; i < 8; ++i) { const float za = bflo(zz[i]), zb = bfhi(zz[i]);
            ov[i] = pk2(bflo(oo[i]) * r_ * gwp[2 * i] * za * sigmoidf_(za), bfhi(oo[i]) * r_ * gwp[2 * i + 1] * zb * sigmoidf_(zb)); }
        u32x4* op = (u32x4*)((bf16_t*)(ws + WS_OCAT) + tok * D + hh * 128 + seg * 16);
        op[0] = (u32x4){ov[0], ov[1], ov[2], ov[3]}; op[1] = (u32x4){ov[4], ov[5], ov[6], ov[7]};
    }
}

__device__ __forceinline__ void attn_item(const Params& P, unsigned char* smem, int item) {
    unsigned char* ws = P.ws;
    const int tid = opaque_tid(), wave = tid >> 6, lane = tid & 63, ql = lane & 31, hf = lane >> 5;
    const int qt = 15 - (item >> 5), bh = item & 31;
    const bf16_t* Qg = (const bf16_t*)(ws + WS_Q) + (size_t)bh * SEQ * DQK;
    const unsigned char* Kg = (const unsigned char*)((const bf16_t*)(ws + WS_K) + (size_t)bh * SEQ * DQK);
    const bf16_t* VTg = (const bf16_t*)(ws + WS_VT) + (size_t)bh * 64 * SEQ;
    bf16_t* OB = (bf16_t*)(ws + WS_OB);
    const int q0 = qt * 256 + 32 * wave;
    const int nkt_w = (q0 >> 6) + 1, nkt_b = 4 * qt + 4;
    constexpr int KB_ = 13312, VB_ = 9216, OK0 = 0, OV0 = 2 * KB_;
    bf16x8 qf[6];
#pragma unroll
    for (int ks = 0; ks < 6; ++ks) qf[ks] = *(const bf16x8*)(Qg + (size_t)(q0 + ql) * DQK + 16 * ks + 8 * hf);
    f32x16 o0, o1;
#pragma unroll
    for (int i = 0; i < 16; ++i) { o0[i] = 0.f; o1[i] = 0.f; }
    float mrun = -1e30f, lsum = 0.f;
    u32x4 sk0, sk1, sv;
    auto gload = [&](int kt) {
        const unsigned char* kp = Kg + (size_t)kt * 64 * DQK * 2;
        sk0 = *(const u32x4*)(kp + (size_t)tid * 16);
        if (tid < 256) sk1 = *(const u32x4*)(kp + (size_t)(tid + 512) * 16);
        sv = *(const u32x4*)(VTg + (size_t)(tid >> 3) * SEQ + kt * 64 + (tid & 7) * 8);
    };
    auto lwrite = [&](int buf) {
        { const int c = tid; *(u32x4*)(smem + OK0 + buf * KB_ + (c / 12) * 208 + (c % 12) * 16) = sk0; }
        if (tid < 256) { const int c = tid + 512; *(u32x4*)(smem + OK0 + buf * KB_ + (c / 12) * 208 + (c % 12) * 16) = sk1; }
        *(u32x4*)(smem + OV0 + buf * VB_ + (tid >> 3) * 144 + (tid & 7) * 16) = sv;
    };
    __syncthreads();
    gload(0); lwrite(0);
    __syncthreads();
    for (int kt = 0; kt < nkt_b; ++kt) {
        if (kt + 1 < nkt_b) gload(kt + 1);
        if (kt < nkt_w) {
            const unsigned char* Kl = smem + OK0 + (kt & 1) * KB_; const unsigned char* Vl = smem + OV0 + (kt & 1) * VB_;
            f32x16 s0, s1;
#pragma unroll
            for (int i = 0; i < 16; ++i) { s0[i] = 0.f; s1[i] = 0.f; }
            bf16x8 kf[6][2], vf[2][2][2];
#pragma unroll
            for (int ks = 0; ks < 6; ++ks) { kf[ks][0] = *(const bf16x8*)(Kl + ql * 208 + (16 * ks + 8 * hf) * 2); kf[ks][1] = *(const bf16x8*)(Kl + (32 + ql) * 208 + (16 * ks + 8 * hf) * 2); }
            __builtin_amdgcn_sched_barrier(0);
#pragma unroll
            for (int ks = 0; ks < 6; ++ks) {
                s0 = __builtin_amdgcn_mfma_f32_32x32x16_bf16(kf[ks][0], qf[ks], s0, 0, 0, 0);
                s1 = __builtin_amdgcn_mfma_f32_32x32x16_bf16(kf[ks][1], qf[ks], s1, 0, 0, 0);
            }
#pragma unroll
            for (int u = 0; u < 2; ++u)
#pragma unroll
                for (int sp = 0; sp < 2; ++sp) { vf[u][sp][0] = *(const bf16x8*)(Vl + ql * 144 + (32 * u + 16 * sp + 8 * hf) * 2); vf[u][sp][1] = *(const bf16x8*)(Vl + (32 + ql) * 144 + (32 * u + 16 * sp + 8 * hf) * 2); }
            __builtin_amdgcn_sched_barrier(0);
            float mx = s0[0];
#pragma unroll
            for (int i = 1; i < 16; ++i) mx = fmaxf(mx, s0[i]);
#pragma unroll
            for (int i = 0; i < 16; ++i) mx = fmaxf(mx, s1[i]);
            mx = fmaxf(mx, __shfl_xor(mx, 32));
            const float mnew = fmaxf(mrun, mx), alpha = __builtin_amdgcn_exp2f(mrun - mnew);
            mrun = mnew;
            float ps = 0.f;
#pragma unroll
            for (int i = 0; i < 16; ++i) { s0[i] = __builtin_amdgcn_exp2f(s0[i] - mnew); s1[i] = __builtin_amdgcn_exp2f(s1[i] - mnew); ps += s0[i] + s1[i]; }
            lsum = lsum * alpha + ps;
#pragma unroll
            for (int i = 0; i < 16; ++i) { o0[i] *= alpha; o1[i] *= alpha; }
            bf16x8 pb[2][2];
#pragma unroll
            for (int sp = 0; sp < 2; ++sp) {
                pb[0][sp] = pack8((f32x4){s0[8 * sp], s0[8 * sp + 1], s0[8 * sp + 2], s0[8 * sp + 3]}, (f32x4){s0[8 * sp + 4], s0[8 * sp + 5], s0[8 * sp + 6], s0[8 * sp + 7]});
                pb[1][sp] = pack8((f32x4){s1[8 * sp], s1[8 * sp + 1], s1[8 * sp + 2], s1[8 * sp + 3]}, (f32x4){s1[8 * sp + 4], s1[8 * sp + 5], s1[8 * sp + 6], s1[8 * sp + 7]});
            }
#pragma unroll
            for (int u = 0; u < 2; ++u)
#pragma unroll
                for (int sp = 0; sp < 2; ++sp) {
                    o0 = __builtin_amdgcn_mfma_f32_32x32x16_bf16(vf[u][sp][0], pb[u][sp], o0, 0, 0, 0);
                    o1 = __builtin_amdgcn_mfma_f32_32x32x16_bf16(vf[u][sp][1], pb[u][sp], o1, 0, 0, 0);
                }
        }
        if (kt + 1 < nkt_b) lwrite((kt + 1) & 1);
        __syncthreads();
    }
    lsum += __shfl_xor(lsum, 32);
    const float inv = 1.f / lsum;
    const int b = bh >> 3, h = bh & 7;
    bf16_t* orow = OB + ((size_t)b * SEQ + q0 + ql) * 512 + h * 64;
#pragma unroll
    for (int r = 0; r < 16; ++r) { const int dv = (r & 3) + 8 * (r >> 2) + 4 * hf; orow[dv] = (bf16_t)f2bf(o0[r] * inv); orow[32 + dv] = (bf16_t)f2bf(o1[r] * inv); }
}

__device__ __forceinline__ void phase5(const Params& P) {
    unsigned char* ws = P.ws;
    const int tid_ = opaque_tid(), lane = tid_ & 63, gw = blockIdx.x * NWAVES + (tid_ >> 6), ngw = gridDim.x * NWAVES;
    const bf16_t* OB = (const bf16_t*)(ws + WS_OB); bf16_t* OCAT = (bf16_t*)(ws + WS_OCAT);
    for (int tq = gw; tq < T / 4; tq += ngw) {
        const int t0 = 4 * tq;
#pragma unroll
        for (int r = 0; r < 4; ++r) {
            const size_t row = (size_t)t0 + r;
            const u32x4 v = *((const u32x4*)(OB + row * 512) + lane);
            float f[8] = {bflo(v.x), bfhi(v.x), bflo(v.y), bfhi(v.y), bflo(v.z), bfhi(v.z), bflo(v.w), bfhi(v.w)};
            float ss = 0.f;
#pragma unroll
            for (int i = 0; i < 8; ++i) ss += f[i] * f[i];
            const float rstd = rsqrtf(wave_sum(ss) * (1.f / 512.f) + EPS);
            const float* wn = P.mla_out_norm_w + 8 * lane;
            u32x4 o; o.x = pk2(f[0] * rstd * wn[0], f[1] * rstd * wn[1]); o.y = pk2(f[2] * rstd * wn[2], f[3] * rstd * wn[3]); o.z = pk2(f[4] * rstd * wn[4], f[5] * rstd * wn[5]); o.w = pk2(f[6] * rstd * wn[6], f[7] * rstd * wn[7]);
            *((u32x4*)(OCAT + row * D + 512) + lane) = o;
        }
    }
}

__device__ __forceinline__ void phase7(const Params& P, unsigned char* smem) {
    unsigned char* ws = P.ws;
    const int tid = opaque_tid(), wave = tid >> 6, lane = tid & 63;
    float* rw = (float*)smem;
    int* lctl = (int*)(smem + LDS_MISC + 256);
    float* lgs = (float*)(smem + LDS_MISC + 256 + 2560);
    for (int i = tid; i < 1024 * 8; i += NTHREADS) { const int k = i >> 3, c = i & 7; const f32x4 v = *(const f32x4*)(P.router_w + (size_t)k * 32 + 4 * c) * P.norm_ffn_w[k];
        *(f32x4*)(rw + k * 32 + ((4 * c + 16 * ((k >> 2) & 1)) & 31)) = v; }
    const float* X1 = (const float*)(ws + WS_X1); unsigned char* H2 = ws + WS_H;
    int* tok_e = (int*)(ws + WS_TOKE); int* tok_r = (int*)(ws + WS_TOKR); float* gate = (float*)(ws + WS_GATE); int* list = (int*)(ws + WS_LIST);
    unsigned* cnt = (unsigned*)(ws + WS_CTL) + CW_CNT;
    for (int tg = blockIdx.x; tg < T / 64; tg += gridDim.x) {
    __syncthreads();
    if (tid < 64) lctl[tid] = 0;
    __syncthreads();
    if (wave < 4) {
        const int ti = lane & 15, kk = lane >> 4; const int row = tg * 64 + wave * 16 + ti;
        const f32x4* xr = (const f32x4*)(X1 + (size_t)row * D) + kk;
        const float* bw = rw + (4 * kk) * 32 + (((lane & 15) + 16 * (kk & 1)) & 31);
        f32x4 a0 = {0.f, 0.f, 0.f, 0.f}, a1 = {0.f, 0.f, 0.f, 0.f}; float ss = 0.f;
#pragma unroll 1
        for (int sb = 0; sb < 64; sb += 8) {
            f32x4 xv[8];
#pragma unroll
            for (int u = 0; u < 8; ++u) xv[u] = xr[4 * (sb + u)];
#pragma unroll
            for (int u = 0; u < 8; ++u) { ss += xv[u].x * xv[u].x + xv[u].y * xv[u].y + xv[u].z * xv[u].z + xv[u].w * xv[u].w;
#pragma unroll
                for (int j = 0; j < 4; ++j) { const float* bp = bw + (16 * (sb + u) + j) * 32; const float b0 = bp[0], b1 = *(const float*)((const char*)bp + ((((lane & 15) + 16 * (kk & 1)) & 16) ? -64 : 64));
                    a0 = __builtin_amdgcn_mfma_f32_16x16x4f32(xv[u][j], b0, a0, 0, 0, 0);
                    a1 = __builtin_amdgcn_mfma_f32_16x16x4f32(xv[u][j], b1, a1, 0, 0, 0); } }
        }
        ss += __shfl_xor(ss, 16); ss += __shfl_xor(ss, 32);
        const float rstd = rsqrtf(ss * (1.f / D) + EPS);
        float* lg = lgs + wave * (16 * 33);
#pragma unroll
        for (int r = 0; r < 4; ++r) { const int t = 4 * kk + r; const float rs = __shfl(rstd, t);
            lg[t * 33 + (lane & 15)] = a0[r] * rs + P.router_b[lane & 15]; lg[t * 33 + 16 + (lane & 15)] = a1[r] * rs + P.router_b[16 + (lane & 15)]; }
        asm volatile("s_waitcnt lgkmcnt(0)" ::: "memory");
        if (lane < 16) {
            const float* l = lg + lane * 33; const int trow = tg * 64 + wave * 16 + lane;
            int ei[4]; float ev[4];
#pragma unroll
            for (int k = 0; k < 4; ++k) { float best = -3.0e38f; int bi = 0;
                for (int j = 0; j < 32; ++j) { const float v = l[j]; const bool taken = (k > 0 && ei[0] == j) || (k > 1 && ei[1] == j) || (k > 2 && ei[2] == j); if (!taken && v > best) { best = v; bi = j; } }
                ei[k] = bi; ev[k] = best; }
            float gs = 0.f, gv[4];
#pragma unroll
            for (int k = 0; k < 4; ++k) { gv[k] = __expf(ev[k] - ev[0]); gs += gv[k]; }
            const float ig = 1.f / gs;
#pragma unroll
            for (int k = 0; k < 4; ++k) { const int lr = atomicAdd(&lctl[ei[k]], 1);
                lctl[64 + ((wave * 16 + lane) * 4 + k) * 2] = ei[k]; lctl[64 + ((wave * 16 + lane) * 4 + k) * 2 + 1] = lr; }
            *(f32x4*)(gate + (size_t)trow * 4) = (f32x4){gv[0] * ig, gv[1] * ig, gv[2] * ig, gv[3] * ig};
        }
    } else {
        for (int ti = 0; ti < 16; ++ti) { const int row = tg * 64 + (wave - 4) * 16 + ti;
            f32x4 v[4]; float ss = 0.f;
#pragma unroll
            for (int j = 0; j < 4; ++j) { v[j] = *((const f32x4*)(X1 + (size_t)row * D) + lane + 64 * j); ss += v[j].x * v[j].x + v[j].y * v[j].y + v[j].z * v[j].z + v[j].w * v[j].w; }
            const float rstd = rsqrtf(wave_sum(ss) * (1.f / D) + EPS);
#pragma unroll
            for (int j = 0; j < 4; ++j) { const f32x4 h = v[j] * rstd * *((const f32x4*)P.norm_ffn_w + lane + 64 * j);
                *((unsigned*)(H2 + (size_t)row * D) + lane + 64 * j) = pk4_fp8(h.x, h.y, h.z, h.w); }
        }
    }
    __syncthreads();
    if (tid < 32) lctl[32 + tid] = (int)atomicAdd(&cnt[tid], (unsigned)lctl[tid]);
    __syncthreads();
    if (tid < 256) { const int e = lctl[64 + tid * 2], lr = lctl[64 + tid * 2 + 1]; const int row = tg * 64 + (tid >> 2); const int rank = lctl[32 + e] + lr;
        tok_e[(size_t)row * 4 + (tid & 3)] = e; tok_r[(size_t)row * 4 + (tid & 3)] = rank; list[e * T + rank] = row; }
    }
}

__device__ __forceinline__ void moe_tiles(const Params& P, unsigned char* smem) {
    int* tstart = (int*)(smem + LDS_MISC + 256); int* cntl = tstart + 64;
    const unsigned* cnt = (const unsigned*)(P.ws + WS_CTL) + CW_CNT;
    __syncthreads();
    if (threadIdx.x == 0) { int acc = 0; for (int e = 0; e < NE; ++e) { const int c = (int)__hip_atomic_load(&cnt[e], __ATOMIC_RELAXED, __HIP_MEMORY_SCOPE_AGENT); cntl[e] = c; tstart[e] = acc; acc += (c + 255) >> 8; } tstart[NE] = acc;
        int* xs = tstart + 100; const int x = blockIdx.x & 7; int a2 = 0; for (int j = 0; j < 4; ++j) { xs[j] = a2; a2 += (cntl[x + 8 * j] + 255) >> 8; } xs[4] = a2; }
    __syncthreads();
}

__device__ __forceinline__ void phase8(const Params& P, unsigned char* smem) {
    unsigned char* ws = P.ws;
    const int tid_ = opaque_tid(), lane = tid_ & 63, gw = blockIdx.x * NWAVES + (tid_ >> 6), ngw = gridDim.x * NWAVES;
    const int* tstart = (const int*)(smem + LDS_MISC + 256);
    const int* tok_e = (const int*)(ws + WS_TOKE); const int* tok_r = (const int*)(ws + WS_TOKR);
    const unsigned char* H2 = ws + WS_H; unsigned char* XG = ws + WS_XG;
    for (int row = gw; row < T; row += ngw) {
        const u32x4 v = *((const u32x4*)(H2 + (size_t)row * D) + lane);
#pragma unroll
        for (int k = 0; k < 4; ++k) { const int e = tok_e[(size_t)row * 4 + k], rk = tok_r[(size_t)row * 4 + k];
            *((u32x4*)(XG + (size_t)(tstart[e] * 256 + rk) * D) + lane) = v; }
    }
}

__device__ __forceinline__ void phase11(const Params& P, unsigned char* smem) {
    unsigned char* ws = P.ws;
    const int tid_ = opaque_tid(), lane = tid_ & 63, gw = blockIdx.x * NWAVES + (tid_ >> 6), ngw = gridDim.x * NWAVES;
    const float* X1 = (const float*)(ws + WS_X1);
    const int* tstart = (const int*)(smem + LDS_MISC + 256);
    const int* tok_e = (const int*)(ws + WS_TOKE); const int* tok_r = (const int*)(ws + WS_TOKR); const float* gate = (const float*)(ws + WS_GATE); const bf16_t* Y = (const bf16_t*)(ws + WS_Y);
    struct Rec { int e[4], rk[4]; float g[4]; };
    auto ldrec = [&](int row, Rec& r) {
#pragma unroll
        for (int k = 0; k < 4; ++k) { r.e[k] = tok_e[(size_t)row * 4 + k]; r.rk[k] = tok_r[(size_t)row * 4 + k]; r.g[k] = gate[(size_t)row * 4 + k]; } };
    Rec rc, rn; f32x4 v[4], vn[4]; u32x2 y[4][4], yn[4][4];
    const int nrows = (T - gw + ngw - 1) / ngw;
    rn.e[0] = 0;
    if (nrows > 0) { ldrec(gw, rc);
#pragma unroll
        for (int j = 0; j < 4; ++j) v[j] = *((const f32x4*)(X1 + (size_t)gw * D) + lane + 64 * j);
        if (nrows > 1) ldrec(gw + ngw, rn);
#pragma unroll
        for (int k = 0; k < 4; ++k) { const bf16_t* yr = Y + (size_t)(tstart[rc.e[k]] * 256 + rc.rk[k]) * D;
#pragma unroll
            for (int j = 0; j < 4; ++j) y[k][j] = *((const u32x2*)yr + lane + 64 * j); } }
    for (int i = 0; i < nrows; ++i) {
        const int row = gw + i * ngw;
        Rec rnn = rn;
        if (i + 1 < nrows) {
#pragma unroll
            for (int j = 0; j < 4; ++j) vn[j] = *((const f32x4*)(X1 + (size_t)(row + ngw) * D) + lane + 64 * j);
#pragma unroll
            for (int k = 0; k < 4; ++k) { const bf16_t* yr = Y + (size_t)(tstart[rn.e[k]] * 256 + rn.rk[k]) * D;
#pragma unroll
                for (int j = 0; j < 4; ++j) yn[k][j] = *((const u32x2*)yr + lane + 64 * j); }
            if (i + 2 < nrows) ldrec(row + 2 * ngw, rnn);
        }
#pragma unroll
        for (int k = 0; k < 4; ++k) { const float gg = rc.g[k];
#pragma unroll
            for (int j = 0; j < 4; ++j) { const u32x2 yy = y[k][j]; v[j].x += gg * bflo(yy.x); v[j].y += gg * bfhi(yy.x); v[j].z += gg * bflo(yy.y); v[j].w += gg * bfhi(yy.y); } }
        float ss = 0.f;
#pragma unroll
        for (int j = 0; j < 4; ++j) ss += v[j].x * v[j].x + v[j].y * v[j].y + v[j].z * v[j].z + v[j].w * v[j].w;
        const float rstd = rsqrtf(wave_sum(ss) * (1.f / D) + EPS);
#pragma unroll
        for (int j = 0; j < 4; ++j) *((f32x4*)(P.out + (size_t)row * D) + lane + 64 * j) = v[j] * rstd * *((const f32x4*)P.norm_final_w + lane + 64 * j);
        rc = rn; rn = rnn;
#pragma unroll
        for (int j = 0; j < 4; ++j) { v[j] = vn[j];
#pragma unroll
            for (int k = 0; k < 4; ++k) y[k][j] = yn[k][j]; }
    }
}

extern "C" __global__ void __launch_bounds__(NTHREADS) fwd_megakernel(Params P) {
    extern __shared__ __attribute__((aligned(16))) unsigned char smem[];
    LAS unsigned char* lds = (LAS unsigned char*)smem;
    unsigned char* ws = P.ws;
    const int tid = threadIdx.x;
    const int G = gridDim.x, bid = blockIdx.x;
    volatile LAS unsigned* misc = (volatile LAS unsigned*)(lds + LDS_MISC);
    if (tid < 64) misc[tid] = 0u;
    __syncthreads();
    XcdBarrier bar = xcd_barrier_post((unsigned*)(ws + WS_CTL) + CW_BAR, misc);
#if TSA >= 0
    unsigned long long* tsw = (unsigned long long*)((unsigned*)(ws + WS_CTL) + CW_TS); int tsi = 0;
#define STAMP() do { if (bid == 0 && tid == 0) tsw[tsi] = __builtin_amdgcn_s_memrealtime(); ++tsi; } while (0)
#else
#define STAMP() do { } while (0)
#endif
#define GRID_BAR() do { xcd_barrier(bar); STAMP(); } while (0)
    STAMP();

    REP(0) phase0(P, smem);
    GRID_BAR();
#if LEVEL >= 2
    REP(1) {
        pg8::DenseOrder S{(const char*)(ws + WS_H), (const char*)(ws + WS_WIN), T / 256, DINP / 256, D, G, bid};
        EpiProj E{(bf16_t*)(ws + WS_PROJ)};
        pg8::gemm_phase<EpiProj, pg8::DenseOrder>(lds, D, S, E);
    }
    GRID_BAR();
    REP(2) phase2a(P);
#if LEVEL >= 3
    REP(12) { u32x4 raw[11]; const int tidp = opaque_tid();
        if (tidp < 384 && bid < NB * GH * NCH) prep_conv_load(P, bid, tidp, raw);
        for (int item = bid; item < NB * GH * NCH; item += G) gdn_prep_item(P, smem, item, (item + G < NB * GH * NCH) ? item + G : -1, raw); }
#endif
    GRID_BAR();
    REP(3) {
        pg8::DenseOrder S{(const char*)(ws + WS_CQN), (const char*)(ws + WS_WUQ), T / 256, 768 / 256, QL, G, bid};
        EpiQ E{(bf16_t*)(ws + WS_Q), (const float*)(ws + WS_TAB)};
        pg8::gemm_phase<EpiQ, pg8::DenseOrder>(lds, QL, S, E);
        pg8::DenseOrder S2{(const char*)(ws + WS_CKVN), (const char*)(ws + WS_WUKV), T / 256, 1024 / 256, KVL, G, (bid + 64) % G};
        EpiKV E2{(bf16_t*)(ws + WS_K), (bf16_t*)(ws + WS_VT)};
        pg8::gemm_phase<EpiKV, pg8::DenseOrder>(lds, KVL, S2, E2);
    }
    GRID_BAR();
    {
        REP(14) if (bid < NB * GH) gdn_scan(P, smem, bid);
#if TSA >= 0
        if (bid == 0 && tid == 0) { tsw[20] = tsw[tsi - 1]; tsw[21] = __builtin_amdgcn_s_memrealtime(); }
#endif
        const int tidq = opaque_tid();
        const bool tfirst = ((bid & 7) >= 5);
        for (int rep_ = 0; rep_ < ((DUP == 4 || DUP == 15) ? 2 : 1); ++rep_)
#pragma unroll 1
        for (int pass = 0; pass < 2; ++pass) {
            unsigned* aq = (unsigned*)(ws + WS_CTL) + CW_AQ + 128 * rep_;
            const bool do_t = (pass == 0) == tfirst;
            unsigned* qh = aq + (do_t ? 64 : 0);
            const int qn = do_t ? 0 : ((rep_ == 1 && DUP == 15) ? 0 : 512);
            if (do_t) { if (!(rep_ == 1 && DUP == 4)) late_transposes(P, smem, qh, misc, tidq); continue; }
            for (;;) {
                __syncthreads();
                if (tidq == 0) misc[8] = atomicAdd(qh, 1u);
                __syncthreads();
                const int item = (int)misc[8];
                if (item >= qn) break;
                attn_item(P, smem, item);
            }
        }
    }
    GRID_BAR();
    REP(5) { phase5(P);
        GdnOutRegs R; const int tido = opaque_tid();
        if (bid < NB * GH * NCH) gdn_out_load(P, bid, tido, R);
        for (int item = bid; item < NB * GH * NCH; item += G) gdn_out_item(P, smem, item, (item + G < NB * GH * NCH) ? item + G : -1, R); }
    GRID_BAR();
    REP(6) {
        pg8::DenseOrder S{(const char*)(ws + WS_OCAT), (const char*)(ws + WS_WOUT), T / 256, D / 256, D, G, bid};
        EpiX1 E{P.x, (float*)(ws + WS_X1)};
        pg8::gemm_phase<EpiX1, pg8::DenseOrder>(lds, D, S, E);
    }
    GRID_BAR();
#endif
#if LEVEL >= 4
    phase7(P, smem);
    GRID_BAR();
    moe_tiles(P, smem);
    REP(9) {
        const LAS int* ts = (const LAS int*)(lds + LDS_MISC + 256);
        MoeOrder1 S{(const char*)(ws + WS_H), (const char*)(ws + WS_W1), (const int*)(ws + WS_LIST), ts, ts + 64, ts + 100, G, bid};
        EpiAct E{ws + WS_ACT, P.b1};
        pg8::gemm_phase<EpiAct, MoeOrder1, true>(lds, D, S, E);
    }
    GRID_BAR();
    REP(10) {
        const LAS int* ts = (const LAS int*)(lds + LDS_MISC + 256);
        MoeOrder2 S{(const char*)(ws + WS_ACT), (const char*)(ws + WS_W2), ts, ts + 100, G, bid};
        EpiY E{(bf16_t*)(ws + WS_Y), P.b2};
        pg8::gemm_phase<EpiY, MoeOrder2, true>(lds, DFF, S, E);
    }
    GRID_BAR();
#endif
    REP(11) phase11(P, smem);
#if TSA >= 0
    if (bid == 0) {
        __syncthreads();
        if (tid == 0) { const unsigned long long dt = tsw[TSA + 1] - tsw[TSA], t0 = __builtin_amdgcn_s_memrealtime();
            while (__builtin_amdgcn_s_memrealtime() - t0 < dt) __builtin_amdgcn_s_sleep(8); }
        __syncthreads();
    }
#endif
}

extern "C" void kernel_launch(void* const* d_in, const int* in_sizes, int n_in, void* d_out, int out_size, void* d_ws, size_t ws_size, hipStream_t stream) {
    static int grid = 0;
    if (grid == 0) {
        if (n_in != 22 || in_sizes[0] != T * D || out_size != T * D || ws_size < WS_END) {
            fprintf(stderr, "kernel_launch: unexpected shapes (n_in %d, in0 %d, out %d, ws %zu < %zu)\n", n_in, n_in > 0 ? in_sizes[0] : -1, out_size, ws_size, (size_t)WS_END); grid = -1; return; }
        int dev = 0, cus = 0, per_cu = 0;
        if (hipGetDevice(&dev) != hipSuccess || hipDeviceGetAttribute(&cus, hipDeviceAttributeMultiprocessorCount, dev) != hipSuccess) { grid = -1; return; }
        if (hipFuncSetAttribute((const void*)fwd_megakernel, hipFuncAttributeMaxDynamicSharedMemorySize, LDS_BYTES) != hipSuccess) { fprintf(stderr, "kernel_launch: hipFuncSetAttribute failed\n"); grid = -1; return; }
        if (hipOccupancyMaxActiveBlocksPerMultiprocessor(&per_cu, (const void*)fwd_megakernel, NTHREADS, LDS_BYTES) != hipSuccess || per_cu < 1) { fprintf(stderr, "kernel_launch: occupancy query says %d\n", per_cu); (void)hipGetLastError(); grid = -1; return; }
        grid = cus;
        if (grid != 256) fprintf(stderr, "kernel_launch: note: %d CUs\n", grid);
    }
    if (grid < 0) return;
    (void)hipMemsetAsync((char*)d_ws + WS_CTL, 0, CTL_BYTES, stream);
    Params p{};
    p.x = (const float*)d_in[0]; p.pos = (const int*)d_in[1]; p.norm_mix_w = (const float*)d_in[2]; p.w_in = (const float*)d_in[3]; p.conv_w = (const float*)d_in[4];
    p.a_log = (const float*)d_in[5]; p.dt_bias = (const float*)d_in[6]; p.gdn_norm_w = (const float*)d_in[7]; p.q_norm_w = (const float*)d_in[8]; p.w_uq = (const float*)d_in[9];
    p.kv_norm_w = (const float*)d_in[10]; p.w_ukv = (const float*)d_in[11]; p.mla_out_norm_w = (const float*)d_in[12]; p.w_out = (const float*)d_in[13]; p.norm_ffn_w = (const float*)d_in[14];
    p.router_w = (const float*)d_in[15]; p.router_b = (const float*)d_in[16]; p.w1 = (const float*)d_in[17]; p.b1 = (const float*)d_in[18]; p.w2 = (const float*)d_in[19];
    p.b2 = (const float*)d_in[20]; p.norm_final_w = (const float*)d_in[21]; p.out = (float*)d_out; p.ws = (unsigned char*)d_ws;
    void* args[] = {&p};
    hipError_t e = hipLaunchCooperativeKernel((const void*)fwd_megakernel, dim3(grid), dim3(NTHREADS), args, LDS_BYTES, stream);
    if (e != hipSuccess) fprintf(stderr, "kernel_launch: cooperative launch failed: %s (grid %d)\n", hipGetErrorString(e), grid);
}
```

```cpp
#include <hip/hip_runtime.h>
#include <cstdio>
#include <cstdint>

#ifndef LEVEL
#define LEVEL 4
#endif

#ifndef DUP
#define DUP -1
#endif
#ifndef TSA
#define TSA -1
#define TSB -1
#endif
#define REP(k) for (int rep_ = 0; rep_ < ((DUP == (k)) ? 2 : 1); ++rep_)
#define LAS __attribute__((address_space(3)))
typedef unsigned short bf16_t;
typedef short bf16x8 __attribute__((ext_vector_type(8)));
typedef float f32x4 __attribute__((ext_vector_type(4)));
typedef float f32x16 __attribute__((ext_vector_type(16)));
typedef unsigned u32x4 __attribute__((ext_vector_type(4)));
typedef unsigned u32x2 __attribute__((ext_vector_type(2)));

constexpr int NB = 4, SEQ = 4096, T = NB * SEQ, D = 1024, DIN = 2728, DINP = 2816;
constexpr int GH = 4, NCH = SEQ / 64;
constexpr int MH = 8, DQK = 96, QL = 384, KVL = 256;
constexpr int NE = 32, DFF = 1024;
constexpr int C_Z = 1536, C_CQ = 2056, C_CKV = 2440, C_KR = 2696;
constexpr float EPS = 1e-6f;
constexpr int NTHREADS = 512, NWAVES = 8;
constexpr int LDS_BYTES = 147456;
constexpr int LDS_MISC = 131072;
constexpr int MOE_MAXROWS = 73728;

constexpr size_t MiB = 1u << 20;
constexpr size_t WS_CTL = 0, CTL_BYTES = 65536;
constexpr size_t WS_WIN = 1 * MiB, WS_WUQ = 7 * MiB, WS_WUKV = 8 * MiB, WS_WOUT = 9 * MiB, WS_W1 = 11 * MiB, WS_W2 = 139 * MiB;
constexpr size_t WS_X1 = 203 * MiB, WS_H = 267 * MiB, WS_AB = 299 * MiB, WS_TAB = 300 * MiB;
constexpr size_t WS_TOKE = 302 * MiB, WS_TOKR = WS_TOKE + 256 * 1024, WS_GATE = WS_TOKR + 256 * 1024, WS_LIST = 303 * MiB;
constexpr size_t WS_R = 306 * MiB;
constexpr size_t WS_PROJ = WS_R, WS_CQN = WS_R + 88 * MiB, WS_CKVN = WS_R + 100 * MiB, WS_Q = WS_R + 108 * MiB, WS_K = WS_R + 132 * MiB, WS_VT = WS_R + 156 * MiB;
constexpr size_t WS_GP = WS_R + 172 * MiB;
constexpr size_t GP_ITEM = 90112, GP_U = 0, GP_W = 32768, GP_QD = 49152, GP_KDT = 65536, GP_QK = 81920;
constexpr size_t WS_GT = WS_R + 260 * MiB, WS_OA = WS_R + 261 * MiB, WS_OB = WS_R + 293 * MiB, WS_OCAT = WS_R + 309 * MiB;
constexpr size_t WS_ACT = WS_R, WS_Y = WS_R + 144 * MiB, WS_XG = WS_R + 288 * MiB;
constexpr size_t WS_SB = WS_R + 341 * MiB;
constexpr size_t WS_END = WS_R + 373 * MiB;
constexpr int CW_BAR = 4096, CW_CNT = 8192  , CW_AQ = 8320  , CW_TS = 12288  ;

struct Params {
    const float* x; const int* pos; const float* norm_mix_w; const float* w_in; const float* conv_w; const float* a_log; const float* dt_bias;
    const float* gdn_norm_w; const float* q_norm_w; const float* w_uq; const float* kv_norm_w; const float* w_ukv; const float* mla_out_norm_w;
    const float* w_out; const float* norm_ffn_w; const float* router_w; const float* router_b; const float* w1; const float* b1; const float* w2;
    const float* b2; const float* norm_final_w; float* out; unsigned char* ws;
};

typedef float f32x2v __attribute__((ext_vector_type(2)));
typedef __bf16 bf16x2v __attribute__((ext_vector_type(2)));
__device__ __forceinline__ unsigned pk2(float lo, float hi) { const f32x2v v = {lo, hi}; return __builtin_bit_cast(unsigned, __builtin_convertvector(v, bf16x2v)); }
__device__ __forceinline__ unsigned f2bf(float f) { return pk2(f, 0.f) & 0xffffu; }
__device__ __forceinline__ unsigned pk4_fp8(float a, float b, float c, float d) { unsigned w = 0u; w = __builtin_amdgcn_cvt_pk_fp8_f32(a, b, w, false); w = __builtin_amdgcn_cvt_pk_fp8_f32(c, d, w, true); return w; }
typedef int v4i_t __attribute__((ext_vector_type(4)));
typedef int v8i_t __attribute__((ext_vector_type(8)));
__device__ __forceinline__ float bflo(unsigned u) { return __builtin_bit_cast(float, u << 16); }
__device__ __forceinline__ float bfhi(unsigned u) { return __builtin_bit_cast(float, u & 0xffff0000u); }
__device__ __forceinline__ float bf1(bf16_t b) { return __builtin_bit_cast(float, (unsigned)b << 16); }
__device__ __forceinline__ float wave_sum(float v) {
#pragma unroll
    for (int o = 1; o < 64; o <<= 1) v += __shfl_xor(v, o);
    return v;
}
__device__ __forceinline__ int opaque_tid() { int t = threadIdx.x; asm volatile("" : "+v"(t)); return t; }
__device__ __forceinline__ float sigmoidf_(float x) { return __builtin_amdgcn_rcpf(1.f + __builtin_amdgcn_exp2f(-1.4426950408889634f * x)); }
__device__ __forceinline__ bf16x8 pack8(f32x4 a, f32x4 b) {
    u32x4 r; r.x = pk2(a.x, a.y); r.y = pk2(a.z, a.w); r.z = pk2(b.x, b.y); r.w = pk2(b.z, b.w);
    return __builtin_bit_cast(bf16x8, r);
}
__device__ __forceinline__ int perm32k(int d) { return (d & ~31) | (((d >> 2) & 3) << 3) | (((d >> 4) & 1) << 2) | (d & 3); }
__device__ __forceinline__ int perm16v(int s) { return (s & ~15) | (((s >> 2) & 1) << 3) | (((s >> 3) & 1) << 2) | (s & 3); }

#define XB_TMO      128
#define XB_XCNT(j)  (256  + 64 * (j))
#define XB_XSUB(j)  (1280 + 64 * (j))
#define XB_XGEN(j)  (2304 + 64 * (j))
#define XB_TOP      3328
#define XB_TOPGEN   3392
#define XCD_BAR_WORDS 3456
#define XB_SPIN_CAP (1u << 18)
__device__ __forceinline__ unsigned xb_ld(unsigned* p)              { return __hip_atomic_load(p, __ATOMIC_RELAXED, __HIP_MEMORY_SCOPE_AGENT); }
__device__ __forceinline__ unsigned xb_add(unsigned* p, unsigned v) { return __hip_atomic_fetch_add(p, v, __ATOMIC_RELAXED, __HIP_MEMORY_SCOPE_AGENT); }
__device__ __forceinline__ unsigned xb_xcc_id() { return (unsigned)__builtin_amdgcn_s_getreg((3 << 11) | 20) & 0xFu; }
#define XB_SPIN(cond, bar) do { unsigned _sp = 0; while (cond) { __builtin_amdgcn_s_sleep(1); \
    if ((++_sp & 255u) == 0u) { if (xb_ld(&(bar)[XB_TMO])) break; if (_sp > XB_SPIN_CAP) { atomicAdd(&(bar)[XB_TMO], 1u); break; } } } } while (0)
struct XcdBarrier { unsigned* bar; unsigned x; volatile LAS unsigned* st; };
__device__ __forceinline__ XcdBarrier xcd_barrier_post(unsigned* bar, volatile LAS unsigned* st) {
    XcdBarrier b; b.bar = bar; b.x = xb_xcc_id(); b.st = st;
    if (threadIdx.x == 0) (void)xb_add(&bar[XB_XCNT(b.x)], 1u);
    return b;
}
__device__ __forceinline__ void xcd_barrier_complete(unsigned* bar, unsigned x, unsigned& nloc, unsigned& nx) {
    const unsigned G = gridDim.x * gridDim.y * gridDim.z;
    unsigned sum, cnt, mine, sp = 0u;
    for (;;) {
        sum = 0u; cnt = 0u; mine = 0u;
#pragma unroll
        for (unsigned j = 0; j < 16; ++j) { const unsigned c = xb_ld(&bar[XB_XCNT(j)]); sum += c; cnt += (c > 0u) ? 1u : 0u; mine = (j == x) ? c : mine; }
        if (sum == G) break;
        __builtin_amdgcn_s_sleep(1);
        if ((++sp & 255u) == 0u) { if (xb_ld(&bar[XB_TMO])) break; if (sp > XB_SPIN_CAP) { atomicAdd(&bar[XB_TMO], 1u); break; } }
    }
    nloc = mine > 0u ? mine : 1u; nx = cnt > 0u ? cnt : 1u;
}
__device__ __forceinline__ void xcd_barrier(const XcdBarrier& b) {
    asm volatile("s_waitcnt vmcnt(0)" ::: "memory");
    __syncthreads();
    if (threadIdx.x == 0) {
        unsigned* bar = b.bar;
        __builtin_amdgcn_s_waitcnt(0);
        unsigned nloc = b.st[0], nx = b.st[1];
        if (nloc == 0u) { xcd_barrier_complete(bar, b.x, nloc, nx); b.st[0] = nloc; b.st[1] = nx; }
        const unsigned old = xb_add(&bar[XB_XSUB(b.x)], 1u);
        const unsigned gen = old / nloc;
        if (old + 1u == (gen + 1u) * nloc) {
            __builtin_amdgcn_fence(__ATOMIC_RELEASE, "agent");
            asm volatile("s_waitcnt vmcnt(0)" ::: "memory");
            const unsigned og = xb_add(&bar[XB_TOP], 1u);
            const unsigned tg = og / nx;
            if (og + 1u == (tg + 1u) * nx) xb_add(&bar[XB_TOPGEN], 1u);
            else XB_SPIN(xb_ld(&bar[XB_TOPGEN]) == tg, bar);
            __builtin_amdgcn_fence(__ATOMIC_ACQUIRE, "agent");
            xb_add(&bar[XB_XGEN(b.x)], 1u);
            asm volatile("s_waitcnt vmcnt(0)" ::: "memory");
        } else {
            XB_SPIN(xb_ld(&bar[XB_XGEN(b.x)]) == gen, bar);
            __builtin_amdgcn_fence(__ATOMIC_ACQUIRE, "agent");
            asm volatile("s_waitcnt vmcnt(0)" ::: "memory");
        }
    }
    __syncthreads();
}

namespace pg8 {
constexpr int BM = 256, BK = 64, HALF = 128, HTB = HALF * BK * 2, NXCD = 8, WGM = 8;
__device__ __forceinline__ int lds_byte(int r, int c) { const int st = (r >> 4) * 2 + (c >> 5), rr = r & 15, cc = c & 31, ob = rr * 64 + cc * 2; return st * 1024 + (ob ^ (((ob >> 9) & 1) << 5)); }
__device__ __forceinline__ void stage_rc(int b, int& R, int& C) { const int st = b / 1024, sb = b % 1024, swz = sb ^ (((sb >> 9) & 1) << 5); R = (st >> 1) * 16 + swz / 64; C = (st & 1) * 32 + (swz % 64) / 2; }
__device__ __forceinline__ int perm32(int rho) { const int n = rho >> 4, i = rho & 15; return 8 * (i >> 2) + 4 * n + (i & 3); }

struct Unit { int pm, pn, e; const char* A; const char* B; };

__device__ __forceinline__ void tile_order(int L, int nM, int nN, int& pm, int& pn) {
    const int nwg = nM * nN; int wgid = L;
    { const int q = nwg / NXCD, r = nwg % NXCD, xcd = wgid % NXCD, off = wgid / NXCD; wgid = (xcd < r ? xcd * (q + 1) : r * (q + 1) + (xcd - r) * q) + off; }
    const int nig = WGM * nN, gid = wgid / nig, fm = gid * WGM, gsz = (nM - fm) < WGM ? (nM - fm) : WGM;
    pm = fm + ((wgid % nig) % gsz); pn = (wgid % nig) / gsz;
}

template <class Epi, class Sched, bool FP8 = false>
__device__ __forceinline__ void gemm_phase(LAS unsigned char* lds, const int K, const Sched& S, const Epi& E) {
    const int tid = opaque_tid(), wid = __builtin_amdgcn_readfirstlane(tid >> 6), lane = tid & 63, wr = wid >> 2, wc = wid & 3, fr = lane & 15, fq = lane >> 4;
    const int RB = FP8 ? K : 2 * K;
    const int nt = RB / 128;
    int Rr[2], Cc[2];
    unsigned voffB[2];
#pragma unroll
    for (int i = 0; i < 2; ++i) { stage_rc(tid * 16 + i * 8192, Rr[i], Cc[i]); const int Rb = Epi::PERM ? ((Rr[i] & ~31) + perm32(Rr[i] & 31)) : Rr[i]; voffB[i] = (unsigned)(Rb * RB + Cc[i] * 2); }
    const size_t kstep = (size_t)(BK * 2);
    const unsigned hstep = (unsigned)HALF * RB;
    const unsigned ldsw = (unsigned)wid * 1024u;
    const int aoff = lds_byte(wr * 64 + fr, fq * 8), boff = lds_byte(wc * 32 + fr, fq * 8);
#define PG8_SA(b, h) (((b) * 2 + (h)) * HTB)
#define PG8_SB(b, h) ((4 + (b) * 2 + (h)) * HTB)
#define PG8_RS(p) __builtin_amdgcn_make_buffer_rsrc((void*)(p), 0, 0x7fffffff, 0x00020000)
#define PG8_STAGE_A(bufoff, base, kb, h, VO) do { const auto rs_ = PG8_RS(base); _Pragma("unroll") for (int _i = 0; _i < 2; ++_i) \
        __builtin_amdgcn_raw_ptr_buffer_load_lds(rs_, (LAS void*)(lds + (bufoff) + ldsw + _i * 8192), 16, (int)(VO)[Sched::GATHER ? (h) : 0][_i], (int)((kb) + (Sched::GATHER ? 0u : (h) * hstep)), 0, 0); } while (0)
#define PG8_STAGE_B(bufoff, base, kb, h) do { const auto rs_ = PG8_RS(base); _Pragma("unroll") for (int _i = 0; _i < 2; ++_i) \
        __builtin_amdgcn_raw_ptr_buffer_load_lds(rs_, (LAS void*)(lds + (bufoff) + ldsw + _i * 8192), 16, (int)voffB[_i], (int)((kb) + (h) * hstep), 0, 0); } while (0)
#define PG8_LDA(dst, b, h) do { if constexpr (FP8) { _Pragma("unroll") for (int m = 0; m < 4; ++m) { const v4i_t x0_ = *(const LAS v4i_t*)(lds + PG8_SA(b, h) + aoff + m * 2048), x1_ = *(const LAS v4i_t*)(lds + PG8_SA(b, h) + aoff + m * 2048 + 1024); \
            dst##8[m] = __builtin_shufflevector(x0_, x1_, 0, 1, 2, 3, 4, 5, 6, 7); } } \
        else { _Pragma("unroll") for (int m = 0; m < 4; ++m) _Pragma("unroll") for (int k = 0; k < 2; ++k) dst[m][k] = *(const LAS bf16x8*)(lds + PG8_SA(b, h) + aoff + m * 2048 + k * 1024); } } while (0)
#define PG8_LDB(dst, b, h) do { if constexpr (FP8) { _Pragma("unroll") for (int n = 0; n < 2; ++n) { const v4i_t x0_ = *(const LAS v4i_t*)(lds + PG8_SB(b, h) + boff + n * 2048), x1_ = *(const LAS v4i_t*)(lds + PG8_SB(b, h) + boff + n * 2048 + 1024); \
            dst##8[n] = __builtin_shufflevector(x0_, x1_, 0, 1, 2, 3, 4, 5, 6, 7); } } \
        else { _Pragma("unroll") for (int n = 0; n < 2; ++n) _Pragma("unroll") for (int k = 0; k < 2; ++k) dst[n][k] = *(const LAS bf16x8*)(lds + PG8_SB(b, h) + boff + n * 2048 + k * 1024); } } while (0)
#define PG8_MMA(ai, bj, At, Bt) do { __builtin_amdgcn_s_setprio(1); \
        if constexpr (FP8) { _Pragma("unroll") for (int m = 0; m < 4; ++m) _Pragma("unroll") for (int n = 0; n < 2; ++n) \
            asm volatile("v_mfma_f32_16x16x128_f8f6f4 %0, %1, %2, %0" : "+v"(acc[ai][bj][m][n]) : "v"(Bt##8[n]), "v"(At##8[m])); } \
        else { _Pragma("unroll") for (int m = 0; m < 4; ++m) _Pragma("unroll") for (int n = 0; n < 2; ++n) _Pragma("unroll") for (int k = 0; k < 2; ++k) \
            acc[ai][bj][m][n] = __builtin_amdgcn_mfma_f32_16x16x32_bf16(Bt[n][k], At[m][k], acc[ai][bj][m][n], 0, 0, 0); } \
        __builtin_amdgcn_s_setprio(0); } while (0)
#define PG8_WAIT_V(n) asm volatile("s_waitcnt vmcnt(" #n ")" ::: "memory")
#define PG8_WAIT_L(n) asm volatile("s_waitcnt lgkmcnt(" #n ")" ::: "memory")
#define PG8_BAR __builtin_amdgcn_s_barrier()
#define PG8_SCHED __builtin_amdgcn_sched_barrier(0)
#define PG8_AOFFS(VO, u) do { _Pragma("unroll") for (int _h = 0; _h < 2; ++_h) _Pragma("unroll") for (int _i = 0; _i < 2; ++_i) { \
        if constexpr (Sched::GATHER) VO[_h][_i] = (unsigned)S.row_src(u, _h * HALF + Rr[_i]) * (unsigned)RB + (unsigned)(Cc[_i] * 2); \
        else VO[_h][_i] = (unsigned)(Rr[_i] * RB + Cc[_i] * 2); } } while (0)
    Unit cur, nxt; int ui = 0;
    if (!S.next(0, cur)) return;
    unsigned voc[2][2], von[2][2];
    PG8_AOFFS(voc, cur);
    f32x4 acc[2][2][4][2];
#pragma unroll
    for (int a = 0; a < 2; ++a)
#pragma unroll
        for (int b = 0; b < 2; ++b)
#pragma unroll
            for (int m = 0; m < 4; ++m)
#pragma unroll
                for (int n = 0; n < 2; ++n) acc[a][b][m][n] = (f32x4){0.f, 0.f, 0.f, 0.f};
    bf16x8 At[4][2], B0[2][2], B1[2][2]; v8i_t At8[4], B08[2], B18[2];
    const char* cA = cur.A; const char* cB = cur.B;
    PG8_STAGE_B(PG8_SB(0, 0), cB, 0, 0); PG8_STAGE_A(PG8_SA(0, 0), cA, 0, 0, voc); PG8_STAGE_B(PG8_SB(0, 1), cB, 0, 1); PG8_STAGE_A(PG8_SA(0, 1), cA, 0, 1, voc);
    if (wr == 1) PG8_BAR;
    PG8_WAIT_V(4); PG8_BAR;
    PG8_STAGE_B(PG8_SB(1, 0), cB, kstep, 0); PG8_STAGE_A(PG8_SA(1, 0), cA, kstep, 0, voc); PG8_STAGE_B(PG8_SB(1, 1), cB, kstep, 1);
    PG8_WAIT_V(6); PG8_BAR;
    for (;;) {
        const bool has_next = S.next(ui + 1, nxt);
        if constexpr (Sched::GATHER) {
            if (has_next) { PG8_AOFFS(von, nxt); }
            else {
#pragma unroll
                for (int _h = 0; _h < 2; ++_h)
#pragma unroll
                    for (int _i = 0; _i < 2; ++_i) von[_h][_i] = voc[_h][_i];
            }
        }
        const char* nA = has_next ? nxt.A : cA; const char* nB = has_next ? nxt.B : cB;
        for (int t = 0; t < nt; t += 2) {
            const bool last = (t == nt - 2);
            const size_t k1 = (size_t)(t + 1) * kstep;
            const char* a2 = last ? nA : cA; const char* b2 = last ? nB : cB;
            const size_t k2 = last ? 0 : (size_t)(t + 2) * kstep, k3 = k2 + kstep;
            unsigned vo2[2][2];
#pragma unroll
            for (int _h = 0; _h < 2; ++_h)
#pragma unroll
                for (int _i = 0; _i < 2; ++_i) { if constexpr (Sched::GATHER) vo2[_h][_i] = last ? von[_h][_i] : voc[_h][_i]; else vo2[_h][_i] = voc[_h][_i]; }
            PG8_LDB(B0, 0, 0); PG8_SCHED; PG8_LDA(At, 0, 0); PG8_STAGE_A(PG8_SA(1, 1), cA, k1, 1, voc);
            PG8_WAIT_L(8); PG8_BAR; PG8_WAIT_L(0); PG8_MMA(0, 0, At, B0); PG8_BAR; PG8_SCHED;
            PG8_LDB(B1, 0, 1); PG8_STAGE_B(PG8_SB(0, 0), b2, k2, 0);
            PG8_BAR; PG8_WAIT_L(0); PG8_MMA(0, 1, At, B1); PG8_BAR;
            PG8_LDA(At, 0, 1); PG8_STAGE_A(PG8_SA(0, 0), a2, k2, 0, vo2);
            PG8_BAR; PG8_WAIT_L(0); PG8_MMA(1, 0, At, B0); PG8_BAR; PG8_SCHED;
            PG8_STAGE_B(PG8_SB(0, 1), b2, k2, 1);
            PG8_WAIT_V(6); PG8_BAR; PG8_MMA(1, 1, At, B1); PG8_BAR;
            PG8_LDB(B0, 1, 0); PG8_SCHED; PG8_LDA(At, 1, 0); PG8_STAGE_A(PG8_SA(0, 1), a2, k2, 1, vo2);
            PG8_WAIT_L(8); PG8_BAR; PG8_WAIT_L(0); PG8_MMA(0, 0, At, B0); PG8_BAR; PG8_SCHED;
            PG8_LDB(B1, 1, 1); PG8_STAGE_B(PG8_SB(1, 0), b2, k3, 0);
            PG8_BAR; PG8_WAIT_L(0); PG8_MMA(0, 1, At, B1); PG8_BAR;
            PG8_LDA(At, 1, 1); PG8_STAGE_A(PG8_SA(1, 0), a2, k3, 0, vo2);
            PG8_BAR; PG8_WAIT_L(0); PG8_MMA(1, 0, At, B0); PG8_BAR; PG8_SCHED;
            PG8_STAGE_B(PG8_SB(1, 1), b2, k3, 1);
            PG8_WAIT_V(6); PG8_BAR; PG8_MMA(1, 1, At, B1); PG8_BAR;
        }
        if constexpr (FP8) asm volatile("s_nop 15\n\ts_nop 15" ::: "memory");
        E(acc, cur, wr, wc, fr, fq);
        if (!has_next) break;
#pragma unroll
        for (int a = 0; a < 2; ++a)
#pragma unroll
            for (int b = 0; b < 2; ++b)
#pragma unroll
                for (int m = 0; m < 4; ++m)
#pragma unroll
                    for (int n = 0; n < 2; ++n) acc[a][b][m][n] = (f32x4){0.f, 0.f, 0.f, 0.f};
        cur = nxt; cA = nA; cB = nB; ++ui;
        if constexpr (Sched::GATHER) {
#pragma unroll
            for (int _h = 0; _h < 2; ++_h)
#pragma unroll
                for (int _i = 0; _i < 2; ++_i) voc[_h][_i] = von[_h][_i];
        }
    }
    PG8_WAIT_V(0);
    if (wr == 0) PG8_BAR;
    PG8_BAR;
#undef PG8_SA
#undef PG8_SB
#undef PG8_STAGE_A
#undef PG8_RS
#undef PG8_STAGE_B
#undef PG8_LDA
#undef PG8_LDB
#undef PG8_MMA
#undef PG8_WAIT_V
#undef PG8_WAIT_L
#undef PG8_BAR
#undef PG8_SCHED
#undef PG8_AOFFS
}

struct DenseOrder {
    static constexpr bool GATHER = false;
    const char* A; const char* Bt; int nM, nN, K, G, c;
    __device__ __forceinline__ bool next(int i, Unit& u) const {
        const int L = i * G + c; if (L >= nM * nN) return false;
        tile_order(L, nM, nN, u.pm, u.pn); u.e = 0;
        u.A = A + (size_t)u.pm * BM * K * 2; u.B = Bt + (size_t)u.pn * BM * K * 2; return true;
    }
    __device__ __forceinline__ int row_src(const Unit&, int) const { return 0; }
};
}
using pg8::Unit;

struct EpiProj {
    static constexpr bool PERM = true;
    bf16_t* O;
    __device__ __forceinline__ void operator()(const f32x4 (&acc)[2][2][4][2], const Unit& u, int wr, int wc, int fr, int fq) const {
#pragma unroll
        for (int ai = 0; ai < 2; ++ai)
#pragma unroll
            for (int m = 0; m < 4; ++m) { const int row = u.pm * 256 + ai * 128 + wr * 64 + m * 16 + fr;
#pragma unroll
                for (int bj = 0; bj < 2; ++bj) { const int col = u.pn * 256 + bj * 128 + wc * 32 + 8 * fq; const f32x4 v0 = acc[ai][bj][m][0], v1 = acc[ai][bj][m][1];
                    u32x4 o; o.x = pk2(v0.x, v0.y); o.y = pk2(v0.z, v0.w); o.z = pk2(v1.x, v1.y); o.w = pk2(v1.z, v1.w);
                    *(u32x4*)(O + (size_t)row * DINP + col) = o; } }
    }
};
struct EpiQ {
    static constexpr bool PERM = false;
    bf16_t* Q; const float* tab;
    __device__ __forceinline__ void operator()(const f32x4 (&acc)[2][2][4][2], const Unit& u, int wr, int wc, int fr, int fq) const {
        const float sc = 0.10206207261596577f * 1.4426950408889634f;
#pragma unroll
        for (int ai = 0; ai < 2; ++ai)
#pragma unroll
            for (int m = 0; m < 4; ++m) { const int row = u.pm * 256 + ai * 128 + wr * 64 + m * 16 + fr; const int b = row / SEQ, s = row % SEQ;
#pragma unroll
                for (int bj = 0; bj < 2; ++bj) { const int c0 = u.pn * 256 + bj * 128 + wc * 32; const int g32 = c0 >> 5; const int head = c0 / 96;
                    f32x4 v0 = acc[ai][bj][m][0], v1 = acc[ai][bj][m][1];
                    if (g32 % 3 == 2) {
                        const f32x4 cs = *(const f32x4*)(tab + (unsigned)(row * 32 + 4 * fq)), sn = *(const f32x4*)(tab + (unsigned)(row * 32 + 16 + 4 * fq));
                        const f32x4 r0 = v0 * cs - v1 * sn, r1 = v1 * cs + v0 * sn; v0 = r0; v1 = r1;
                    }
                    v0 = v0 * sc; v1 = v1 * sc;
                    bf16_t* base = Q + (unsigned)(((b * MH + head) * SEQ + s) * DQK + (c0 - head * 96) + 4 * fq);
                    u32x2 o0; o0.x = pk2(v0.x, v0.y); o0.y = pk2(v0.z, v0.w); *(u32x2*)(base) = o0;
                    u32x2 o1; o1.x = pk2(v1.x, v1.y); o1.y = pk2(v1.z, v1.w); *(u32x2*)(base + 16) = o1; }
                __builtin_amdgcn_sched_barrier(0); }
    }
};
struct EpiKV {
    static constexpr bool PERM = false;
    bf16_t* Kp; bf16_t* VT;
    __device__ __forceinline__ void operator()(const f32x4 (&acc)[2][2][4][2], const Unit& u, int wr, int wc, int fr, int fq) const {
#pragma unroll
        for (int ai = 0; ai < 2; ++ai)
#pragma unroll
            for (int m = 0; m < 4; ++m) { const int row = u.pm * 256 + ai * 128 + wr * 64 + m * 16 + fr; const int b = row / SEQ, s = row % SEQ;
#pragma unroll
                for (int bj = 0; bj < 2; ++bj) { const int c0 = u.pn * 256 + bj * 128 + wc * 32; const int head = c0 >> 7; const int w0 = c0 & 127;
#pragma unroll
                    for (int n = 0; n < 2; ++n) { const f32x4 v = acc[ai][bj][m][n]; const int within = w0 + 16 * n + 4 * fq;
                        if (within < 64) { u32x2 o; o.x = pk2(v.x, v.y); o.y = pk2(v.z, v.w); *(u32x2*)(Kp + ((size_t)(b * MH + head) * SEQ + s) * DQK + within) = o; }
                        else { bf16_t* vb = VT + ((size_t)(b * MH + head) * 64 + (within - 64)) * SEQ + perm16v(s);
                            vb[0] = (bf16_t)f2bf(v.x); vb[SEQ] = (bf16_t)f2bf(v.y); vb[2 * SEQ] = (bf16_t)f2bf(v.z); vb[3 * SEQ] = (bf16_t)f2bf(v.w); } } } }
    }
};
struct EpiX1 {
    static constexpr bool PERM = false;
    const float* x; float* X1;
    __device__ __forceinline__ void operator()(const f32x4 (&acc)[2][2][4][2], const Unit& u, int wr, int wc, int fr, int fq) const {
#pragma unroll
        for (int ai = 0; ai < 2; ++ai)
#pragma unroll
            for (int m = 0; m < 4; ++m) { const int row = u.pm * 256 + ai * 128 + wr * 64 + m * 16 + fr;
#pragma unroll
                for (int bj = 0; bj < 2; ++bj)
#pragma unroll
                    for (int n = 0; n < 2; ++n) { const size_t o = (size_t)row * D + u.pn * 256 + bj * 128 + wc * 32 + 16 * n + 4 * fq;
                        *(f32x4*)(X1 + o) = *(const f32x4*)(x + o) + acc[ai][bj][m][n]; } }
    }
};
struct EpiAct {
    static constexpr bool PERM = true;
    unsigned char* ACT; const float* b1;
    __device__ __forceinline__ void operator()(const f32x4 (&acc)[2][2][4][2], const Unit& u, int wr, int wc, int fr, int fq) const {
        const float* bb = b1 + (size_t)u.e * 2048;
#pragma unroll
        for (int bj = 0; bj < 2; ++bj) { const int col = u.pn * 256 + bj * 128 + wc * 32 + 8 * fq;
            const f32x4 bv0 = *(const f32x4*)(bb + col), bv1 = *(const f32x4*)(bb + col + 4);
#pragma unroll
            for (int ai = 0; ai < 2; ++ai)
#pragma unroll
                for (int m = 0; m < 4; ++m) { const int row = u.pm * 256 + ai * 128 + wr * 64 + m * 16 + fr;
                    const f32x4 v0 = acc[ai][bj][m][0] * 0.03125f + bv0, v1 = acc[ai][bj][m][1] * 0.03125f + bv1;
                    float g[4] = {v0.x, v0.z, v1.x, v1.z}, l[4] = {v0.y, v0.w, v1.y, v1.w}, a[4];
#pragma unroll
                    for (int i = 0; i < 4; ++i) { const float xg = fminf(g[i], 7.f), xl = fminf(fmaxf(l[i], -7.f), 7.f); a[i] = xg * sigmoidf_(1.702f * xg) * (xl + 1.f); }
                    *(unsigned*)(ACT + (unsigned)(row * DFF + (col >> 1))) = pk4_fp8(a[0], a[1], a[2], a[3]);
                    __builtin_amdgcn_sched_barrier(0); } }
    }
};
struct EpiY {
    static constexpr bool PERM = true;
    bf16_t* Y; const float* b2;
    __device__ __forceinline__ void operator()(const f32x4 (&acc)[2][2][4][2], const Unit& u, int wr, int wc, int fr, int fq) const {
        const float* bb = b2 + (size_t)u.e * 1024;
#pragma unroll
        for (int bj = 0; bj < 2; ++bj) { const int col = u.pn * 256 + bj * 128 + wc * 32 + 8 * fq;
            const f32x4 bv0 = *(const f32x4*)(bb + col), bv1 = *(const f32x4*)(bb + col + 4);
#pragma unroll
            for (int ai = 0; ai < 2; ++ai)
#pragma unroll
                for (int m = 0; m < 4; ++m) { const int row = u.pm * 256 + ai * 128 + wr * 64 + m * 16 + fr;
                    const f32x4 v0 = acc[ai][bj][m][0] * 0.03125f + bv0, v1 = acc[ai][bj][m][1] * 0.03125f + bv1;
                    u32x4 o; o.x = pk2(v0.x, v0.y); o.y = pk2(v0.z, v0.w); o.z = pk2(v1.x, v1.y); o.w = pk2(v1.z, v1.w);
                    *(u32x4*)(Y + (size_t)row * D + col) = o;
                    __builtin_amdgcn_sched_barrier(0); } }
    }
};

struct MoeOrder1 {
    static constexpr bool GATHER = true;
    const char* H2; const char* W1T; const int* list; const LAS int* tstart; const LAS int* cnt; const LAS int* xs; int G, c;
    __device__ __forceinline__ bool next(int i, Unit& u) const {
        const int x = c & 7, j = i * (G >> 3) + (c >> 3); const int t = j >> 3;
        const int x1 = __builtin_amdgcn_readfirstlane(xs[1]), x2 = __builtin_amdgcn_readfirstlane(xs[2]), x3 = __builtin_amdgcn_readfirstlane(xs[3]), x4 = __builtin_amdgcn_readfirstlane(xs[4]);
        if (t >= x4) return false;
        const int jj = (t >= x3) ? 3 : ((t >= x2) ? 2 : ((t >= x1) ? 1 : 0)); const int base = (jj == 3) ? x3 : ((jj == 2) ? x2 : ((jj == 1) ? x1 : 0));
        const int e = x + 8 * jj;
        u.pm = __builtin_amdgcn_readfirstlane(tstart[e]) + (t - base); u.pn = j & 7; u.e = e;
        u.A = H2; u.B = W1T + ((size_t)e * 2048 + (size_t)u.pn * 256) * 1024; return true;
    }
    __device__ __forceinline__ int row_src(const Unit& u, int r) const {
        const int rank = (u.pm - tstart[u.e]) * 256 + r; return rank < cnt[u.e] ? list[u.e * T + rank] : 0;
    }
};
struct MoeOrder2 {
    static constexpr bool GATHER = false;
    const char* ACT; const char* W2T; const LAS int* tstart; const LAS int* xs; int G, c;
    __device__ __forceinline__ bool next(int i, Unit& u) const {
        const int x = c & 7, j = i * (G >> 3) + (c >> 3); const int t = j >> 2;
        const int x1 = __builtin_amdgcn_readfirstlane(xs[1]), x2 = __builtin_amdgcn_readfirstlane(xs[2]), x3 = __builtin_amdgcn_readfirstlane(xs[3]), x4 = __builtin_amdgcn_readfirstlane(xs[4]);
        if (t >= x4) return false;
        const int jj = (t >= x3) ? 3 : ((t >= x2) ? 2 : ((t >= x1) ? 1 : 0)); const int base = (jj == 3) ? x3 : ((jj == 2) ? x2 : ((jj == 1) ? x1 : 0));
        const int e = x + 8 * jj;
        u.pm = __builtin_amdgcn_readfirstlane(tstart[e]) + (t - base); u.pn = j & 3; u.e = e;
        u.A = ACT + (size_t)u.pm * 256 * 1024; u.B = W2T + ((size_t)e * 1024 + (size_t)u.pn * 256) * 1024; return true;
    }
    __device__ __forceinline__ int row_src(const Unit&, int) const { return 0; }
};

__device__ __forceinline__ void transpose_tile(const float* W, int K, int N, bf16_t* WT, int kb, int nb, unsigned char* smem, int tid) {
    float* tile = (float*)smem;
    const int k0 = 64 * kb, n0 = 256 * nb, n4 = tid & 63, kr = tid >> 6;
    f32x4 v[8];
#pragma unroll
    for (int i = 0; i < 8; ++i) { const int k = kr + 8 * i; v[i] = (n0 + 4 * n4 < N) ? *(const f32x4*)(W + (size_t)(k0 + k) * N + n0 + 4 * n4) : (f32x4){0.f, 0.f, 0.f, 0.f}; }
    __syncthreads();
#pragma unroll
    for (int i = 0; i < 8; ++i) { const int k = kr + 8 * i; *(f32x4*)(tile + k * 260 + ((4 * n4) ^ (8 * (k >> 3)))) = v[i]; }
    __syncthreads();
#pragma unroll
    for (int j = 0; j < 4; ++j) { const int c = tid + 512 * j, n = c >> 3, kc = c & 7; const float* src = tile + (8 * kc) * 260 + (n ^ (8 * kc));
        u32x4 o; o.x = pk2(src[0], src[260]); o.y = pk2(src[2 * 260], src[3 * 260]); o.z = pk2(src[4 * 260], src[5 * 260]); o.w = pk2(src[6 * 260], src[7 * 260]);
        *(u32x4*)(WT + (size_t)(n0 + n) * K + k0 + 8 * kc) = o; }
}
__device__ __forceinline__ void transpose_tile_fp8(const float* W, int K, int N, unsigned char* WT, int kb, int nb, float scale, unsigned char* smem, int tid) {
    float* tile = (float*)smem;
    const int k0 = 64 * kb, n0 = 256 * nb, n4 = tid & 63, kr = tid >> 6;
    f32x4 v[8];
#pragma unroll
    for (int i = 0; i < 8; ++i) { const int k = kr + 8 * i; v[i] = *(const f32x4*)(W + (size_t)(k0 + k) * N + n0 + 4 * n4) * scale; }
    __syncthreads();
#pragma unroll
    for (int i = 0; i < 8; ++i) { const int k = kr + 8 * i; *(f32x4*)(tile + k * 260 + ((4 * n4) ^ (8 * (k >> 3)))) = v[i]; }
    __syncthreads();
#pragma unroll
    for (int j = 0; j < 2; ++j) { const int c = tid + 512 * j, n = c >> 2, kc = c & 3;
        const float* s0 = tile + (16 * kc) * 260 + (n ^ (8 * (2 * kc))); const float* s1 = tile + (16 * kc + 8) * 260 + (n ^ (8 * (2 * kc + 1)));
        u32x4 o; o.x = pk4_fp8(s0[0], s0[260], s0[2 * 260], s0[3 * 260]); o.y = pk4_fp8(s0[4 * 260], s0[5 * 260], s0[6 * 260], s0[7 * 260]);
        o.z = pk4_fp8(s1[0], s1[260], s1[2 * 260], s1[3 * 260]); o.w = pk4_fp8(s1[4 * 260], s1[5 * 260], s1[6 * 260], s1[7 * 260]);
        *(u32x4*)(WT + (size_t)(n0 + n) * K + k0 + 16 * kc) = o; }
}
constexpr int TT_W1 = 128, TT_W2 = 64, TT_TOTAL = NE * TT_W1 + NE * TT_W2;
struct TTile { const float* src; unsigned char* dst; int N; };
__device__ __forceinline__ TTile tt_decode(const Params& P, int it, int n4, int kr) {
    TTile t;
    if (it < NE * TT_W1) { const int e = it >> 7, r = it & 127, kb = r >> 3, nb = r & 7; t.N = 2048;
        t.src = P.w1 + (size_t)e * D * 2048 + (size_t)(64 * kb + kr) * 2048 + 256 * nb + 4 * n4; t.dst = P.ws + WS_W1 + (size_t)e * 2048 * D + (size_t)(256 * nb) * D + 64 * kb; }
    else { const int i2 = it - NE * TT_W1, e = i2 >> 6, r = i2 & 63, kb = r >> 2, nb = r & 3; t.N = 1024;
        t.src = P.w2 + (size_t)e * DFF * D + (size_t)(64 * kb + kr) * 1024 + 256 * nb + 4 * n4; t.dst = P.ws + WS_W2 + (size_t)e * D * DFF + (size_t)(256 * nb) * DFF + 64 * kb; }
    return t;
}
__device__ __forceinline__ void late_transposes(const Params& P, unsigned char* smem, unsigned* qh, volatile LAS unsigned* misc, int tid) {
    float* tile = (float*)smem;
    const int n4 = tid & 63, kr = tid >> 6;
    __syncthreads();
    if (tid == 0) misc[8] = atomicAdd(qh, 1u);
    __syncthreads();
    int cur = (int)misc[8];
    if (cur >= TT_TOTAL) return;
    f32x4 v[8]; TTile tc = tt_decode(P, cur, n4, kr);
#pragma unroll
    for (int i = 0; i < 8; ++i) v[i] = *(const f32x4*)(tc.src + (size_t)(8 * i) * tc.N);
    for (;;) {
        if (tid == 0) misc[8] = atomicAdd(qh, 1u);
        __syncthreads();
        const int nxt = (int)misc[8];
#pragma unroll
        for (int i = 0; i < 8; ++i) { const int k = kr + 8 * i; *(f32x4*)(tile + k * 260 + ((4 * n4) ^ (8 * (k >> 3)))) = v[i] * 32.f; }
        TTile tn = tc;
        if (nxt < TT_TOTAL) { tn = tt_decode(P, nxt, n4, kr);
#pragma unroll
            for (int i = 0; i < 8; ++i) v[i] = *(const f32x4*)(tn.src + (size_t)(8 * i) * tn.N); }
        __syncthreads();
#pragma unroll
        for (int j = 0; j < 2; ++j) { const int c = tid + 512 * j, n = c >> 2, kc = c & 3;
            const float* s0 = tile + (16 * kc) * 260 + (n ^ (8 * (2 * kc))); const float* s1 = tile + (16 * kc + 8) * 260 + (n ^ (8 * (2 * kc + 1)));
            u32x4 o; o.x = pk4_fp8(s0[0], s0[260], s0[2 * 260], s0[3 * 260]); o.y = pk4_fp8(s0[4 * 260], s0[5 * 260], s0[6 * 260], s0[7 * 260]);
            o.z = pk4_fp8(s1[0], s1[260], s1[2 * 260], s1[3 * 260]); o.w = pk4_fp8(s1[4 * 260], s1[5 * 260], s1[6 * 260], s1[7 * 260]);
            *(u32x4*)(tc.dst + (size_t)n * 1024 + 16 * kc) = o; }
        if (nxt >= TT_TOTAL) break;
        cur = nxt; tc = tn;
    }
}

__device__ __forceinline__ void phase0(const Params& P, unsigned char* smem) {
    unsigned char* ws = P.ws;
    const int tid_ = opaque_tid(), lane = tid_ & 63, wave = tid_ >> 6, gw = blockIdx.x * NWAVES + wave, ngw = gridDim.x * NWAVES;
    float* slab = (float*)(smem + 73728);
    for (int i = tid_; i < 1024 * 8; i += NTHREADS) { const int k = i >> 3, c = i & 7, pos = (k & 3) * 256 + (k >> 2); slab[(c >> 2) * 4096 + pos * 4 + (c & 3)] = P.w_in[(size_t)k * DIN + 2048 + c]; }
    __syncthreads();
    bf16_t* H = (bf16_t*)(ws + WS_H); float* AB = (float*)(ws + WS_AB);
    f32x4 vnx[4];
    if (gw < T) {
#pragma unroll
        for (int j = 0; j < 4; ++j) vnx[j] = *((const f32x4*)(P.x + (size_t)gw * D) + lane + 64 * j); }
    for (int row = gw; row < T; row += ngw) {
        f32x4 v[4]; float ss = 0.f;
#pragma unroll
        for (int j = 0; j < 4; ++j) { v[j] = vnx[j]; ss += v[j].x * v[j].x + v[j].y * v[j].y + v[j].z * v[j].z + v[j].w * v[j].w; }
        if (row + ngw < T) {
#pragma unroll
            for (int j = 0; j < 4; ++j) vnx[j] = *((const f32x4*)(P.x + (size_t)(row + ngw) * D) + lane + 64 * j); }
        const float rstd = rsqrtf(wave_sum(ss) * (1.f / D) + EPS);
        float acc[8];
#pragma unroll
        for (int c = 0; c < 8; ++c) acc[c] = 0.f;
#pragma unroll
        for (int j = 0; j < 4; ++j) {
            const f32x4 w = *((const f32x4*)P.norm_mix_w + lane + 64 * j);
            v[j] = v[j] * rstd * w;
            u32x2 o; o.x = pk2(v[j].x, v[j].y); o.y = pk2(v[j].z, v[j].w);
            *((u32x2*)(H + (size_t)row * D) + lane + 64 * j) = o;
#pragma unroll
            for (int i = 0; i < 4; ++i) { const float* sw = slab + (size_t)(i * 256 + lane + 64 * j) * 4; const f32x4 w0 = *(const f32x4*)sw, w1 = *(const f32x4*)(sw + 4096); const float hv = v[j][i];
                acc[0] += hv * w0.x; acc[1] += hv * w0.y; acc[2] += hv * w0.z; acc[3] += hv * w0.w; acc[4] += hv * w1.x; acc[5] += hv * w1.y; acc[6] += hv * w1.z; acc[7] += hv * w1.w; }
        }
#pragma unroll
        for (int c = 0; c < 8; ++c) acc[c] = wave_sum(acc[c]);
        if (lane == 0) { *(f32x4*)(AB + (size_t)row * 8) = (f32x4){acc[0], acc[1], acc[2], acc[3]}; *(f32x4*)(AB + (size_t)row * 8 + 4) = (f32x4){acc[4], acc[5], acc[6], acc[7]}; }
    }
    __syncthreads();
    for (int it = blockIdx.x; it < 274; it += gridDim.x) {
        if (it >= 210) transpose_tile(P.w_out, D, D, (bf16_t*)(ws + WS_WOUT), (it - 210) >> 2, (it - 210) & 3, smem, tid_);
        else if (it < 176) transpose_tile(P.w_in, D, DIN, (bf16_t*)(ws + WS_WIN), it / 11, it % 11, smem, tid_);
        else if (it < 194) transpose_tile(P.w_uq, QL, 768, (bf16_t*)(ws + WS_WUQ), (it - 176) / 3, (it - 176) % 3, smem, tid_);
        else transpose_tile(P.w_ukv, KVL, 1024, (bf16_t*)(ws + WS_WUKV), (it - 194) >> 2, (it - 194) & 3, smem, tid_);
    }
}

__constant__ float c_inv_freq[16] = {1.0f, 0.5623413324356079f, 0.3162277638912201f, 0.17782793939113617f, 0.10000000149011612f, 0.05623413249850273f, 0.03162277489900589f,
    0.017782794311642647f, 0.009999999776482582f, 0.005623413249850273f, 0.003162277629598975f, 0.0017782794311642647f, 0.0010000000474974513f, 0.000562341301701963f,
    0.0003162277571391314f, 0.00017782794020604342f};
__device__ __forceinline__ void phase2a(const Params& P) {
    unsigned char* ws = P.ws;
    const int tid_ = opaque_tid(), lane = tid_ & 63, gw = blockIdx.x * NWAVES + (tid_ >> 6), ngw = gridDim.x * NWAVES;
    const bf16_t* PROJ = (const bf16_t*)(ws + WS_PROJ); bf16_t* CQN = (bf16_t*)(ws + WS_CQN); bf16_t* CKVN = (bf16_t*)(ws + WS_CKVN);
    bf16_t* Kp = (bf16_t*)(ws + WS_K); float* tab = (float*)(ws + WS_TAB);
    for (int row = gw; row < T; row += ngw) {
        const bf16_t* pr = PROJ + (size_t)row * DINP; const int b = row / SEQ, s = row % SEQ;
        {
            unsigned a[3]; float ss = 0.f;
#pragma unroll
            for (int j = 0; j < 3; ++j) { a[j] = *(const unsigned*)(pr + C_CQ + 2 * (lane + 64 * j)); const float lo = bflo(a[j]), hi = bfhi(a[j]); ss += lo * lo + hi * hi; }
            const float rstd = rsqrtf(wave_sum(ss) * (1.f / QL) + EPS);
#pragma unroll
            for (int j = 0; j < 3; ++j) { const int idx = 2 * (lane + 64 * j); *(unsigned*)(CQN + (size_t)row * QL + idx) = pk2(bflo(a[j]) * rstd * P.q_norm_w[idx], bfhi(a[j]) * rstd * P.q_norm_w[idx + 1]); }
        }
        {
            unsigned a[2]; float ss = 0.f;
#pragma unroll
            for (int j = 0; j < 2; ++j) { a[j] = *(const unsigned*)(pr + C_CKV + 2 * (lane + 64 * j)); const float lo = bflo(a[j]), hi = bfhi(a[j]); ss += lo * lo + hi * hi; }
            const float rstd = rsqrtf(wave_sum(ss) * (1.f / KVL) + EPS);
#pragma unroll
            for (int j = 0; j < 2; ++j) { const int idx = 2 * (lane + 64 * j); *(unsigned*)(CKVN + (size_t)row * KVL + idx) = pk2(bflo(a[j]) * rstd * P.kv_norm_w[idx], bfhi(a[j]) * rstd * P.kv_norm_w[idx + 1]); }
        }
        if (lane < 16) {
            const float x1 = bf1(pr[C_KR + lane]), x2 = bf1(pr[C_KR + 16 + lane]);
            const float ang = (float)P.pos[row] * c_inv_freq[lane];
            double tt = (double)ang * 0.15915494309189535; tt -= floor(tt);
            if (tt > 0.5) tt -= 1.0;
            const float ar = (float)(tt * 6.283185307179586);
            const float cs = __cosf(ar), sn = __sinf(ar);
            tab[(size_t)row * 32 + lane] = cs; tab[(size_t)row * 32 + 16 + lane] = sn;
            const bf16_t o1 = (bf16_t)f2bf(x1 * cs - x2 * sn), o2 = (bf16_t)f2bf(x2 * cs + x1 * sn);
#pragma unroll
            for (int h = 0; h < MH; ++h) { bf16_t* kp = Kp + ((size_t)(b * MH + h) * SEQ + s) * DQK + 64; kp[lane] = o1; kp[16 + lane] = o2; }
        }
    }
}

__device__ __forceinline__ float softplusf_(float x) { return fmaxf(x, 0.f) + log1pf(__expf(-fabsf(x))); }
__device__ __forceinline__ void prep_conv_load(const Params& P, int item, int tid, u32x4 (&raw)[11]) {
    const int n = item % NCH, hh = (item / NCH) % GH, b = item / (NCH * GH);
    const int rg = tid / 48, c8 = tid % 48, which = c8 >> 4, cc = (c8 & 15) * 8, gc = which * 512 + hh * 128 + cc;
    const bf16_t* PROJ = (const bf16_t*)(P.ws + WS_PROJ);
#pragma unroll
    for (int i = 0; i < 11; ++i) { const int t = 64 * n + 8 * rg - 3 + i;
        raw[i] = (t >= 0) ? *(const u32x4*)(PROJ + (size_t)(b * SEQ + t) * DINP + gc) : (u32x4){0u, 0u, 0u, 0u}; }
}
__device__ __forceinline__ void gdn_prep_item(const Params& P, unsigned char* smem, int item, int next_item, u32x4 (&raw)[11]) {
    unsigned char* ws = P.ws;
    const int tid = opaque_tid(), wave = tid >> 6, lane = tid & 63;
    const int n = item % NCH, hh = (item / NCH) % GH, b = item / (NCH * GH);
    const bf16_t* PROJ = (const bf16_t*)(ws + WS_PROJ); const float* AB = (const float*)(ws + WS_AB);
    unsigned char* gp = ws + WS_GP + (size_t)item * GP_ITEM;
    float* Ug = (float*)(gp + GP_U); bf16_t* Wg = (bf16_t*)(gp + GP_W); bf16_t* QDg = (bf16_t*)(gp + GP_QD); bf16_t* KDTg = (bf16_t*)(gp + GP_KDT); bf16_t* QKg = (bf16_t*)(gp + GP_QK);
    float* qs = (float*)smem; float* ks = qs + 64 * 132; float* vs = ks + 64 * 132; float* Am = vs + 64 * 132;
    float* sbeta = Am + 64 * 68; float* sG = sbeta + 64; float* seG = sG + 64; float* sekd = seG + 64;
    __syncthreads();
    if (tid < 384) {
        const int rg = tid / 48, c8 = tid % 48, which = c8 >> 4, cc = (c8 & 15) * 8, gc = which * 512 + hh * 128 + cc;
        float wv[4][8];
#pragma unroll
        for (int j = 0; j < 4; ++j) { const f32x4 a = *(const f32x4*)(P.conv_w + j * 1536 + gc), c = *(const f32x4*)(P.conv_w + j * 1536 + gc + 4);
            wv[j][0] = a.x; wv[j][1] = a.y; wv[j][2] = a.z; wv[j][3] = a.w; wv[j][4] = c.x; wv[j][5] = c.y; wv[j][6] = c.z; wv[j][7] = c.w; }
        float* dst = qs + which * (64 * 132) + (8 * rg) * 132 + cc;
#pragma unroll
        for (int rr = 0; rr < 8; ++rr) {
            float y[8];
#pragma unroll
            for (int d = 0; d < 4; ++d) { float ya = 0.f, yb = 0.f;
#pragma unroll
                for (int j = 0; j < 4; ++j) { const unsigned u = raw[rr + j][d]; ya += wv[j][2 * d] * bflo(u); yb += wv[j][2 * d + 1] * bfhi(u); }
                y[2 * d] = ya * sigmoidf_(ya); y[2 * d + 1] = yb * sigmoidf_(yb); }
            *(f32x4*)(dst + rr * 132) = (f32x4){y[0], y[1], y[2], y[3]}; *(f32x4*)(dst + rr * 132 + 4) = (f32x4){y[4], y[5], y[6], y[7]};
        }
        if (next_item >= 0) prep_conv_load(P, next_item, tid, raw);
    } else if (tid >= 448) {
        const int r = lane; const size_t tok = (size_t)b * SEQ + 64 * n + r;
        const float a = AB[tok * 8 + hh], bb = AB[tok * 8 + 4 + hh];
        const float g = -__expf(P.a_log[hh]) * softplusf_(a + P.dt_bias[hh]);
        float G = g;
#pragma unroll
        for (int o = 1; o < 64; o <<= 1) { const float up = __shfl_up(G, o); if (lane >= o) G += up; }
        const float Gl = __shfl(G, 63);
        sbeta[r] = sigmoidf_(bb); sG[r] = G; seG[r] = __expf(G); sekd[r] = __expf(Gl - G);
        if (lane == 0) ((float*)(ws + WS_GT))[item] = __expf(Gl);
    }
    __syncthreads();
    for (int p = wave; p < 128; p += NWAVES) {
        const int which = p >> 6, r = p & 63; float* row = qs + which * (64 * 132) + r * 132;
        const float a0 = row[2 * lane], a1 = row[2 * lane + 1];
        const float ss = wave_sum(a0 * a0 + a1 * a1);
        const float sc = rsqrtf(ss + EPS) * (which == 0 ? 0.08838834764831845f : 1.f);
        row[2 * lane] = a0 * sc; row[2 * lane + 1] = a1 * sc;
    }
    for (int idx = tid; idx < 6 * 256; idx += NTHREADS) {
        const int u = idx >> 8, w = idx & 255; const int I = (u < 3) ? 0 : (u < 5 ? 1 : 2), J = (u < 3) ? u + 1 : (u < 5 ? u - 1 : 3);
        QKg[(16 * I + (w >> 4)) * 64 + perm32k(16 * J + (w & 15))] = 0;
    }
    __syncthreads();
    for (int job = wave; job < 20; job += NWAVES) {
        const int kind = job / 10, p = job % 10; const int I = (p < 1) ? 0 : (p < 3 ? 1 : (p < 6 ? 2 : 3)); const int J = p - (I * (I + 1)) / 2;
        const float* Ar = (kind ? qs : ks) + (16 * I + (lane & 15)) * 132 + (lane >> 4);
        const float* Br = ks + (16 * J + (lane & 15)) * 132 + (lane >> 4);
        f32x4 acc = {0.f, 0.f, 0.f, 0.f};
#pragma unroll 8
        for (int s = 0; s < 32; ++s) acc = __builtin_amdgcn_mfma_f32_16x16x4f32(Ar[4 * s], Br[4 * s], acc, 0, 0, 0);
        const int j = 16 * J + (lane & 15);
#pragma unroll
        for (int r = 0; r < 4; ++r) { const int i = 16 * I + 4 * (lane >> 4) + r;
            const float dec = (i >= j) ? __expf(sG[i] - sG[j]) : 0.f;
            if (kind == 0) Am[i * 68 + j] = (i > j) ? sbeta[i] * acc[r] * dec : 0.f;
            else QKg[i * 64 + perm32k(j)] = (bf16_t)f2bf((i >= j) ? acc[r] * dec : 0.f); }
    }
    __syncthreads();
    if (wave < 4) {
        if (lane < 16) {
            const int i0_ = 16 * wave, c = lane; float Tc[16];
            const LAS float* AmL = (const LAS float*)Am + i0_ * 68 + i0_; asm volatile("" : "+v"(AmL));
#pragma unroll
            for (int i = 0; i < 16; ++i) { float a = (i == c) ? 1.f : 0.f;
#pragma unroll
                for (int j = 0; j < i; ++j) a -= AmL[i * 68 + j] * Tc[j];
                Tc[i] = a; asm volatile("" : "+v"(Tc[i])); }
#pragma unroll
            for (int i = 0; i < 16; ++i) Am[(i0_ + i) * 68 + i0_ + c] = Tc[i];
        }
    } else {
        const int t2 = tid - 256;
        for (int idx = t2; idx < 64 * 64; idx += 256) { const int i = idx >> 6, d = (idx & 63) * 2; *(unsigned*)(QDg + i * 128 + perm32k(d)) = pk2(qs[i * 132 + d] * seG[i], qs[i * 132 + d + 1] * seG[i]); }
        for (int idx = t2; idx < 128 * 32; idx += 256) { const int d = idx >> 5, cc = (idx & 31) * 2; *(unsigned*)(KDTg + d * 64 + perm32k(cc)) = pk2(ks[cc * 132 + d] * sekd[cc], ks[(cc + 1) * 132 + d] * sekd[cc + 1]); }
    }
    __syncthreads();
    for (int idx = tid; idx < 64 * 32; idx += NTHREADS) { const int i = idx >> 5, c4 = (idx & 31) * 4; const float bi = sbeta[i], bw = bi * seG[i];
        f32x4* pv = (f32x4*)(vs + i * 132 + c4); *pv = *pv * bi; f32x4* pk = (f32x4*)(ks + i * 132 + c4); *pk = *pk * bw; }
    __syncthreads();
    {
        const int rl = lane & 15, kk = lane >> 4;
        float* arr0 = (wave < 4 ? vs : ks) + ((2 * wave) & 7) * 16; float* arr1 = arr0 + 16;
#pragma unroll
        for (int i = 0; i < 4; ++i) {
            f32x4 acc0, acc1;
#pragma unroll
            for (int r = 0; r < 4; ++r) { acc0[r] = arr0[(16 * i + 4 * kk + r) * 132 + rl]; acc1[r] = arr1[(16 * i + 4 * kk + r) * 132 + rl]; }
#pragma unroll
            for (int j = 0; j < i; ++j)
#pragma unroll
                for (int sx = 0; sx < 4; ++sx) { const float a = -Am[(16 * i + rl) * 68 + 16 * j + 4 * sx + kk];
                    acc0 = __builtin_amdgcn_mfma_f32_16x16x4f32(a, arr0[(16 * j + 4 * sx + kk) * 132 + rl], acc0, 0, 0, 0);
                    acc1 = __builtin_amdgcn_mfma_f32_16x16x4f32(a, arr1[(16 * j + 4 * sx + kk) * 132 + rl], acc1, 0, 0, 0); }
#pragma unroll
            for (int r = 0; r < 4; ++r) { arr0[(16 * i + 4 * kk + r) * 132 + rl] = acc0[r]; arr1[(16 * i + 4 * kk + r) * 132 + rl] = acc1[r]; }
            asm volatile("s_waitcnt lgkmcnt(0)" ::: "memory");
            f32x4 o0 = {0.f, 0.f, 0.f, 0.f}, o1 = {0.f, 0.f, 0.f, 0.f};
#pragma unroll
            for (int sx = 0; sx < 4; ++sx) { const float a = Am[(16 * i + rl) * 68 + 16 * i + 4 * sx + kk];
                o0 = __builtin_amdgcn_mfma_f32_16x16x4f32(a, arr0[(16 * i + 4 * sx + kk) * 132 + rl], o0, 0, 0, 0);
                o1 = __builtin_amdgcn_mfma_f32_16x16x4f32(a, arr1[(16 * i + 4 * sx + kk) * 132 + rl], o1, 0, 0, 0); }
#pragma unroll
            for (int r = 0; r < 4; ++r) { arr0[(16 * i + 4 * kk + r) * 132 + rl] = o0[r]; arr1[(16 * i + 4 * kk + r) * 132 + rl] = o1[r]; }
            asm volatile("s_waitcnt lgkmcnt(0)" ::: "memory");
        }
    }
    __syncthreads();
    for (int idx = tid; idx < 2048; idx += NTHREADS) { const int e = idx & 15, g = (idx >> 4) & 3, m = (idx >> 6) & 3, w = idx >> 8; const float* src = vs + (16 * m + 4 * g) * 132 + 16 * w + e;
        u32x2 o; o.x = pk2(src[0], src[132]); o.y = pk2(src[2 * 132], src[3 * 132]); ((u32x2*)Ug)[idx] = o; }
    for (int idx = tid; idx < 64 * 64; idx += NTHREADS) { const int i = idx >> 6, d = (idx & 63) * 2; *(unsigned*)(Wg + i * 128 + perm32k(d)) = pk2(-ks[i * 132 + d], -ks[i * 132 + d + 1]); }
}

__device__ __forceinline__ void gdn_scan(const Params& P, unsigned char* smem, int bh) {
    unsigned char* ws = P.ws;
    const int tid = opaque_tid(), wave = tid >> 6, lane = tid & 63, e = lane & 15, g = lane >> 4;
    const float* GT = (const float*)(ws + WS_GT);
    constexpr int BUF = 36864, OW = 0, OKD = 18432;
    f32x4 S[8];
#pragma unroll
    for (int t = 0; t < 8; ++t) S[t] = (f32x4){0.f, 0.f, 0.f, 0.f};
    u32x4 st[2][4]; u32x2 un[2][4]; float gtn[2];
#define SCAN_GLOAD(p, n) do { const unsigned char* gp_ = ws + WS_GP + (size_t)(bh * NCH + (n)) * GP_ITEM; \
        _Pragma("unroll") for (int k = 0; k < 2; ++k) st[p][k] = *(const u32x4*)(gp_ + GP_W + (size_t)(tid + 512 * k) * 16); \
        _Pragma("unroll") for (int k = 0; k < 2; ++k) st[p][2 + k] = *(const u32x4*)(gp_ + GP_KDT + (size_t)(tid + 512 * k) * 16); \
        const u32x2* ug_ = (const u32x2*)(gp_ + GP_U) + wave * 256 + lane; \
        _Pragma("unroll") for (int m = 0; m < 4; ++m) un[p][m] = ug_[m * 64]; \
        gtn[p] = GT[bh * NCH + (n)]; } while (0)
#define SCAN_LWRITE(p, buf) do { unsigned char* L_ = smem + (buf) * BUF; \
        _Pragma("unroll") for (int k = 0; k < 2; ++k) { const int c = tid + 512 * k; *(u32x4*)(L_ + OW + (c >> 4) * 288 + (c & 15) * 16) = st[p][k]; } \
        _Pragma("unroll") for (int k = 0; k < 2; ++k) { const int c = tid + 512 * k; *(u32x4*)(L_ + OKD + (c >> 3) * 144 + (c & 7) * 16) = st[p][2 + k]; } } while (0)
    __syncthreads();
    SCAN_GLOAD(0, 0); SCAN_LWRITE(0, 0); SCAN_GLOAD(1, 1);
    __syncthreads();
    for (int n2 = 0; n2 < NCH; n2 += 2) {
#pragma unroll
      for (int p = 0; p < 2; ++p) {
        const int n = n2 + p;
        f32x4 av[4];
#pragma unroll
        for (int m = 0; m < 4; ++m) av[m] = (f32x4){bflo(un[p][m].x), bfhi(un[p][m].x), bflo(un[p][m].y), bfhi(un[p][m].y)};
        const float gt = gtn[p];
        if (n + 2 < NCH) SCAN_GLOAD(p, n + 2);
        const unsigned char* L = smem + p * BUF;
        bf16x8 Sb[4];
#pragma unroll
        for (int s = 0; s < 4; ++s) Sb[s] = pack8(S[2 * s], S[2 * s + 1]);
        {
            bf16x8* sb = (bf16x8*)(ws + WS_SB) + ((size_t)(bh * NCH + n) * 8 + wave) * 256 + lane;
#pragma unroll
            for (int s = 0; s < 4; ++s) sb[s * 64] = Sb[s];
        }
#pragma unroll
        for (int s = 0; s < 4; ++s)
#pragma unroll
            for (int m = 0; m < 4; ++m) {
                const bf16x8 wf = *(const bf16x8*)(L + OW + (16 * m + e) * 288 + (32 * s + 8 * g) * 2);
                av[m] = __builtin_amdgcn_mfma_f32_16x16x32_bf16(wf, Sb[s], av[m], 0, 0, 0);
            }
        bf16x8 Vb[2];
#pragma unroll
        for (int s = 0; s < 2; ++s) Vb[s] = pack8(av[2 * s], av[2 * s + 1]);
#pragma unroll
        for (int t = 0; t < 8; ++t) { S[t] = S[t] * gt;
#pragma unroll
            for (int s = 0; s < 2; ++s) {
                const bf16x8 df = *(const bf16x8*)(L + OKD + (16 * t + e) * 144 + (32 * s + 8 * g) * 2);
                S[t] = __builtin_amdgcn_mfma_f32_16x16x32_bf16(df, Vb[s], S[t], 0, 0, 0);
            } }
        if (n + 1 < NCH) SCAN_LWRITE(p ^ 1, p ^ 1);
        __syncthreads();
      }
    }
#undef SCAN_GLOAD
#undef SCAN_LWRITE
}

struct GdnOutRegs { u32x4 st[5]; bf16x8 Sb[4]; u32x2 un[4]; };
__device__ __forceinline__ void gdn_out_load(const Params& P, int item, int tid, GdnOutRegs& R) {
    unsigned char* ws = P.ws; const int wave = tid >> 6, lane = tid & 63;
    const unsigned char* gp = ws + WS_GP + (size_t)item * GP_ITEM;
#pragma unroll
    for (int k = 0; k < 2; ++k) R.st[k] = *(const u32x4*)(gp + GP_W + (size_t)(tid + 512 * k) * 16);
#pragma unroll
    for (int k = 0; k < 2; ++k) R.st[2 + k] = *(const u32x4*)(gp + GP_QD + (size_t)(tid + 512 * k) * 16);
    R.st[4] = *(const u32x4*)(gp + GP_QK + (size_t)tid * 16);
    const bf16x8* sb = (const bf16x8*)(ws + WS_SB) + ((size_t)item * 8 + wave) * 256 + lane;
#pragma unroll
    for (int s = 0; s < 4; ++s) R.Sb[s] = sb[s * 64];
    const u32x2* ug = (const u32x2*)(gp + GP_U) + wave * 256 + lane;
#pragma unroll
    for (int m = 0; m < 4; ++m) R.un[m] = ug[m * 64];
}
__device__ __forceinline__ void gdn_out_item(const Params& P, unsigned char* smem, int item, int next_item, GdnOutRegs& R) {
    unsigned char* ws = P.ws;
    const int tid = opaque_tid(), wave = tid >> 6, lane = tid & 63, e = lane & 15, g = lane >> 4;
    const int n = item % NCH, hh = (item / NCH) % GH, b = item / (NCH * GH);
    constexpr int OW = 0, OQD = 18432, OQK = 36864, OSS = 46080, ORS = OSS + 2048, OT = 49152;
    float* ssq = (float*)(smem + OSS); float* rs = (float*)(smem + ORS);
    u32x4 st[5]; bf16x8 Sb[4]; u32x2 un[4];
#pragma unroll
    for (int k = 0; k < 5; ++k) st[k] = R.st[k];
#pragma unroll
    for (int k = 0; k < 4; ++k) { Sb[k] = R.Sb[k]; un[k] = R.un[k]; }
    __syncthreads();
#pragma unroll
    for (int k = 0; k < 2; ++k) { const int c = tid + 512 * k; *(u32x4*)(smem + OW + (c >> 4) * 288 + (c & 15) * 16) = st[k]; }
#pragma unroll
    for (int k = 0; k < 2; ++k) { const int c = tid + 512 * k; *(u32x4*)(smem + OQD + (c >> 4) * 288 + (c & 15) * 16) = st[2 + k]; }
    { const int c = tid; *(u32x4*)(smem + OQK + (c >> 3) * 144 + (c & 7) * 16) = st[4]; }
    __syncthreads();
    if (next_item >= 0) gdn_out_load(P, next_item, tid, R);
    f32x4 av[4], ao[4];
#pragma unroll
    for (int m = 0; m < 4; ++m) { av[m] = (f32x4){bflo(un[m].x), bfhi(un[m].x), bflo(un[m].y), bfhi(un[m].y)}; ao[m] = (f32x4){0.f, 0.f, 0.f, 0.f}; }
#pragma unroll
    for (int s = 0; s < 4; ++s)
#pragma unroll
        for (int m = 0; m < 4; ++m) {
            const bf16x8 wf = *(const bf16x8*)(smem + OW + (16 * m + e) * 288 + (32 * s + 8 * g) * 2);
            const bf16x8 qf = *(const bf16x8*)(smem + OQD + (16 * m + e) * 288 + (32 * s + 8 * g) * 2);
            av[m] = __builtin_amdgcn_mfma_f32_16x16x32_bf16(wf, Sb[s], av[m], 0, 0, 0);
            ao[m] = __builtin_amdgcn_mfma_f32_16x16x32_bf16(qf, Sb[s], ao[m], 0, 0, 0);
        }
    bf16x8 Vb[2];
#pragma unroll
    for (int s = 0; s < 2; ++s) Vb[s] = pack8(av[2 * s], av[2 * s + 1]);
#pragma unroll
    for (int m = 0; m < 4; ++m)
#pragma unroll
        for (int s = 0; s < 2; ++s) {
            const bf16x8 kf = *(const bf16x8*)(smem + OQK + (16 * m + e) * 144 + (32 * s + 8 * g) * 2);
            ao[m] = __builtin_amdgcn_mfma_f32_16x16x32_bf16(kf, Vb[s], ao[m], 0, 0, 0);
        }
#pragma unroll
    for (int m = 0; m < 4; ++m)
#pragma unroll
        for (int r = 0; r < 4; ++r) { float q = ao[m][r] * ao[m][r];
            q += __shfl_xor(q, 1); q += __shfl_xor(q, 2); q += __shfl_xor(q, 4); q += __shfl_xor(q, 8);
            if (e == 0) ssq[wave * 64 + 16 * m + 4 * g + r] = q;
            *(bf16_t*)(smem + OT + (16 * m + 4 * g + r) * 272 + (16 * wave + e) * 2) = (bf16_t)f2bf(ao[m][r]); }
    __syncthreads();
    if (tid < 64) { float q = 0.f;
#pragma unroll
        for (int w = 0; w < 8; ++w) q += ssq[w * 64 + tid];
        rs[tid] = rsqrtf(q * (1.f / 128.f) + EPS); }
    __syncthreads();
    {
        const int row = tid >> 3, seg = tid & 7; const size_t tok = (size_t)b * SEQ + 64 * n + row;
        const u32x4* tp = (const u32x4*)(smem + OT + row * 272 + seg * 32);
        const u32x4 o0 = tp[0], o1 = tp[1];
        const u32x4* zp = (const u32x4*)((const bf16_t*)(ws + WS_PROJ) + tok * DINP + C_Z + hh * 128 + seg * 16);
        const u32x4 z0 = zp[0], z1 = zp[1];
        const float r_ = rs[row]; const float* gwp = P.gdn_norm_w + seg * 16;
        unsigned ov[8]; const unsigned oo[8] = {o0.x, o0.y, o0.z, o0.w, o1.x, o1.y, o1.z, o1.w}, zz[8] = {z0.x, z0.y, z0.z, z0.w, z1.x, z1.y, z1.z, z1.w};
#pragma unroll
        for (int i = 0; i < 8; ++i) { const float za = bflo(zz[i]), zb = bfhi(zz[i]);
            ov[i] = pk2(bflo(oo[i]) * r_ * gwp[2 * i] * za * sigmoidf_(za), bfhi(oo[i]) * r_ * gwp[2 * i + 1] * zb * sigmoidf_(zb)); }
        u32x4* op = (u32x4*)((bf16_t*)(ws + WS_OCAT) + tok * D + hh * 128 + seg * 16);
        op[0] = (u32x4){ov[0], ov[1], ov[2], ov[3]}; op[1] = (u32x4){ov[4], ov[5], ov[6], ov[7]};
    }
}

__device__ __forceinline__ void attn_item(const Params& P, unsigned char* smem, int item) {
    unsigned char* ws = P.ws;
    const int tid = opaque_tid(), wave = tid >> 6, lane = tid & 63, ql = lane & 31, hf = lane >> 5;
    const int qt = 15 - (item >> 5), bh = item & 31;
    const bf16_t* Qg = (const bf16_t*)(ws + WS_Q) + (size_t)bh * SEQ * DQK;
    const unsigned char* Kg = (const unsigned char*)((const bf16_t*)(ws + WS_K) + (size_t)bh * SEQ * DQK);
    const bf16_t* VTg = (const bf16_t*)(ws + WS_VT) + (size_t)bh * 64 * SEQ;
    bf16_t* OB = (bf16_t*)(ws + WS_OB);
    const int q0 = qt * 256 + 32 * wave;
    const int nkt_w = (q0 >> 6) + 1, nkt_b = 2 * qt + 2;
    constexpr int KB_ = 26624, VB_ = 17408, OK0 = 0, OV0 = 2 * KB_;
    bf16x8 qf[6];
#pragma unroll
    for (int ks = 0; ks < 6; ++ks) qf[ks] = *(const bf16x8*)(Qg + (size_t)(q0 + ql) * DQK + 16 * ks + 8 * hf);
    f32x16 o0, o1;
#pragma unroll
    for (int i = 0; i < 16; ++i) { o0[i] = 0.f; o1[i] = 0.f; }
    float mrun = -1e30f, lsum = 0.f;
    u32x4 sk[3], sv[2];
    auto gload = [&](int kt) {
        const unsigned char* kp = Kg + (size_t)kt * 128 * DQK * 2;
#pragma unroll
        for (int k = 0; k < 3; ++k) sk[k] = *(const u32x4*)(kp + (size_t)(tid + 512 * k) * 16);
#pragma unroll
        for (int k = 0; k < 2; ++k) { const int c = tid + 512 * k; sv[k] = *(const u32x4*)(VTg + (size_t)(c >> 4) * SEQ + kt * 128 + (c & 15) * 8); }
    };
    auto lwrite = [&](int buf) {
#pragma unroll
        for (int k = 0; k < 3; ++k) { const int c = tid + 512 * k; *(u32x4*)(smem + OK0 + buf * KB_ + (c / 12) * 208 + (c % 12) * 16) = sk[k]; }
#pragma unroll
        for (int k = 0; k < 2; ++k) { const int c = tid + 512 * k; *(u32x4*)(smem + OV0 + buf * VB_ + (c >> 4) * 272 + (c & 15) * 16) = sv[k]; }
    };
    __syncthreads();
    gload(0); lwrite(0);
    __syncthreads();
    for (int kt = 0; kt < nkt_b; ++kt) {
        if (kt + 1 < nkt_b) gload(kt + 1);
#pragma unroll
        for (int u2 = 0; u2 < 2; ++u2) if (2 * kt + u2 < nkt_w) {
            const unsigned char* Kl = smem + OK0 + (kt & 1) * KB_ + u2 * (64 * 208); const unsigned char* Vl = smem + OV0 + (kt & 1) * VB_ + u2 * 128;
            f32x16 s0, s1;
#pragma unroll
            for (int i = 0; i < 16; ++i) { s0[i] = 0.f; s1[i] = 0.f; }
            bf16x8 kf[6][2], vf[2][2][2];
#pragma unroll
            for (int ks = 0; ks < 6; ++ks) { kf[ks][0] = *(const bf16x8*)(Kl + ql * 208 + (16 * ks + 8 * hf) * 2); kf[ks][1] = *(const bf16x8*)(Kl + (32 + ql) * 208 + (16 * ks + 8 * hf) * 2); }
            __builtin_amdgcn_sched_barrier(0);
#pragma unroll
            for (int ks = 0; ks < 6; ++ks) {
                s0 = __builtin_amdgcn_mfma_f32_32x32x16_bf16(kf[ks][0], qf[ks], s0, 0, 0, 0);
                s1 = __builtin_amdgcn_mfma_f32_32x32x16_bf16(kf[ks][1], qf[ks], s1, 0, 0, 0);
            }
#pragma unroll
            for (int u = 0; u < 2; ++u)
#pragma unroll
                for (int sp = 0; sp < 2; ++sp) { vf[u][sp][0] = *(const bf16x8*)(Vl + ql * 272 + (32 * u + 16 * sp + 8 * hf) * 2); vf[u][sp][1] = *(const bf16x8*)(Vl + (32 + ql) * 272 + (32 * u + 16 * sp + 8 * hf) * 2); }
            __builtin_amdgcn_sched_barrier(0);
            float mx = s0[0];
#pragma unroll
            for (int i = 1; i < 16; ++i) mx = fmaxf(mx, s0[i]);
#pragma unroll
            for (int i = 0; i < 16; ++i) mx = fmaxf(mx, s1[i]);
            mx = fmaxf(mx, __shfl_xor(mx, 32));
            const float mnew = fmaxf(mrun, mx), alpha = __builtin_amdgcn_exp2f(mrun - mnew);
            mrun = mnew;
            float ps = 0.f;
#pragma unroll
            for (int i = 0; i < 16; ++i) { s0[i] = __builtin_amdgcn_exp2f(s0[i] - mnew); s1[i] = __builtin_amdgcn_exp2f(s1[i] - mnew); ps += s0[i] + s1[i]; }
            lsum = lsum * alpha + ps;
#pragma unroll
            for (int i = 0; i < 16; ++i) { o0[i] *= alpha; o1[i] *= alpha; }
            bf16x8 pb[2][2];
#pragma unroll
            for (int sp = 0; sp < 2; ++sp) {
                pb[0][sp] = pack8((f32x4){s0[8 * sp], s0[8 * sp + 1], s0[8 * sp + 2], s0[8 * sp + 3]}, (f32x4){s0[8 * sp + 4], s0[8 * sp + 5], s0[8 * sp + 6], s0[8 * sp + 7]});
                pb[1][sp] = pack8((f32x4){s1[8 * sp], s1[8 * sp + 1], s1[8 * sp + 2], s1[8 * sp + 3]}, (f32x4){s1[8 * sp + 4], s1[8 * sp + 5], s1[8 * sp + 6], s1[8 * sp + 7]});
            }
#pragma unroll
            for (int u = 0; u < 2; ++u)
#pragma unroll
                for (int sp = 0; sp < 2; ++sp) {
                    o0 = __builtin_amdgcn_mfma_f32_32x32x16_bf16(vf[u][sp][0], pb[u][sp], o0, 0, 0, 0);
                    o1 = __builtin_amdgcn_mfma_f32_32x32x16_bf16(vf[u][sp][1], pb[u][sp], o1, 0, 0, 0);
                }
        }
        if (kt + 1 < nkt_b) lwrite((kt + 1) & 1);
        __syncthreads();
    }
    lsum += __shfl_xor(lsum, 32);
    const float inv = 1.f / lsum;
    const int b = bh >> 3, h = bh & 7;
    bf16_t* orow = OB + ((size_t)b * SEQ + q0 + ql) * 512 + h * 64;
#pragma unroll
    for (int r = 0; r < 16; ++r) { const int dv = (r & 3) + 8 * (r >> 2) + 4 * hf; orow[dv] = (bf16_t)f2bf(o0[r] * inv); orow[32 + dv] = (bf16_t)f2bf(o1[r] * inv); }
}

__device__ __forceinline__ void phase5(const Params& P) {
    unsigned char* ws = P.ws;
    const int tid_ = opaque_tid(), lane = tid_ & 63, gw = blockIdx.x * NWAVES + (tid_ >> 6), ngw = gridDim.x * NWAVES;
    const bf16_t* OB = (const bf16_t*)(ws + WS_OB); bf16_t* OCAT = (bf16_t*)(ws + WS_OCAT);
    for (int tq = gw; tq < T / 4; tq += ngw) {
        const int t0 = 4 * tq;
#pragma unroll
        for (int r = 0; r < 4; ++r) {
            const size_t row = (size_t)t0 + r;
            const u32x4 v = *((const u32x4*)(OB + row * 512) + lane);
            float f[8] = {bflo(v.x), bfhi(v.x), bflo(v.y), bfhi(v.y), bflo(v.z), bfhi(v.z), bflo(v.w), bfhi(v.w)};
            float ss = 0.f;
#pragma unroll
            for (int i = 0; i < 8; ++i) ss += f[i] * f[i];
            const float rstd = rsqrtf(wave_sum(ss) * (1.f / 512.f) + EPS);
            const float* wn = P.mla_out_norm_w + 8 * lane;
            u32x4 o; o.x = pk2(f[0] * rstd * wn[0], f[1] * rstd * wn[1]); o.y = pk2(f[2] * rstd * wn[2], f[3] * rstd * wn[3]); o.z = pk2(f[4] * rstd * wn[4], f[5] * rstd * wn[5]); o.w = pk2(f[6] * rstd * wn[6], f[7] * rstd * wn[7]);
            *((u32x4*)(OCAT + row * D + 512) + lane) = o;
        }
    }
}

__device__ __forceinline__ void phase7(const Params& P, unsigned char* smem) {
    unsigned char* ws = P.ws;
    const int tid = opaque_tid(), wave = tid >> 6, lane = tid & 63;
    float* rw = (float*)smem;
    int* lctl = (int*)(smem + LDS_MISC + 256);
    float* lgs = (float*)(smem + LDS_MISC + 256 + 2560);
    for (int i = tid; i < 1024 * 8; i += NTHREADS) { const int k = i >> 3, c = i & 7; const f32x4 v = *(const f32x4*)(P.router_w + (size_t)k * 32 + 4 * c) * P.norm_ffn_w[k];
        *(f32x4*)(rw + k * 32 + ((4 * c + 16 * ((k >> 2) & 1)) & 31)) = v; }
    const float* X1 = (const float*)(ws + WS_X1); unsigned char* H2 = ws + WS_H;
    int* tok_e = (int*)(ws + WS_TOKE); int* tok_r = (int*)(ws + WS_TOKR); float* gate = (float*)(ws + WS_GATE); int* list = (int*)(ws + WS_LIST);
    unsigned* cnt = (unsigned*)(ws + WS_CTL) + CW_CNT;
    for (int tg = blockIdx.x; tg < T / 64; tg += gridDim.x) {
    __syncthreads();
    if (tid < 64) lctl[tid] = 0;
    __syncthreads();
    if (wave < 4) {
        const int ti = lane & 15, kk = lane >> 4; const int row = tg * 64 + wave * 16 + ti;
        const f32x4* xr = (const f32x4*)(X1 + (size_t)row * D) + kk;
        const float* bw = rw + (4 * kk) * 32 + (((lane & 15) + 16 * (kk & 1)) & 31);
        f32x4 a0 = {0.f, 0.f, 0.f, 0.f}, a1 = {0.f, 0.f, 0.f, 0.f}; float ss = 0.f;
#pragma unroll 1
        for (int sb = 0; sb < 64; sb += 8) {
            f32x4 xv[8];
#pragma unroll
            for (int u = 0; u < 8; ++u) xv[u] = xr[4 * (sb + u)];
#pragma unroll
            for (int u = 0; u < 8; ++u) { ss += xv[u].x * xv[u].x + xv[u].y * xv[u].y + xv[u].z * xv[u].z + xv[u].w * xv[u].w;
#pragma unroll
                for (int j = 0; j < 4; ++j) { const float* bp = bw + (16 * (sb + u) + j) * 32; const float b0 = bp[0], b1 = *(const float*)((const char*)bp + ((((lane & 15) + 16 * (kk & 1)) & 16) ? -64 : 64));
                    a0 = __builtin_amdgcn_mfma_f32_16x16x4f32(xv[u][j], b0, a0, 0, 0, 0);
                    a1 = __builtin_amdgcn_mfma_f32_16x16x4f32(xv[u][j], b1, a1, 0, 0, 0); } }
        }
        ss += __shfl_xor(ss, 16); ss += __shfl_xor(ss, 32);
        const float rstd = rsqrtf(ss * (1.f / D) + EPS);
        float* lg = lgs + wave * (16 * 33);
#pragma unroll
        for (int r = 0; r < 4; ++r) { const int t = 4 * kk + r; const float rs = __shfl(rstd, t);
            lg[t * 33 + (lane & 15)] = a0[r] * rs + P.router_b[lane & 15]; lg[t * 33 + 16 + (lane & 15)] = a1[r] * rs + P.router_b[16 + (lane & 15)]; }
        asm volatile("s_waitcnt lgkmcnt(0)" ::: "memory");
        if (lane < 16) {
            const float* l = lg + lane * 33; const int trow = tg * 64 + wave * 16 + lane;
            int ei[4]; float ev[4];
#pragma unroll
            for (int k = 0; k < 4; ++k) { float best = -3.0e38f; int bi = 0;
                for (int j = 0; j < 32; ++j) { const float v = l[j]; const bool taken = (k > 0 && ei[0] == j) || (k > 1 && ei[1] == j) || (k > 2 && ei[2] == j); if (!taken && v > best) { best = v; bi = j; } }
                ei[k] = bi; ev[k] = best; }
            float gs = 0.f, gv[4];
#pragma unroll
            for (int k = 0; k < 4; ++k) { gv[k] = __expf(ev[k] - ev[0]); gs += gv[k]; }
            const float ig = 1.f / gs;
#pragma unroll
            for (int k = 0; k < 4; ++k) { const int lr = atomicAdd(&lctl[ei[k]], 1);
                lctl[64 + ((wave * 16 + lane) * 4 + k) * 2] = ei[k]; lctl[64 + ((wave * 16 + lane) * 4 + k) * 2 + 1] = lr; }
            *(f32x4*)(gate + (size_t)trow * 4) = (f32x4){gv[0] * ig, gv[1] * ig, gv[2] * ig, gv[3] * ig};
        }
    } else {
        for (int ti = 0; ti < 16; ++ti) { const int row = tg * 64 + (wave - 4) * 16 + ti;
            f32x4 v[4]; float ss = 0.f;
#pragma unroll
            for (int j = 0; j < 4; ++j) { v[j] = *((const f32x4*)(X1 + (size_t)row * D) + lane + 64 * j); ss += v[j].x * v[j].x + v[j].y * v[j].y + v[j].z * v[j].z + v[j].w * v[j].w; }
            const float rstd = rsqrtf(wave_sum(ss) * (1.f / D) + EPS);
#pragma unroll
            for (int j = 0; j < 4; ++j) { const f32x4 h = v[j] * rstd * *((const f32x4*)P.norm_ffn_w + lane + 64 * j);
                *((unsigned*)(H2 + (size_t)row * D) + lane + 64 * j) = pk4_fp8(h.x, h.y, h.z, h.w); }
        }
    }
    __syncthreads();
    if (tid < 32) lctl[32 + tid] = (int)atomicAdd(&cnt[tid], (unsigned)lctl[tid]);
    __syncthreads();
    if (tid < 256) { const int e = lctl[64 + tid * 2], lr = lctl[64 + tid * 2 + 1]; const int row = tg * 64 + (tid >> 2); const int rank = lctl[32 + e] + lr;
        tok_e[(size_t)row * 4 + (tid & 3)] = e; tok_r[(size_t)row * 4 + (tid & 3)] = rank; list[e * T + rank] = row; }
    }
}

__device__ __forceinline__ void moe_tiles(const Params& P, unsigned char* smem) {
    int* tstart = (int*)(smem + LDS_MISC + 256); int* cntl = tstart + 64;
    const unsigned* cnt = (const unsigned*)(P.ws + WS_CTL) + CW_CNT;
    __syncthreads();
    if (threadIdx.x == 0) { int acc = 0; for (int e = 0; e < NE; ++e) { const int c = (int)__hip_atomic_load(&cnt[e], __ATOMIC_RELAXED, __HIP_MEMORY_SCOPE_AGENT); cntl[e] = c; tstart[e] = acc; acc += (c + 255) >> 8; } tstart[NE] = acc;
        int* xs = tstart + 100; const int x = blockIdx.x & 7; int a2 = 0; for (int j = 0; j < 4; ++j) { xs[j] = a2; a2 += (cntl[x + 8 * j] + 255) >> 8; } xs[4] = a2; }
    __syncthreads();
}

__device__ __forceinline__ void phase8(const Params& P, unsigned char* smem) {
    unsigned char* ws = P.ws;
    const int tid_ = opaque_tid(), lane = tid_ & 63, gw = blockIdx.x * NWAVES + (tid_ >> 6), ngw = gridDim.x * NWAVES;
    const int* tstart = (const int*)(smem + LDS_MISC + 256);
    const int* tok_e = (const int*)(ws + WS_TOKE); const int* tok_r = (const int*)(ws + WS_TOKR);
    const unsigned char* H2 = ws + WS_H; unsigned char* XG = ws + WS_XG;
    for (int row = gw; row < T; row += ngw) {
        const u32x4 v = *((const u32x4*)(H2 + (size_t)row * D) + lane);
#pragma unroll
        for (int k = 0; k < 4; ++k) { const int e = tok_e[(size_t)row * 4 + k], rk = tok_r[(size_t)row * 4 + k];
            *((u32x4*)(XG + (size_t)(tstart[e] * 256 + rk) * D) + lane) = v; }
    }
}

__device__ __forceinline__ void phase11(const Params& P, unsigned char* smem) {
    unsigned char* ws = P.ws;
    const int tid_ = opaque_tid(), lane = tid_ & 63, gw = blockIdx.x * NWAVES + (tid_ >> 6), ngw = gridDim.x * NWAVES;
    const float* X1 = (const float*)(ws + WS_X1);
    const int* tstart = (const int*)(smem + LDS_MISC + 256);
    const int* tok_e = (const int*)(ws + WS_TOKE); const int* tok_r = (const int*)(ws + WS_TOKR); const float* gate = (const float*)(ws + WS_GATE); const bf16_t* Y = (const bf16_t*)(ws + WS_Y);
    struct Rec { int e[4], rk[4]; float g[4]; };
    auto ldrec = [&](int row, Rec& r) {
#pragma unroll
        for (int k = 0; k < 4; ++k) { r.e[k] = tok_e[(size_t)row * 4 + k]; r.rk[k] = tok_r[(size_t)row * 4 + k]; r.g[k] = gate[(size_t)row * 4 + k]; } };
    Rec rc, rn; f32x4 v[4], vn[4]; u32x2 y[4][4], yn[4][4];
    const int nrows = (T - gw + ngw - 1) / ngw;
    rn.e[0] = 0;
    if (nrows > 0) { ldrec(gw, rc);
#pragma unroll
        for (int j = 0; j < 4; ++j) v[j] = *((const f32x4*)(X1 + (size_t)gw * D) + lane + 64 * j);
        if (nrows > 1) ldrec(gw + ngw, rn);
#pragma unroll
        for (int k = 0; k < 4; ++k) { const bf16_t* yr = Y + (size_t)(tstart[rc.e[k]] * 256 + rc.rk[k]) * D;
#pragma unroll
            for (int j = 0; j < 4; ++j) y[k][j] = *((const u32x2*)yr + lane + 64 * j); } }
    for (int i = 0; i < nrows; ++i) {
        const int row = gw + i * ngw;
        Rec rnn = rn;
        if (i + 1 < nrows) {
#pragma unroll
            for (int j = 0; j < 4; ++j) vn[j] = *((const f32x4*)(X1 + (size_t)(row + ngw) * D) + lane + 64 * j);
#pragma unroll
            for (int k = 0; k < 4; ++k) { const bf16_t* yr = Y + (size_t)(tstart[rn.e[k]] * 256 + rn.rk[k]) * D;
#pragma unroll
                for (int j = 0; j < 4; ++j) yn[k][j] = *((const u32x2*)yr + lane + 64 * j); }
            if (i + 2 < nrows) ldrec(row + 2 * ngw, rnn);
        }
#pragma unroll
        for (int k = 0; k < 4; ++k) { const float gg = rc.g[k];
#pragma unroll
            for (int j = 0; j < 4; ++j) { const u32x2 yy = y[k][j]; v[j].x += gg * bflo(yy.x); v[j].y += gg * bfhi(yy.x); v[j].z += gg * bflo(yy.y); v[j].w += gg * bfhi(yy.y); } }
        float ss = 0.f;
#pragma unroll
        for (int j = 0; j < 4; ++j) ss += v[j].x * v[j].x + v[j].y * v[j].y + v[j].z * v[j].z + v[j].w * v[j].w;
        const float rstd = rsqrtf(wave_sum(ss) * (1.f / D) + EPS);
#pragma unroll
        for (int j = 0; j < 4; ++j) *((f32x4*)(P.out + (size_t)row * D) + lane + 64 * j) = v[j] * rstd * *((const f32x4*)P.norm_final_w + lane + 64 * j);
        rc = rn; rn = rnn;
#pragma unroll
        for (int j = 0; j < 4; ++j) { v[j] = vn[j];
#pragma unroll
            for (int k = 0; k < 4; ++k) y[k][j] = yn[k][j]; }
    }
}

extern "C" __global__ void __launch_bounds__(NTHREADS) fwd_megakernel(Params P) {
    extern __shared__ __attribute__((aligned(16))) unsigned char smem[];
    LAS unsigned char* lds = (LAS unsigned char*)smem;
    unsigned char* ws = P.ws;
    const int tid = threadIdx.x;
    const int G = gridDim.x, bid = blockIdx.x;
    volatile LAS unsigned* misc = (volatile LAS unsigned*)(lds + LDS_MISC);
    if (tid < 64) misc[tid] = 0u;
    __syncthreads();
    XcdBarrier bar = xcd_barrier_post((unsigned*)(ws + WS_CTL) + CW_BAR, misc);
#if TSA >= 0
    unsigned long long* tsw = (unsigned long long*)((unsigned*)(ws + WS_CTL) + CW_TS); int tsi = 0;
#define STAMP() do { if (bid == 0 && tid == 0) tsw[tsi] = __builtin_amdgcn_s_memrealtime(); ++tsi; } while (0)
#else
#define STAMP() do { } while (0)
#endif
#define GRID_BAR() do { xcd_barrier(bar); STAMP(); } while (0)
    STAMP();

    REP(0) phase0(P, smem);
    GRID_BAR();
#if LEVEL >= 2
    REP(1) {
        pg8::DenseOrder S{(const char*)(ws + WS_H), (const char*)(ws + WS_WIN), T / 256, DINP / 256, D, G, bid};
        EpiProj E{(bf16_t*)(ws + WS_PROJ)};
        pg8::gemm_phase<EpiProj, pg8::DenseOrder>(lds, D, S, E);
    }
    GRID_BAR();
    REP(2) phase2a(P);
#if LEVEL >= 3
    REP(12) { u32x4 raw[11]; const int tidp = opaque_tid();
        if (tidp < 384 && bid < NB * GH * NCH) prep_conv_load(P, bid, tidp, raw);
        for (int item = bid; item < NB * GH * NCH; item += G) gdn_prep_item(P, smem, item, (item + G < NB * GH * NCH) ? item + G : -1, raw); }
#endif
    GRID_BAR();
    REP(3) {
        pg8::DenseOrder S{(const char*)(ws + WS_CQN), (const char*)(ws + WS_WUQ), T / 256, 768 / 256, QL, G, bid};
        EpiQ E{(bf16_t*)(ws + WS_Q), (const float*)(ws + WS_TAB)};
        pg8::gemm_phase<EpiQ, pg8::DenseOrder>(lds, QL, S, E);
        pg8::DenseOrder S2{(const char*)(ws + WS_CKVN), (const char*)(ws + WS_WUKV), T / 256, 1024 / 256, KVL, G, (bid + 64) % G};
        EpiKV E2{(bf16_t*)(ws + WS_K), (bf16_t*)(ws + WS_VT)};
        pg8::gemm_phase<EpiKV, pg8::DenseOrder>(lds, KVL, S2, E2);
    }
    GRID_BAR();
    {
        REP(14) if (bid < NB * GH) gdn_scan(P, smem, bid);
#if TSA >= 0
        if (bid == 0 && tid == 0) { tsw[20] = tsw[tsi - 1]; tsw[21] = __builtin_amdgcn_s_memrealtime(); }
#endif
        const int tidq = opaque_tid();
        const bool tfirst = ((bid & 7) >= 5);
        for (int rep_ = 0; rep_ < ((DUP == 4 || DUP == 15) ? 2 : 1); ++rep_)
#pragma unroll 1
        for (int pass = 0; pass < 2; ++pass) {
            unsigned* aq = (unsigned*)(ws + WS_CTL) + CW_AQ + 128 * rep_;
            const bool do_t = (pass == 0) == tfirst;
            unsigned* qh = aq + (do_t ? 64 : 0);
            const int qn = do_t ? 0 : ((rep_ == 1 && DUP == 15) ? 0 : 512);
            if (do_t) { if (!(rep_ == 1 && DUP == 4)) late_transposes(P, smem, qh, misc, tidq); continue; }
            for (;;) {
                __syncthreads();
                if (tidq == 0) misc[8] = atomicAdd(qh, 1u);
                __syncthreads();
                const int item = (int)misc[8];
                if (item >= qn) break;
                attn_item(P, smem, item);
            }
        }
    }
    GRID_BAR();
    REP(5) { phase5(P);
        GdnOutRegs R; const int tido = opaque_tid();
        if (bid < NB * GH * NCH) gdn_out_load(P, bid, tido, R);
        for (int item = bid; item < NB * GH * NCH; item += G) gdn_out_item(P, smem, item, (item + G < NB * GH * NCH) ? item + G : -1, R); }
    GRID_BAR();
    REP(6) {
        pg8::DenseOrder S{(const char*)(ws + WS_OCAT), (const char*)(ws + WS_WOUT), T / 256, D / 256, D, G, bid};
        EpiX1 E{P.x, (float*)(ws + WS_X1)};
        pg8::gemm_phase<EpiX1, pg8::DenseOrder>(lds, D, S, E);
    }
    GRID_BAR();
#endif
#if LEVEL >= 4
    phase7(P, smem);
    GRID_BAR();
    moe_tiles(P, smem);
    REP(9) {
        const LAS int* ts = (const LAS int*)(lds + LDS_MISC + 256);
        MoeOrder1 S{(const char*)(ws + WS_H), (const char*)(ws + WS_W1), (const int*)(ws + WS_LIST), ts, ts + 64, ts + 100, G, bid};
        EpiAct E{ws + WS_ACT, P.b1};
        pg8::gemm_phase<EpiAct, MoeOrder1, true>(lds, D, S, E);
    }
    GRID_BAR();
    REP(10) {
        const LAS int* ts = (const LAS int*)(lds + LDS_MISC + 256);
        MoeOrder2 S{(const char*)(ws + WS_ACT), (const char*)(ws + WS_W2), ts, ts + 100, G, bid};
        EpiY E{(bf16_t*)(ws + WS_Y), P.b2};
        pg8::gemm_phase<EpiY, MoeOrder2, true>(lds, DFF, S, E);
    }
    GRID_BAR();
#endif
    REP(11) phase11(P, smem);
#if TSA >= 0
    if (bid == 0) {
        __syncthreads();
        if (tid == 0) { const unsigned long long dt = tsw[TSA + 1] - tsw[TSA], t0 = __builtin_amdgcn_s_memrealtime();
            while (__builtin_amdgcn_s_memrealtime() - t0 < dt) __builtin_amdgcn_s_sleep(8); }
        __syncthreads();
    }
#endif
}

extern "C" void kernel_launch(void* const* d_in, const int* in_sizes, int n_in, void* d_out, int out_size, void* d_ws, size_t ws_size, hipStream_t stream) {
    static int grid = 0;
    if (grid == 0) {
        if (n_in != 22 || in_sizes[0] != T * D || out_size != T * D || ws_size < WS_END) {
            fprintf(stderr, "kernel_launch: unexpected shapes (n_in %d, in0 %d, out %d, ws %zu < %zu)\n", n_in, n_in > 0 ? in_sizes[0] : -1, out_size, ws_size, (size_t)WS_END); grid = -1; return; }
        int dev = 0, cus = 0, per_cu = 0;
        if (hipGetDevice(&dev) != hipSuccess || hipDeviceGetAttribute(&cus, hipDeviceAttributeMultiprocessorCount, dev) != hipSuccess) { grid = -1; return; }
        if (hipFuncSetAttribute((const void*)fwd_megakernel, hipFuncAttributeMaxDynamicSharedMemorySize, LDS_BYTES) != hipSuccess) { fprintf(stderr, "kernel_launch: hipFuncSetAttribute failed\n"); grid = -1; return; }
        if (hipOccupancyMaxActiveBlocksPerMultiprocessor(&per_cu, (const void*)fwd_megakernel, NTHREADS, LDS_BYTES) != hipSuccess || per_cu < 1) { fprintf(stderr, "kernel_launch: occupancy query says %d\n", per_cu); (void)hipGetLastError(); grid = -1; return; }
        grid = cus;
        if (grid != 256) fprintf(stderr, "kernel_launch: note: %d CUs\n", grid);
    }
    if (grid < 0) return;
    (void)hipMemsetAsync((char*)d_ws + WS_CTL, 0, CTL_BYTES, stream);
    Params p{};
    p.x = (const float*)d_in[0]; p.pos = (const int*)d_in[1]; p.norm_mix_w = (const float*)d_in[2]; p.w_in = (const float*)d_in[3]; p.conv_w = (const float*)d_in[4];
    p.a_log = (const float*)d_in[5]; p.dt_bias = (const float*)d_in[6]; p.gdn_norm_w = (const float*)d_in[7]; p.q_norm_w = (const float*)d_in[8]; p.w_uq = (const float*)d_in[9];
    p.kv_norm_w = (const float*)d_in[10]; p.w_ukv = (const float*)d_in[11]; p.mla_out_norm_w = (const float*)d_in[12]; p.w_out = (const float*)d_in[13]; p.norm_ffn_w = (const float*)d_in[14];
    p.router_w = (const float*)d_in[15]; p.router_b = (const float*)d_in[16]; p.w1 = (const float*)d_in[17]; p.b1 = (const float*)d_in[18]; p.w2 = (const float*)d_in[19];
    p.b2 = (const float*)d_in[20]; p.norm_final_w = (const float*)d_in[21]; p.out = (float*)d_out; p.ws = (unsigned char*)d_ws;
    void* args[] = {&p};
    hipError_t e = hipLaunchCooperativeKernel((const void*)fwd_megakernel, dim3(grid), dim3(NTHREADS), args, LDS_BYTES, stream);
    if (e != hipSuccess) fprintf(stderr, "kernel_launch: cooperative launch failed: %s (grid %d)\n", hipGetErrorString(e), grid);
}
```

```cpp
#include <hip/hip_runtime.h>
#include <cstdio>
#include <cstdint>

#ifndef LEVEL
#define LEVEL 4
#endif

#ifndef DUP
#define DUP -1
#endif
#ifndef TSA
#define TSA -1
#define TSB -1
#endif
#define REP(k) for (int rep_ = 0; rep_ < ((DUP == (k)) ? 2 : 1); ++rep_)
#define LAS __attribute__((address_space(3)))
typedef unsigned short bf16_t;
typedef short bf16x8 __attribute__((ext_vector_type(8)));
typedef float f32x4 __attribute__((ext_vector_type(4)));
typedef float f32x16 __attribute__((ext_vector_type(16)));
typedef unsigned u32x4 __attribute__((ext_vector_type(4)));
typedef unsigned u32x2 __attribute__((ext_vector_type(2)));

constexpr int NB = 4, SEQ = 4096, T = NB * SEQ, D = 1024, DIN = 2728, DINP = 2816;
constexpr int GH = 4, NCH = SEQ / 64;
constexpr int MH = 8, DQK = 96, QL = 384, KVL = 256;
constexpr int NE = 32, DFF = 1024;
constexpr int C_Z = 1536, C_CQ = 2056, C_CKV = 2440, C_KR = 2696;
constexpr float EPS = 1e-6f;
constexpr int NTHREADS = 512, NWAVES = 8;
constexpr int LDS_BYTES = 147456;
constexpr int LDS_MISC = 131072;
constexpr int MOE_MAXROWS = 73728;

constexpr size_t MiB = 1u << 20;
constexpr size_t WS_CTL = 0, CTL_BYTES = 65536;
constexpr size_t WS_WIN = 1 * MiB, WS_WUQ = 7 * MiB, WS_WUKV = 8 * MiB, WS_WOUT = 9 * MiB, WS_W1 = 11 * MiB, WS_W2 = 139 * MiB;
constexpr size_t WS_X1 = 203 * MiB, WS_H = 267 * MiB, WS_AB = 299 * MiB, WS_TAB = 300 * MiB;
constexpr size_t WS_TOKE = 302 * MiB, WS_TOKR = WS_TOKE + 256 * 1024, WS_GATE = WS_TOKR + 256 * 1024, WS_LIST = 303 * MiB;
constexpr size_t WS_R = 306 * MiB;
constexpr size_t WS_PROJ = WS_R, WS_CQN = WS_R + 88 * MiB, WS_CKVN = WS_R + 100 * MiB, WS_Q = WS_R + 108 * MiB, WS_K = WS_R + 132 * MiB, WS_VT = WS_R + 156 * MiB;
constexpr size_t WS_GP = WS_R + 172 * MiB;
constexpr size_t GP_ITEM = 90112, GP_U = 0, GP_W = 32768, GP_QD = 49152, GP_KDT = 65536, GP_QK = 81920;
constexpr size_t WS_GT = WS_R + 260 * MiB, WS_OA = WS_R + 261 * MiB, WS_OB = WS_R + 293 * MiB, WS_OCAT = WS_R + 309 * MiB;
constexpr size_t WS_ACT = WS_R, WS_Y = WS_R + 144 * MiB, WS_XG = WS_R + 288 * MiB;
constexpr size_t WS_SB = WS_R + 341 * MiB;
constexpr size_t WS_END = WS_R + 373 * MiB;
constexpr int CW_BAR = 4096, CW_CNT = 8192  , CW_AQ = 8320  , CW_TS = 12288  ;

struct Params {
    const float* x; const int* pos; const float* norm_mix_w; const float* w_in; const float* conv_w; const float* a_log; const float* dt_bias;
    const float* gdn_norm_w; const float* q_norm_w; const float* w_uq; const float* kv_norm_w; const float* w_ukv; const float* mla_out_norm_w;
    const float* w_out; const float* norm_ffn_w; const float* router_w; const float* router_b; const float* w1; const float* b1; const float* w2;
    const float* b2; const float* norm_final_w; float* out; unsigned char* ws;
};

typedef float f32x2v __attribute__((ext_vector_type(2)));
typedef __bf16 bf16x2v __attribute__((ext_vector_type(2)));
__device__ __forceinline__ unsigned pk2(float lo, float hi) { const f32x2v v = {lo, hi}; return __builtin_bit_cast(unsigned, __builtin_convertvector(v, bf16x2v)); }
__device__ __forceinline__ unsigned f2bf(float f) { return pk2(f, 0.f) & 0xffffu; }
__device__ __forceinline__ unsigned pk4_fp8(float a, float b, float c, float d) { unsigned w = 0u; w = __builtin_amdgcn_cvt_pk_fp8_f32(a, b, w, false); w = __builtin_amdgcn_cvt_pk_fp8_f32(c, d, w, true); return w; }
typedef int v4i_t __attribute__((ext_vector_type(4)));
typedef int v8i_t __attribute__((ext_vector_type(8)));
__device__ __forceinline__ float bflo(unsigned u) { return __builtin_bit_cast(float, u << 16); }
__device__ __forceinline__ float bfhi(unsigned u) { return __builtin_bit_cast(float, u & 0xffff0000u); }
__device__ __forceinline__ float bf1(bf16_t b) { return __builtin_bit_cast(float, (unsigned)b << 16); }
template <int CTRL> __device__ __forceinline__ float dpp_mov(float v) { return __builtin_bit_cast(float, __builtin_amdgcn_update_dpp(0, __builtin_bit_cast(int, v), CTRL, 0xF, 0xF, true)); }
__device__ __forceinline__ void swap16(float& a, float& b) { asm("s_nop 1\n\tv_permlane16_swap_b32 %0, %1" : "+v"(a), "+v"(b)); }
__device__ __forceinline__ void swap32(float& a, float& b) { asm("s_nop 1\n\tv_permlane32_swap_b32 %0, %1" : "+v"(a), "+v"(b)); }
__device__ __forceinline__ float row16_sum(float v) {
    v += dpp_mov<0xB1>(v); v += dpp_mov<0x4E>(v); v += dpp_mov<0x141>(v); v += dpp_mov<0x140>(v); return v; }
template <int CTRL, int ROWS> __device__ __forceinline__ float dpp_mov0(float v) { return __builtin_bit_cast(float, __builtin_amdgcn_update_dpp(0, __builtin_bit_cast(int, v), CTRL, ROWS, 0xF, false)); }
__device__ __forceinline__ float wave_scan(float v) {
    v += dpp_mov0<0x111, 0xF>(v); v += dpp_mov0<0x112, 0xF>(v); v += dpp_mov0<0x114, 0xF>(v); v += dpp_mov0<0x118, 0xF>(v);
    v += dpp_mov0<0x142, 0xA>(v); v += dpp_mov0<0x143, 0xC>(v); return v; }
__device__ __forceinline__ float xor16_sum(float v) { float a = v, b = v; swap16(a, b); return a + b; }
__device__ __forceinline__ float xor32_sum(float v) { float a = v, b = v; swap32(a, b); return a + b; }
__device__ __forceinline__ float xor32_max(float v) { float a = v, b = v; swap32(a, b); return fmaxf(a, b); }
__device__ __forceinline__ float wave_sum(float v) { return xor32_sum(xor16_sum(row16_sum(v))); }
__device__ __forceinline__ int opaque_tid() { int t = threadIdx.x; asm volatile("" : "+v"(t)); return t; }
__device__ __forceinline__ float sigmoidf_(float x) { return __builtin_amdgcn_rcpf(1.f + __builtin_amdgcn_exp2f(-1.4426950408889634f * x)); }
__device__ __forceinline__ bf16x8 pack8(f32x4 a, f32x4 b) {
    u32x4 r; r.x = pk2(a.x, a.y); r.y = pk2(a.z, a.w); r.z = pk2(b.x, b.y); r.w = pk2(b.z, b.w);
    return __builtin_bit_cast(bf16x8, r);
}
__device__ __forceinline__ int perm32k(int d) { return (d & ~31) | (((d >> 2) & 3) << 3) | (((d >> 4) & 1) << 2) | (d & 3); }
__device__ __forceinline__ int perm16v(int s) { return (s & ~15) | (((s >> 2) & 1) << 3) | (((s >> 3) & 1) << 2) | (s & 3); }

#define XB_TMO      128
#define XB_XCNT(j)  (256  + 64 * (j))
#define XB_XSUB(j)  (1280 + 64 * (j))
#define XB_XGEN(j)  (2304 + 64 * (j))
#define XB_TOP      3328
#define XB_TOPGEN   3392
#define XCD_BAR_WORDS 3456
#define XB_SPIN_CAP (1u << 18)
__device__ __forceinline__ unsigned xb_ld(unsigned* p)              { return __hip_atomic_load(p, __ATOMIC_RELAXED, __HIP_MEMORY_SCOPE_AGENT); }
__device__ __forceinline__ unsigned xb_add(unsigned* p, unsigned v) { return __hip_atomic_fetch_add(p, v, __ATOMIC_RELAXED, __HIP_MEMORY_SCOPE_AGENT); }
__device__ __forceinline__ unsigned xb_xcc_id() { return (unsigned)__builtin_amdgcn_s_getreg((3 << 11) | 20) & 0xFu; }
#define XB_SPIN(cond, bar) do { unsigned _sp = 0; while (cond) { __builtin_amdgcn_s_sleep(1); \
    if ((++_sp & 255u) == 0u) { if (xb_ld(&(bar)[XB_TMO])) break; if (_sp > XB_SPIN_CAP) { atomicAdd(&(bar)[XB_TMO], 1u); break; } } } } while (0)
struct XcdBarrier { unsigned* bar; unsigned x; volatile LAS unsigned* st; };
__device__ __forceinline__ XcdBarrier xcd_barrier_post(unsigned* bar, volatile LAS unsigned* st) {
    XcdBarrier b; b.bar = bar; b.x = xb_xcc_id(); b.st = st;
    if (threadIdx.x == 0) (void)xb_add(&bar[XB_XCNT(b.x)], 1u);
    return b;
}
__device__ __forceinline__ void xcd_barrier_complete(unsigned* bar, unsigned x, unsigned& nloc, unsigned& nx) {
    const unsigned G = gridDim.x * gridDim.y * gridDim.z;
    unsigned sum, cnt, mine, sp = 0u;
    for (;;) {
        sum = 0u; cnt = 0u; mine = 0u;
#pragma unroll
        for (unsigned j = 0; j < 16; ++j) { const unsigned c = xb_ld(&bar[XB_XCNT(j)]); sum += c; cnt += (c > 0u) ? 1u : 0u; mine = (j == x) ? c : mine; }
        if (sum == G) break;
        __builtin_amdgcn_s_sleep(1);
        if ((++sp & 255u) == 0u) { if (xb_ld(&bar[XB_TMO])) break; if (sp > XB_SPIN_CAP) { atomicAdd(&bar[XB_TMO], 1u); break; } }
    }
    nloc = mine > 0u ? mine : 1u; nx = cnt > 0u ? cnt : 1u;
}
__device__ __forceinline__ void xcd_barrier(const XcdBarrier& b) {
    asm volatile("s_waitcnt vmcnt(0)" ::: "memory");
    __syncthreads();
    if (threadIdx.x == 0) {
        unsigned* bar = b.bar;
        __builtin_amdgcn_s_waitcnt(0);
        unsigned nloc = b.st[0], nx = b.st[1];
        if (nloc == 0u) { xcd_barrier_complete(bar, b.x, nloc, nx); b.st[0] = nloc; b.st[1] = nx; }
        const unsigned old = xb_add(&bar[XB_XSUB(b.x)], 1u);
        const unsigned gen = old / nloc;
        if (old + 1u == (gen + 1u) * nloc) {
            __builtin_amdgcn_fence(__ATOMIC_RELEASE, "agent");
            asm volatile("s_waitcnt vmcnt(0)" ::: "memory");
            const unsigned og = xb_add(&bar[XB_TOP], 1u);
            const unsigned tg = og / nx;
            if (og + 1u == (tg + 1u) * nx) xb_add(&bar[XB_TOPGEN], 1u);
            else XB_SPIN(xb_ld(&bar[XB_TOPGEN]) == tg, bar);
            __builtin_amdgcn_fence(__ATOMIC_ACQUIRE, "agent");
            xb_add(&bar[XB_XGEN(b.x)], 1u);
            asm volatile("s_waitcnt vmcnt(0)" ::: "memory");
        } else {
            XB_SPIN(xb_ld(&bar[XB_XGEN(b.x)]) == gen, bar);
            __builtin_amdgcn_fence(__ATOMIC_ACQUIRE, "agent");
            asm volatile("s_waitcnt vmcnt(0)" ::: "memory");
        }
    }
    __syncthreads();
}

namespace pg8 {
constexpr int BM = 256, BK = 64, HALF = 128, HTB = HALF * BK * 2, NXCD = 8, WGM = 4;
__device__ __forceinline__ int lds_byte(int r, int c) { const int st = (r >> 4) * 2 + (c >> 5), rr = r & 15, cc = c & 31, ob = rr * 64 + cc * 2; return st * 1024 + (ob ^ (((ob >> 9) & 1) << 5)); }
__device__ __forceinline__ void stage_rc(int b, int& R, int& C) { const int st = b / 1024, sb = b % 1024, swz = sb ^ (((sb >> 9) & 1) << 5); R = (st >> 1) * 16 + swz / 64; C = (st & 1) * 32 + (swz % 64) / 2; }
__device__ __forceinline__ int perm32(int rho) { const int n = rho >> 4, i = rho & 15; return 8 * (i >> 2) + 4 * n + (i & 3); }

struct Unit { int pm, pn, e; const char* A; const char* B; };

__device__ __forceinline__ void tile_order(int L, int nM, int nN, int& pm, int& pn) {
    const int nwg = nM * nN; int wgid = L;
    { const int q = nwg / NXCD, r = nwg % NXCD, xcd = wgid % NXCD, off = wgid / NXCD; wgid = (xcd < r ? xcd * (q + 1) : r * (q + 1) + (xcd - r) * q) + off; }
    const int nig = WGM * nN, gid = wgid / nig, fm = gid * WGM, gsz = (nM - fm) < WGM ? (nM - fm) : WGM;
    pm = fm + ((wgid % nig) % gsz); pn = (wgid % nig) / gsz;
}

template <class Epi, class Sched, bool FP8 = false>
__device__ __forceinline__ void gemm_phase(LAS unsigned char* lds, const int K, const Sched& S, const Epi& E) {
    const int tid = opaque_tid(), wid = __builtin_amdgcn_readfirstlane(tid >> 6), lane = tid & 63, wr = wid >> 2, wc = wid & 3, fr = lane & 15, fq = lane >> 4;
    const int RB = FP8 ? K : 2 * K;
    const int nt = RB / 128;
    int Rr[2], Cc[2];
    unsigned voffB[2];
#pragma unroll
    for (int i = 0; i < 2; ++i) { stage_rc(tid * 16 + i * 8192, Rr[i], Cc[i]); const int Rb = Epi::PERM ? ((Rr[i] & ~31) + perm32(Rr[i] & 31)) : Rr[i]; voffB[i] = (unsigned)(Rb * RB + Cc[i] * 2); }
    const size_t kstep = (size_t)(BK * 2);
    const unsigned hstep = (unsigned)HALF * RB;
    const unsigned ldsw = (unsigned)wid * 1024u;
    const int aoff = lds_byte(wr * 64 + fr, fq * 8), boff = lds_byte(wc * 32 + fr, fq * 8);
#define PG8_SA(b, h) (((b) * 2 + (h)) * HTB)
#define PG8_SB(b, h) ((4 + (b) * 2 + (h)) * HTB)
#define PG8_RS(p) __builtin_amdgcn_make_buffer_rsrc((void*)(p), 0, 0x7fffffff, 0x00020000)
#define PG8_STAGE_A(bufoff, base, kb, h, VO) do { const auto rs_ = PG8_RS(base); _Pragma("unroll") for (int _i = 0; _i < 2; ++_i) \
        __builtin_amdgcn_raw_ptr_buffer_load_lds(rs_, (LAS void*)(lds + (bufoff) + ldsw + _i * 8192), 16, (int)(VO)[Sched::GATHER ? (h) : 0][_i], (int)((kb) + (Sched::GATHER ? 0u : (h) * hstep)), 0, 0); } while (0)
#define PG8_STAGE_B(bufoff, base, kb, h) do { const auto rs_ = PG8_RS(base); _Pragma("unroll") for (int _i = 0; _i < 2; ++_i) \
        __builtin_amdgcn_raw_ptr_buffer_load_lds(rs_, (LAS void*)(lds + (bufoff) + ldsw + _i * 8192), 16, (int)voffB[_i], (int)((kb) + (h) * hstep), 0, 0); } while (0)
#define PG8_LDA(dst, b, h) do { if constexpr (FP8) { _Pragma("unroll") for (int m = 0; m < 4; ++m) { const v4i_t x0_ = *(const LAS v4i_t*)(lds + PG8_SA(b, h) + aoff + m * 2048), x1_ = *(const LAS v4i_t*)(lds + PG8_SA(b, h) + aoff + m * 2048 + 1024); \
            dst##8[m] = __builtin_shufflevector(x0_, x1_, 0, 1, 2, 3, 4, 5, 6, 7); } } \
        else { _Pragma("unroll") for (int m = 0; m < 4; ++m) _Pragma("unroll") for (int k = 0; k < 2; ++k) dst[m][k] = *(const LAS bf16x8*)(lds + PG8_SA(b, h) + aoff + m * 2048 + k * 1024); } } while (0)
#define PG8_LDB(dst, b, h) do { if constexpr (FP8) { _Pragma("unroll") for (int n = 0; n < 2; ++n) { const v4i_t x0_ = *(const LAS v4i_t*)(lds + PG8_SB(b, h) + boff + n * 2048), x1_ = *(const LAS v4i_t*)(lds + PG8_SB(b, h) + boff + n * 2048 + 1024); \
            dst##8[n] = __builtin_shufflevector(x0_, x1_, 0, 1, 2, 3, 4, 5, 6, 7); } } \
        else { _Pragma("unroll") for (int n = 0; n < 2; ++n) _Pragma("unroll") for (int k = 0; k < 2; ++k) dst[n][k] = *(const LAS bf16x8*)(lds + PG8_SB(b, h) + boff + n * 2048 + k * 1024); } } while (0)
#define PG8_MMA(ai, bj, At, Bt) do { __builtin_amdgcn_s_setprio(1); \
        if constexpr (FP8) { _Pragma("unroll") for (int m = 0; m < 4; ++m) _Pragma("unroll") for (int n = 0; n < 2; ++n) \
            asm volatile("v_mfma_f32_16x16x128_f8f6f4 %0, %1, %2, %0" : "+v"(acc[ai][bj][m][n]) : "v"(Bt##8[n]), "v"(At##8[m])); } \
        else { _Pragma("unroll") for (int m = 0; m < 4; ++m) _Pragma("unroll") for (int n = 0; n < 2; ++n) _Pragma("unroll") for (int k = 0; k < 2; ++k) \
            acc[ai][bj][m][n] = __builtin_amdgcn_mfma_f32_16x16x32_bf16(Bt[n][k], At[m][k], acc[ai][bj][m][n], 0, 0, 0); } \
        __builtin_amdgcn_s_setprio(0); } while (0)
#define PG8_WAIT_V(n) asm volatile("s_waitcnt vmcnt(" #n ")" ::: "memory")
#define PG8_WAIT_L(n) asm volatile("s_waitcnt lgkmcnt(" #n ")" ::: "memory")
#define PG8_BAR __builtin_amdgcn_s_barrier()
#define PG8_SCHED __builtin_amdgcn_sched_barrier(0)
#define PG8_AOFFS(VO, u) do { _Pragma("unroll") for (int _h = 0; _h < 2; ++_h) _Pragma("unroll") for (int _i = 0; _i < 2; ++_i) { \
        if constexpr (Sched::GATHER) VO[_h][_i] = (unsigned)S.row_src(u, _h * HALF + Rr[_i]) * (unsigned)RB + (unsigned)(Cc[_i] * 2); \
        else VO[_h][_i] = (unsigned)(Rr[_i] * RB + Cc[_i] * 2); } } while (0)
    Unit cur, nxt; int ui = 0;
    if (!S.next(0, cur)) return;
    unsigned voc[2][2], von[2][2];
    PG8_AOFFS(voc, cur);
    f32x4 acc[2][2][4][2];
#pragma unroll
    for (int a = 0; a < 2; ++a)
#pragma unroll
        for (int b = 0; b < 2; ++b)
#pragma unroll
            for (int m = 0; m < 4; ++m)
#pragma unroll
                for (int n = 0; n < 2; ++n) acc[a][b][m][n] = (f32x4){0.f, 0.f, 0.f, 0.f};
    bf16x8 At[4][2], B0[2][2], B1[2][2]; v8i_t At8[4], B08[2], B18[2];
    const char* cA = cur.A; const char* cB = cur.B;
    PG8_STAGE_B(PG8_SB(0, 0), cB, 0, 0); PG8_STAGE_A(PG8_SA(0, 0), cA, 0, 0, voc); PG8_STAGE_B(PG8_SB(0, 1), cB, 0, 1); PG8_STAGE_A(PG8_SA(0, 1), cA, 0, 1, voc);
    if (wr == 1) PG8_BAR;
    PG8_WAIT_V(4); PG8_BAR;
    PG8_STAGE_B(PG8_SB(1, 0), cB, kstep, 0); PG8_STAGE_A(PG8_SA(1, 0), cA, kstep, 0, voc); PG8_STAGE_B(PG8_SB(1, 1), cB, kstep, 1);
    PG8_WAIT_V(6); PG8_BAR;
    for (;;) {
        const bool has_next = S.next(ui + 1, nxt);
        if constexpr (Sched::GATHER) {
            if (has_next) { PG8_AOFFS(von, nxt); }
            else {
#pragma unroll
                for (int _h = 0; _h < 2; ++_h)
#pragma unroll
                    for (int _i = 0; _i < 2; ++_i) von[_h][_i] = voc[_h][_i];
            }
        }
        const char* nA = has_next ? nxt.A : cA; const char* nB = has_next ? nxt.B : cB;
        for (int t = 0; t < nt; t += 2) {
            const bool last = (t == nt - 2);
            const size_t k1 = (size_t)(t + 1) * kstep;
            const char* a2 = last ? nA : cA; const char* b2 = last ? nB : cB;
            const size_t k2 = last ? 0 : (size_t)(t + 2) * kstep, k3 = k2 + kstep;
            unsigned vo2[2][2];
#pragma unroll
            for (int _h = 0; _h < 2; ++_h)
#pragma unroll
                for (int _i = 0; _i < 2; ++_i) { if constexpr (Sched::GATHER) vo2[_h][_i] = last ? von[_h][_i] : voc[_h][_i]; else vo2[_h][_i] = voc[_h][_i]; }
            PG8_LDB(B0, 0, 0); PG8_SCHED; PG8_LDA(At, 0, 0); PG8_STAGE_A(PG8_SA(1, 1), cA, k1, 1, voc);
            PG8_WAIT_L(8); PG8_BAR; PG8_WAIT_L(0); PG8_MMA(0, 0, At, B0); PG8_BAR; PG8_SCHED;
            PG8_LDB(B1, 0, 1); PG8_STAGE_B(PG8_SB(0, 0), b2, k2, 0);
            PG8_BAR; PG8_WAIT_L(0); PG8_MMA(0, 1, At, B1); PG8_BAR;
            PG8_LDA(At, 0, 1); PG8_STAGE_A(PG8_SA(0, 0), a2, k2, 0, vo2);
            PG8_BAR; PG8_WAIT_L(0); PG8_MMA(1, 0, At, B0); PG8_BAR; PG8_SCHED;
            PG8_STAGE_B(PG8_SB(0, 1), b2, k2, 1);
            PG8_WAIT_V(6); PG8_BAR; PG8_MMA(1, 1, At, B1); PG8_BAR;
            PG8_LDB(B0, 1, 0); PG8_SCHED; PG8_LDA(At, 1, 0); PG8_STAGE_A(PG8_SA(0, 1), a2, k2, 1, vo2);
            PG8_WAIT_L(8); PG8_BAR; PG8_WAIT_L(0); PG8_MMA(0, 0, At, B0); PG8_BAR; PG8_SCHED;
            PG8_LDB(B1, 1, 1); PG8_STAGE_B(PG8_SB(1, 0), b2, k3, 0);
            PG8_BAR; PG8_WAIT_L(0); PG8_MMA(0, 1, At, B1); PG8_BAR;
            PG8_LDA(At, 1, 1); PG8_STAGE_A(PG8_SA(1, 0), a2, k3, 0, vo2);
            PG8_BAR; PG8_WAIT_L(0); PG8_MMA(1, 0, At, B0); PG8_BAR; PG8_SCHED;
            PG8_STAGE_B(PG8_SB(1, 1), b2, k3, 1);
            PG8_WAIT_V(6); PG8_BAR; PG8_MMA(1, 1, At, B1); PG8_BAR;
        }
        if constexpr (FP8) asm volatile("s_nop 15\n\ts_nop 15" ::: "memory");
        E(acc, cur, wr, wc, fr, fq);
        if (!has_next) break;
#pragma unroll
        for (int a = 0; a < 2; ++a)
#pragma unroll
            for (int b = 0; b < 2; ++b)
#pragma unroll
                for (int m = 0; m < 4; ++m)
#pragma unroll
                    for (int n = 0; n < 2; ++n) acc[a][b][m][n] = (f32x4){0.f, 0.f, 0.f, 0.f};
        cur = nxt; cA = nA; cB = nB; ++ui;
        if constexpr (Sched::GATHER) {
#pragma unroll
            for (int _h = 0; _h < 2; ++_h)
#pragma unroll
                for (int _i = 0; _i < 2; ++_i) voc[_h][_i] = von[_h][_i];
        }
    }
    PG8_WAIT_V(0);
    if (wr == 0) PG8_BAR;
    PG8_BAR;
#undef PG8_SA
#undef PG8_SB
#undef PG8_STAGE_A
#undef PG8_RS
#undef PG8_STAGE_B
#undef PG8_LDA
#undef PG8_LDB
#undef PG8_MMA
#undef PG8_WAIT_V
#undef PG8_WAIT_L
#undef PG8_BAR
#undef PG8_SCHED
#undef PG8_AOFFS
}

struct DenseOrder {
    static constexpr bool GATHER = false;
    const char* A; const char* Bt; int nM, nN, K, G, c;
    __device__ __forceinline__ bool next(int i, Unit& u) const {
        const int L = i * G + c; if (L >= nM * nN) return false;
        tile_order(L, nM, nN, u.pm, u.pn); u.e = 0;
        u.A = A + (size_t)u.pm * BM * K * 2; u.B = Bt + (size_t)u.pn * BM * K * 2; return true;
    }
    __device__ __forceinline__ int row_src(const Unit&, int) const { return 0; }
};
}
using pg8::Unit;

struct EpiProj {
    static constexpr bool PERM = true;
    bf16_t* O;
    __device__ __forceinline__ void operator()(const f32x4 (&acc)[2][2][4][2], const Unit& u, int wr, int wc, int fr, int fq) const {
#pragma unroll
        for (int ai = 0; ai < 2; ++ai)
#pragma unroll
            for (int m = 0; m < 4; ++m) { const int row = u.pm * 256 + ai * 128 + wr * 64 + m * 16 + fr;
#pragma unroll
                for (int bj = 0; bj < 2; ++bj) { const int col = u.pn * 256 + bj * 128 + wc * 32 + 8 * fq; const f32x4 v0 = acc[ai][bj][m][0], v1 = acc[ai][bj][m][1];
                    u32x4 o; o.x = pk2(v0.x, v0.y); o.y = pk2(v0.z, v0.w); o.z = pk2(v1.x, v1.y); o.w = pk2(v1.z, v1.w);
                    *(u32x4*)(O + (size_t)row * DINP + col) = o; } }
    }
};
struct EpiQ {
    static constexpr bool PERM = false;
    bf16_t* Q; const float* tab;
    __device__ __forceinline__ void operator()(const f32x4 (&acc)[2][2][4][2], const Unit& u, int wr, int wc, int fr, int fq) const {
        const float sc = 0.10206207261596577f * 1.4426950408889634f;
        const bool anyrope = ((u.pn * 8 + wc) % 3 == 2) || ((u.pn * 8 + 4 + wc) % 3 == 2);
        f32x4 csv[2][4], snv[2][4];
        if (anyrope) {
#pragma unroll
            for (int ai = 0; ai < 2; ++ai)
#pragma unroll
                for (int m = 0; m < 4; ++m) { const int row = u.pm * 256 + ai * 128 + wr * 64 + m * 16 + fr;
                    csv[ai][m] = *(const f32x4*)(tab + (unsigned)(row * 32 + 4 * fq)); snv[ai][m] = *(const f32x4*)(tab + (unsigned)(row * 32 + 16 + 4 * fq)); } }
        __builtin_amdgcn_sched_barrier(0);
#pragma unroll
        for (int ai = 0; ai < 2; ++ai)
#pragma unroll
            for (int m = 0; m < 4; ++m) { const int row = u.pm * 256 + ai * 128 + wr * 64 + m * 16 + fr; const int b = row / SEQ, s = row % SEQ;
#pragma unroll
                for (int bj = 0; bj < 2; ++bj) { const int c0 = u.pn * 256 + bj * 128 + wc * 32; const int g32 = c0 >> 5; const int head = c0 / 96;
                    f32x4 v0 = acc[ai][bj][m][0], v1 = acc[ai][bj][m][1];
                    if (g32 % 3 == 2) {
                        const f32x4 cs = csv[ai][m], sn = snv[ai][m];
                        const f32x4 r0 = v0 * cs - v1 * sn, r1 = v1 * cs + v0 * sn; v0 = r0; v1 = r1;
                    }
                    v0 = v0 * sc; v1 = v1 * sc;
                    bf16_t* base = Q + (unsigned)(((b * MH + head) * SEQ + s) * DQK + (c0 - head * 96) + 4 * fq);
                    u32x2 o0; o0.x = pk2(v0.x, v0.y); o0.y = pk2(v0.z, v0.w); *(u32x2*)(base) = o0;
                    u32x2 o1; o1.x = pk2(v1.x, v1.y); o1.y = pk2(v1.z, v1.w); *(u32x2*)(base + 16) = o1; }
                __builtin_amdgcn_sched_barrier(0); }
    }
};
struct EpiKV {
    static constexpr bool PERM = false;
    bf16_t* Kp; bf16_t* VT;
    __device__ __forceinline__ void operator()(const f32x4 (&acc)[2][2][4][2], const Unit& u, int wr, int wc, int fr, int fq) const {
#pragma unroll
        for (int ai = 0; ai < 2; ++ai)
#pragma unroll
            for (int m = 0; m < 4; ++m) { const int row = u.pm * 256 + ai * 128 + wr * 64 + m * 16 + fr; const int b = row / SEQ, s = row % SEQ;
#pragma unroll
                for (int bj = 0; bj < 2; ++bj) { const int c0 = u.pn * 256 + bj * 128 + wc * 32; const int head = c0 >> 7; const int w0 = c0 & 127;
#pragma unroll
                    for (int n = 0; n < 2; ++n) { const f32x4 v = acc[ai][bj][m][n]; const int within = w0 + 16 * n + 4 * fq;
                        if (within < 64) { u32x2 o; o.x = pk2(v.x, v.y); o.y = pk2(v.z, v.w); *(u32x2*)(Kp + ((size_t)(b * MH + head) * SEQ + s) * DQK + within) = o; }
                        else { bf16_t* vb = VT + ((size_t)(b * MH + head) * 64 + (within - 64)) * SEQ + perm16v(s);
                            vb[0] = (bf16_t)f2bf(v.x); vb[SEQ] = (bf16_t)f2bf(v.y); vb[2 * SEQ] = (bf16_t)f2bf(v.z); vb[3 * SEQ] = (bf16_t)f2bf(v.w); } } } }
    }
};
struct EpiX1 {
    static constexpr bool PERM = false;
    const float* x; bf16_t* X1;
    __device__ __forceinline__ void operator()(const f32x4 (&acc)[2][2][4][2], const Unit& u, int wr, int wc, int fr, int fq) const {
#pragma unroll
        for (int ai = 0; ai < 2; ++ai) {
            f32x4 xv[4][2][2];
#pragma unroll
            for (int m = 0; m < 4; ++m) { const int row = u.pm * 256 + ai * 128 + wr * 64 + m * 16 + fr;
#pragma unroll
                for (int bj = 0; bj < 2; ++bj)
#pragma unroll
                    for (int n = 0; n < 2; ++n) xv[m][bj][n] = *(const f32x4*)(x + (unsigned)(row * D + u.pn * 256 + bj * 128 + wc * 32 + 16 * n + 4 * fq)); }
            __builtin_amdgcn_sched_barrier(0);
#pragma unroll
            for (int m = 0; m < 4; ++m) { const int row = u.pm * 256 + ai * 128 + wr * 64 + m * 16 + fr;
#pragma unroll
                for (int bj = 0; bj < 2; ++bj)
#pragma unroll
                    for (int n = 0; n < 2; ++n) { const unsigned o = (unsigned)(row * D + u.pn * 256 + bj * 128 + wc * 32 + 16 * n + 4 * fq);
                        const f32x4 v = xv[m][bj][n] + acc[ai][bj][m][n];
                        u32x2 p; p.x = pk2(v.x, v.y); p.y = pk2(v.z, v.w); *(u32x2*)(X1 + o) = p; } }
            __builtin_amdgcn_sched_barrier(0);
        }
    }
};
struct EpiAct {
    static constexpr bool PERM = true;
    unsigned char* ACT; const float* b1;
    __device__ __forceinline__ void operator()(const f32x4 (&acc)[2][2][4][2], const Unit& u, int wr, int wc, int fr, int fq) const {
        const float* bb = b1 + (size_t)u.e * 2048 + u.pn * 256 + wc * 32 + 8 * fq;
        f32x4 bq[4] = {*(const f32x4*)bb, *(const f32x4*)(bb + 4), *(const f32x4*)(bb + 128), *(const f32x4*)(bb + 132)};
#pragma unroll
        for (int k = 0; k < 4; ++k) { bq[k].y += 1.f; bq[k].w += 1.f; }
        __builtin_amdgcn_sched_barrier(0);
#pragma unroll
        for (int bj = 0; bj < 2; ++bj) { const int col = u.pn * 256 + bj * 128 + wc * 32 + 8 * fq;
            const f32x4 bv0 = bq[2 * bj], bv1 = bq[2 * bj + 1];
#pragma unroll
            for (int ai = 0; ai < 2; ++ai)
#pragma unroll
                for (int m = 0; m < 4; ++m) { const int row = u.pm * 256 + ai * 128 + wr * 64 + m * 16 + fr;
                    const f32x4 v0 = acc[ai][bj][m][0] * 0.03125f + bv0, v1 = acc[ai][bj][m][1] * 0.03125f + bv1;
                    f32x2v xgA = {fminf(v0.x, 7.f), fminf(v0.z, 7.f)}, xgB = {fminf(v1.x, 7.f), fminf(v1.z, 7.f)};
                    const f32x2v xlA = {__builtin_amdgcn_fmed3f(v0.y, -6.f, 8.f), __builtin_amdgcn_fmed3f(v0.w, -6.f, 8.f)}, xlB = {__builtin_amdgcn_fmed3f(v1.y, -6.f, 8.f), __builtin_amdgcn_fmed3f(v1.w, -6.f, 8.f)};
                    const f32x2v zA = xgA * -2.4554669595930157f, zB = xgB * -2.4554669595930157f;
                    f32x2v eA = {__builtin_amdgcn_exp2f(zA.x), __builtin_amdgcn_exp2f(zA.y)}, eB = {__builtin_amdgcn_exp2f(zB.x), __builtin_amdgcn_exp2f(zB.y)};
                    eA = eA + 1.f; eB = eB + 1.f;
                    const f32x2v rA = {__builtin_amdgcn_rcpf(eA.x), __builtin_amdgcn_rcpf(eA.y)}, rB = {__builtin_amdgcn_rcpf(eB.x), __builtin_amdgcn_rcpf(eB.y)};
                    const f32x2v aA = xgA * rA * xlA, aB = xgB * rB * xlB;
                    *(unsigned*)(ACT + (unsigned)(row * DFF + (col >> 1))) = pk4_fp8(aA.x, aA.y, aB.x, aB.y);
                    __builtin_amdgcn_sched_barrier(0); } }
    }
};
struct EpiY {
    static constexpr bool PERM = true;
    unsigned char* Y; const float* b2;
    __device__ __forceinline__ void operator()(const f32x4 (&acc)[2][2][4][2], const Unit& u, int wr, int wc, int fr, int fq) const {
        const float* bb = b2 + (size_t)u.e * 1024 + u.pn * 256 + wc * 32 + 8 * fq;
        const f32x4 bq[4] = {*(const f32x4*)bb, *(const f32x4*)(bb + 4), *(const f32x4*)(bb + 128), *(const f32x4*)(bb + 132)};
        __builtin_amdgcn_sched_barrier(0);
#pragma unroll
        for (int bj = 0; bj < 2; ++bj) { const int col = u.pn * 256 + bj * 128 + wc * 32 + 8 * fq;
            const f32x4 bv0 = bq[2 * bj], bv1 = bq[2 * bj + 1];
#pragma unroll
            for (int ai = 0; ai < 2; ++ai)
#pragma unroll
                for (int m = 0; m < 4; ++m) { const int row = u.pm * 256 + ai * 128 + wr * 64 + m * 16 + fr;
                    const f32x4 v0 = acc[ai][bj][m][0] * 0.03125f + bv0, v1 = acc[ai][bj][m][1] * 0.03125f + bv1;
                    u32x2 o; o.x = pk4_fp8(v0.x, v0.y, v0.z, v0.w); o.y = pk4_fp8(v1.x, v1.y, v1.z, v1.w);
                    *(u32x2*)(Y + (unsigned)(row * D + col)) = o;
                    __builtin_amdgcn_sched_barrier(0); } }
    }
};

struct MoeOrder1 {
    static constexpr bool GATHER = true;
    const char* H2; const char* W1T; const int* list; const LAS int* tstart; const LAS int* cnt; const LAS int* xs; int G, c;
    __device__ __forceinline__ bool next(int i, Unit& u) const {
        const int x = c & 7, j = i * (G >> 3) + (c >> 3); const int t = j >> 3;
        const int x1 = __builtin_amdgcn_readfirstlane(xs[1]), x2 = __builtin_amdgcn_readfirstlane(xs[2]), x3 = __builtin_amdgcn_readfirstlane(xs[3]), x4 = __builtin_amdgcn_readfirstlane(xs[4]);
        if (t >= x4) return false;
        const int jj = (t >= x3) ? 3 : ((t >= x2) ? 2 : ((t >= x1) ? 1 : 0)); const int base = (jj == 3) ? x3 : ((jj == 2) ? x2 : ((jj == 1) ? x1 : 0));
        const int e = x + 8 * jj;
        u.pm = __builtin_amdgcn_readfirstlane(tstart[e]) + (t - base); u.pn = j & 7; u.e = e;
        u.A = H2; u.B = W1T + ((size_t)e * 2048 + (size_t)u.pn * 256) * 1024; return true;
    }
    __device__ __forceinline__ int row_src(const Unit& u, int r) const {
        const int rank = (u.pm - tstart[u.e]) * 256 + r; return rank < cnt[u.e] ? list[u.e * T + rank] : 0;
    }
};
struct MoeOrder2 {
    static constexpr bool GATHER = false;
    const char* ACT; const char* W2T; const LAS int* tstart; const LAS int* xs; int G, c;
    __device__ __forceinline__ bool next(int i, Unit& u) const {
        const int x = c & 7, j = i * (G >> 3) + (c >> 3); const int t = j >> 2;
        const int x1 = __builtin_amdgcn_readfirstlane(xs[1]), x2 = __builtin_amdgcn_readfirstlane(xs[2]), x3 = __builtin_amdgcn_readfirstlane(xs[3]), x4 = __builtin_amdgcn_readfirstlane(xs[4]);
        if (t >= x4) return false;
        const int jj = (t >= x3) ? 3 : ((t >= x2) ? 2 : ((t >= x1) ? 1 : 0)); const int base = (jj == 3) ? x3 : ((jj == 2) ? x2 : ((jj == 1) ? x1 : 0));
        const int e = x + 8 * jj;
        u.pm = __builtin_amdgcn_readfirstlane(tstart[e]) + (t - base); u.pn = j & 3; u.e = e;
        u.A = ACT + (size_t)u.pm * 256 * 1024; u.B = W2T + ((size_t)e * 1024 + (size_t)u.pn * 256) * 1024; return true;
    }
    __device__ __forceinline__ int row_src(const Unit&, int) const { return 0; }
};

__device__ __forceinline__ void transpose_tile(const float* W, int K, int N, bf16_t* WT, int kb, int nb, unsigned char* smem, int tid) {
    float* tile = (float*)smem;
    const int k0 = 64 * kb, n0 = 256 * nb, n4 = tid & 63, kr = tid >> 6;
    f32x4 v[8];
#pragma unroll
    for (int i = 0; i < 8; ++i) { const int k = kr + 8 * i; v[i] = (n0 + 4 * n4 < N) ? *(const f32x4*)(W + (size_t)(k0 + k) * N + n0 + 4 * n4) : (f32x4){0.f, 0.f, 0.f, 0.f}; }
    __syncthreads();
#pragma unroll
    for (int i = 0; i < 8; ++i) { const int k = kr + 8 * i; *(f32x4*)(tile + k * 260 + ((4 * n4) ^ (8 * (k >> 3)))) = v[i]; }
    __syncthreads();
#pragma unroll
    for (int j = 0; j < 4; ++j) { const int c = tid + 512 * j, n = c >> 3, kc = c & 7; const float* src = tile + (8 * kc) * 260 + (n ^ (8 * kc));
        u32x4 o; o.x = pk2(src[0], src[260]); o.y = pk2(src[2 * 260], src[3 * 260]); o.z = pk2(src[4 * 260], src[5 * 260]); o.w = pk2(src[6 * 260], src[7 * 260]);
        *(u32x4*)(WT + (size_t)(n0 + n) * K + k0 + 8 * kc) = o; }
}
__device__ __forceinline__ void transpose_tile_fp8(const float* W, int K, int N, unsigned char* WT, int kb, int nb, float scale, unsigned char* smem, int tid) {
    float* tile = (float*)smem;
    const int k0 = 64 * kb, n0 = 256 * nb, n4 = tid & 63, kr = tid >> 6;
    f32x4 v[8];
#pragma unroll
    for (int i = 0; i < 8; ++i) { const int k = kr + 8 * i; v[i] = *(const f32x4*)(W + (size_t)(k0 + k) * N + n0 + 4 * n4) * scale; }
    __syncthreads();
#pragma unroll
    for (int i = 0; i < 8; ++i) { const int k = kr + 8 * i; *(f32x4*)(tile + k * 260 + ((4 * n4) ^ (8 * (k >> 3)))) = v[i]; }
    __syncthreads();
#pragma unroll
    for (int j = 0; j < 2; ++j) { const int c = tid + 512 * j, n = c >> 2, kc = c & 3;
        const float* s0 = tile + (16 * kc) * 260 + (n ^ (8 * (2 * kc))); const float* s1 = tile + (16 * kc + 8) * 260 + (n ^ (8 * (2 * kc + 1)));
        u32x4 o; o.x = pk4_fp8(s0[0], s0[260], s0[2 * 260], s0[3 * 260]); o.y = pk4_fp8(s0[4 * 260], s0[5 * 260], s0[6 * 260], s0[7 * 260]);
        o.z = pk4_fp8(s1[0], s1[260], s1[2 * 260], s1[3 * 260]); o.w = pk4_fp8(s1[4 * 260], s1[5 * 260], s1[6 * 260], s1[7 * 260]);
        *(u32x4*)(WT + (size_t)(n0 + n) * K + k0 + 16 * kc) = o; }
}
constexpr int TT_W1 = 128, TT_W2 = 64, TT_TOTAL = NE * TT_W1 + NE * TT_W2;
struct TTile { const float* src; unsigned char* dst; int N; };
__device__ __forceinline__ TTile tt_decode(const Params& P, int it, int n4, int kr) {
    TTile t;
    if (it < NE * TT_W1) { const int e = it >> 7, r = it & 127, kb = r >> 3, nb = r & 7; t.N = 2048;
        t.src = P.w1 + (size_t)e * D * 2048 + (size_t)(64 * kb + kr) * 2048 + 256 * nb + 4 * n4; t.dst = P.ws + WS_W1 + (size_t)e * 2048 * D + (size_t)(256 * nb) * D + 64 * kb; }
    else { const int i2 = it - NE * TT_W1, e = i2 >> 6, r = i2 & 63, kb = r >> 2, nb = r & 3; t.N = 1024;
        t.src = P.w2 + (size_t)e * DFF * D + (size_t)(64 * kb + kr) * 1024 + 256 * nb + 4 * n4; t.dst = P.ws + WS_W2 + (size_t)e * D * DFF + (size_t)(256 * nb) * DFF + 64 * kb; }
    return t;
}
__device__ __forceinline__ void late_transposes(const Params& P, unsigned char* smem, unsigned* qh, volatile LAS unsigned* misc, int tid) {
    float* tile = (float*)smem;
    const int n4 = tid & 63, kr = tid >> 6;
    __syncthreads();
    if (tid == 0) misc[8] = atomicAdd(qh, 1u);
    __syncthreads();
    int cur = (int)misc[8];
    if (cur >= TT_TOTAL) return;
    f32x4 v[8]; TTile tc = tt_decode(P, cur, n4, kr);
#pragma unroll
    for (int i = 0; i < 8; ++i) v[i] = *(const f32x4*)(tc.src + (size_t)(8 * i) * tc.N);
    for (;;) {
        if (tid == 0) misc[8] = atomicAdd(qh, 1u);
        __syncthreads();
        const int nxt = (int)misc[8];
#pragma unroll
        for (int i = 0; i < 8; ++i) { const int k = kr + 8 * i; *(f32x4*)(tile + k * 260 + ((4 * n4) ^ (8 * (k >> 3)))) = v[i] * 32.f; }
        TTile tn = tc;
        if (nxt < TT_TOTAL) { tn = tt_decode(P, nxt, n4, kr);
#pragma unroll
            for (int i = 0; i < 8; ++i) v[i] = *(const f32x4*)(tn.src + (size_t)(8 * i) * tn.N); }
        __syncthreads();
#pragma unroll
        for (int j = 0; j < 2; ++j) { const int c = tid + 512 * j, n = c >> 2, kc = c & 3;
            const float* s0 = tile + (16 * kc) * 260 + (n ^ (8 * (2 * kc))); const float* s1 = tile + (16 * kc + 8) * 260 + (n ^ (8 * (2 * kc + 1)));
            u32x4 o; o.x = pk4_fp8(s0[0], s0[260], s0[2 * 260], s0[3 * 260]); o.y = pk4_fp8(s0[4 * 260], s0[5 * 260], s0[6 * 260], s0[7 * 260]);
            o.z = pk4_fp8(s1[0], s1[260], s1[2 * 260], s1[3 * 260]); o.w = pk4_fp8(s1[4 * 260], s1[5 * 260], s1[6 * 260], s1[7 * 260]);
            *(u32x4*)(tc.dst + (size_t)n * 1024 + 16 * kc) = o; }
        if (nxt >= TT_TOTAL) break;
        cur = nxt; tc = tn;
    }
}

__device__ __forceinline__ void phase0(const Params& P, unsigned char* smem) {
    unsigned char* ws = P.ws;
    const int tid_ = opaque_tid(), lane = tid_ & 63, wave = tid_ >> 6, gw = blockIdx.x * NWAVES + wave, ngw = gridDim.x * NWAVES;
    float* slab = (float*)(smem + 73728);
    for (int i = tid_; i < 1024 * 8; i += NTHREADS) { const int k = i >> 3, c = i & 7, pos = (k & 3) * 256 + (k >> 2); slab[(c >> 2) * 4096 + pos * 4 + (c & 3)] = P.w_in[(size_t)k * DIN + 2048 + c]; }
    __syncthreads();
    bf16_t* H = (bf16_t*)(ws + WS_H); float* AB = (float*)(ws + WS_AB);
    f32x4 vnx[4], nw[4];
#pragma unroll
    for (int j = 0; j < 4; ++j) nw[j] = *((const f32x4*)P.norm_mix_w + lane + 64 * j);
    if (gw < T) {
#pragma unroll
        for (int j = 0; j < 4; ++j) vnx[j] = *((const f32x4*)(P.x + (size_t)gw * D) + lane + 64 * j); }
    for (int row = gw; row < T; row += ngw) {
        f32x4 v[4]; float ss = 0.f;
#pragma unroll
        for (int j = 0; j < 4; ++j) { v[j] = vnx[j]; ss += v[j].x * v[j].x + v[j].y * v[j].y + v[j].z * v[j].z + v[j].w * v[j].w; }
        if (row + ngw < T) {
#pragma unroll
            for (int j = 0; j < 4; ++j) vnx[j] = *((const f32x4*)(P.x + (size_t)(row + ngw) * D) + lane + 64 * j); }
        const float rstd = rsqrtf(wave_sum(ss) * (1.f / D) + EPS);
        float acc[8];
#pragma unroll
        for (int c = 0; c < 8; ++c) acc[c] = 0.f;
#pragma unroll
        for (int j = 0; j < 4; ++j) {
            v[j] = v[j] * rstd * nw[j];
            u32x2 o; o.x = pk2(v[j].x, v[j].y); o.y = pk2(v[j].z, v[j].w);
            *((u32x2*)(H + (size_t)row * D) + lane + 64 * j) = o;
#pragma unroll
            for (int i = 0; i < 4; ++i) { const float* sw = slab + (size_t)(i * 256 + lane + 64 * j) * 4; const f32x4 w0 = *(const f32x4*)sw, w1 = *(const f32x4*)(sw + 4096); const float hv = v[j][i];
                acc[0] += hv * w0.x; acc[1] += hv * w0.y; acc[2] += hv * w0.z; acc[3] += hv * w0.w; acc[4] += hv * w1.x; acc[5] += hv * w1.y; acc[6] += hv * w1.z; acc[7] += hv * w1.w; }
        }
#pragma unroll
        for (int c = 0; c < 8; ++c) acc[c] = wave_sum(acc[c]);
        if (lane == 0) { *(f32x4*)(AB + (size_t)row * 8) = (f32x4){acc[0], acc[1], acc[2], acc[3]}; *(f32x4*)(AB + (size_t)row * 8 + 4) = (f32x4){acc[4], acc[5], acc[6], acc[7]}; }
    }
    __syncthreads();
    for (int it = blockIdx.x; it < 274; it += gridDim.x) {
        if (it >= 210) transpose_tile(P.w_out, D, D, (bf16_t*)(ws + WS_WOUT), (it - 210) >> 2, (it - 210) & 3, smem, tid_);
        else if (it < 176) transpose_tile(P.w_in, D, DIN, (bf16_t*)(ws + WS_WIN), it / 11, it % 11, smem, tid_);
        else if (it < 194) transpose_tile(P.w_uq, QL, 768, (bf16_t*)(ws + WS_WUQ), (it - 176) / 3, (it - 176) % 3, smem, tid_);
        else transpose_tile(P.w_ukv, KVL, 1024, (bf16_t*)(ws + WS_WUKV), (it - 194) >> 2, (it - 194) & 3, smem, tid_);
    }
}

__constant__ float c_inv_freq[16] = {1.0f, 0.5623413324356079f, 0.3162277638912201f, 0.17782793939113617f, 0.10000000149011612f, 0.05623413249850273f, 0.03162277489900589f,
    0.017782794311642647f, 0.009999999776482582f, 0.005623413249850273f, 0.003162277629598975f, 0.0017782794311642647f, 0.0010000000474974513f, 0.000562341301701963f,
    0.0003162277571391314f, 0.00017782794020604342f};
__device__ __forceinline__ void phase2a(const Params& P) {
    unsigned char* ws = P.ws;
    const int tid_ = opaque_tid(), lane = tid_ & 63, gw = blockIdx.x * NWAVES + (tid_ >> 6), ngw = gridDim.x * NWAVES;
    const bf16_t* PROJ = (const bf16_t*)(ws + WS_PROJ); bf16_t* CQN = (bf16_t*)(ws + WS_CQN); bf16_t* CKVN = (bf16_t*)(ws + WS_CKVN);
    bf16_t* Kp = (bf16_t*)(ws + WS_K); float* tab = (float*)(ws + WS_TAB);
    f32x2v qw[3], kw[2];
#pragma unroll
    for (int j = 0; j < 3; ++j) qw[j] = *(const f32x2v*)(P.q_norm_w + 2 * (lane + 64 * j));
#pragma unroll
    for (int j = 0; j < 2; ++j) kw[j] = *(const f32x2v*)(P.kv_norm_w + 2 * (lane + 64 * j));
    unsigned nq[3], nk[2]; bf16_t nx1 = 0, nx2 = 0; int npos = 0;
    auto ldrow = [&](int row) { const bf16_t* pr = PROJ + (size_t)row * DINP;
#pragma unroll
        for (int j = 0; j < 3; ++j) nq[j] = *(const unsigned*)(pr + C_CQ + 2 * (lane + 64 * j));
#pragma unroll
        for (int j = 0; j < 2; ++j) nk[j] = *(const unsigned*)(pr + C_CKV + 2 * (lane + 64 * j));
        nx1 = pr[C_KR + (lane & 15)]; nx2 = pr[C_KR + 16 + (lane & 15)]; npos = P.pos[row]; };
    if (gw < T) ldrow(gw);
    for (int row = gw; row < T; row += ngw) {
        const int b = row / SEQ, s = row % SEQ;
        unsigned aq[3], ak[2]; const bf16_t cx1 = nx1, cx2 = nx2; const int cpos = npos;
#pragma unroll
        for (int j = 0; j < 3; ++j) aq[j] = nq[j];
#pragma unroll
        for (int j = 0; j < 2; ++j) ak[j] = nk[j];
        if (row + ngw < T) ldrow(row + ngw);
        {
            float ss = 0.f;
#pragma unroll
            for (int j = 0; j < 3; ++j) { const float lo = bflo(aq[j]), hi = bfhi(aq[j]); ss += lo * lo + hi * hi; }
            const float rstd = rsqrtf(wave_sum(ss) * (1.f / QL) + EPS);
#pragma unroll
            for (int j = 0; j < 3; ++j) { const int idx = 2 * (lane + 64 * j); *(unsigned*)(CQN + (size_t)row * QL + idx) = pk2(bflo(aq[j]) * rstd * qw[j].x, bfhi(aq[j]) * rstd * qw[j].y); }
        }
        {
            float ss = 0.f;
#pragma unroll
            for (int j = 0; j < 2; ++j) { const float lo = bflo(ak[j]), hi = bfhi(ak[j]); ss += lo * lo + hi * hi; }
            const float rstd = rsqrtf(wave_sum(ss) * (1.f / KVL) + EPS);
#pragma unroll
            for (int j = 0; j < 2; ++j) { const int idx = 2 * (lane + 64 * j); *(unsigned*)(CKVN + (size_t)row * KVL + idx) = pk2(bflo(ak[j]) * rstd * kw[j].x, bfhi(ak[j]) * rstd * kw[j].y); }
        }
        if (lane < 16) {
            const float x1 = bf1(cx1), x2 = bf1(cx2);
            const float ang = (float)cpos * c_inv_freq[lane];
            double tt = (double)ang * 0.15915494309189535; tt -= floor(tt);
            if (tt > 0.5) tt -= 1.0;
            const float ar = (float)(tt * 6.283185307179586);
            const float cs = __cosf(ar), sn = __sinf(ar);
            tab[(size_t)row * 32 + lane] = cs; tab[(size_t)row * 32 + 16 + lane] = sn;
            const bf16_t o1 = (bf16_t)f2bf(x1 * cs - x2 * sn), o2 = (bf16_t)f2bf(x2 * cs + x1 * sn);
#pragma unroll
            for (int h = 0; h < MH; ++h) { bf16_t* kp = Kp + ((size_t)(b * MH + h) * SEQ + s) * DQK + 64; kp[lane] = o1; kp[16 + lane] = o2; }
        }
    }
}

__device__ __forceinline__ float softplusf_(float x) { return fmaxf(x, 0.f) + log1pf(__expf(-fabsf(x))); }
__device__ __forceinline__ void prep_conv_load(const Params& P, int item, int tid, u32x4 (&raw)[2][7]) {
    const int n = item % NCH, hh = (item / NCH) % GH, b = item / (NCH * GH);
    const bf16_t* PROJ = (const bf16_t*)(P.ws + WS_PROJ);
#pragma unroll
    for (int p = 0; p < 2; ++p) { if (p == 1 && tid >= 256) break;
        const int q = tid + 512 * p, rg = q / 48, c8 = q % 48, which = c8 >> 4, cc = (c8 & 15) * 8, gc = which * 512 + hh * 128 + cc;
#pragma unroll
        for (int i = 0; i < 7; ++i) { const int t = 64 * n + 4 * rg - 3 + i;
            raw[p][i] = (t >= 0) ? *(const u32x4*)(PROJ + (size_t)(b * SEQ + t) * DINP + gc) : (u32x4){0u, 0u, 0u, 0u}; } }
}
__device__ __forceinline__ void gdn_prep_item(const Params& P, unsigned char* smem, int item, int next_item, u32x4 (&raw)[2][7]) {
    unsigned char* ws = P.ws;
    const int tid = opaque_tid(), wave = tid >> 6, lane = tid & 63;
    const int n = item % NCH, hh = (item / NCH) % GH, b = item / (NCH * GH);
    const bf16_t* PROJ = (const bf16_t*)(ws + WS_PROJ); const float* AB = (const float*)(ws + WS_AB);
    unsigned char* gp = ws + WS_GP + (size_t)item * GP_ITEM;
    float* Ug = (float*)(gp + GP_U); bf16_t* Wg = (bf16_t*)(gp + GP_W); bf16_t* QDg = (bf16_t*)(gp + GP_QD); bf16_t* KDTg = (bf16_t*)(gp + GP_KDT); bf16_t* QKg = (bf16_t*)(gp + GP_QK);
    float* qs = (float*)smem; float* ks = qs + 64 * 132; float* vs = ks + 64 * 132; float* Am = vs + 64 * 132;
    float* sbeta = Am + 64 * 68; float* sG = sbeta + 64; float* seG = sG + 64; float* sekd = seG + 64;
    __syncthreads();
    float ab_a = 0.f, ab_b = 0.f, ab_al = 0.f, ab_dt = 0.f;
    if (tid >= 448) { const size_t tok = (size_t)b * SEQ + 64 * n + lane; ab_a = AB[tok * 8 + hh]; ab_b = AB[tok * 8 + 4 + hh]; ab_al = P.a_log[hh]; ab_dt = P.dt_bias[hh]; }
#pragma unroll
    for (int p = 0; p < 2; ++p) { if (p == 1 && tid >= 256) break;
        const int q = tid + 512 * p, rg = q / 48, c8 = q % 48, which = c8 >> 4, cc = (c8 & 15) * 8, gc = which * 512 + hh * 128 + cc;
        float wv[4][8];
#pragma unroll
        for (int j = 0; j < 4; ++j) { const f32x4 a = *(const f32x4*)(P.conv_w + j * 1536 + gc), c = *(const f32x4*)(P.conv_w + j * 1536 + gc + 4);
            wv[j][0] = a.x; wv[j][1] = a.y; wv[j][2] = a.z; wv[j][3] = a.w; wv[j][4] = c.x; wv[j][5] = c.y; wv[j][6] = c.z; wv[j][7] = c.w; }
        float* dst = qs + which * (64 * 132) + (4 * rg) * 132 + cc;
#pragma unroll
        for (int rr = 0; rr < 4; ++rr) {
            float y[8];
#pragma unroll
            for (int d = 0; d < 4; ++d) { float ya = 0.f, yb = 0.f;
#pragma unroll
                for (int j = 0; j < 4; ++j) { const unsigned u = raw[p][rr + j][d]; ya += wv[j][2 * d] * bflo(u); yb += wv[j][2 * d + 1] * bfhi(u); }
                y[2 * d] = ya * sigmoidf_(ya); y[2 * d + 1] = yb * sigmoidf_(yb); }
            const float ss = row16_sum(y[0] * y[0] + y[1] * y[1] + y[2] * y[2] + y[3] * y[3] + y[4] * y[4] + y[5] * y[5] + y[6] * y[6] + y[7] * y[7]);
            if (which < 2) {
                const float sc = rsqrtf(ss + EPS) * (which == 0 ? 0.08838834764831845f : 1.f);
#pragma unroll
                for (int d = 0; d < 8; ++d) y[d] *= sc;
                u32x4 h, l;
                h.x = pk2(y[0], y[1]); h.y = pk2(y[2], y[3]); h.z = pk2(y[4], y[5]); h.w = pk2(y[6], y[7]);
                l.x = pk2(y[0] - bflo(h.x), y[1] - bfhi(h.x)); l.y = pk2(y[2] - bflo(h.y), y[3] - bfhi(h.y)); l.z = pk2(y[4] - bflo(h.z), y[5] - bfhi(h.z)); l.w = pk2(y[6] - bflo(h.w), y[7] - bfhi(h.w));
                const int r = 4 * rg + rr; unsigned char* tp = (unsigned char*)(qs + which * (64 * 132)) + r * 256 + ((((c8 & 15)) ^ (r & 15)) * 16);
                *(u32x4*)tp = h; *(u32x4*)(tp + 16384) = l;
            } else { *(f32x4*)(dst + rr * 132) = (f32x4){y[0], y[1], y[2], y[3]}; *(f32x4*)(dst + rr * 132 + 4) = (f32x4){y[4], y[5], y[6], y[7]}; }
        }
    }
    if (next_item >= 0) prep_conv_load(P, next_item, tid, raw);
    if (tid >= 448) {
        const int r = lane;
        const float a = ab_a, bb = ab_b;
        const float g = -__expf(ab_al) * softplusf_(a + ab_dt);
        float G = g;
        G = wave_scan(G);
        const float Gl = __builtin_amdgcn_readlane(G, 63);
        sbeta[r] = sigmoidf_(bb); sG[r] = G; seG[r] = __expf(G); sekd[r] = __expf(Gl - G);
        if (lane == 0) ((float*)(ws + WS_GT))[item] = __expf(Gl);
    }
    __syncthreads();
    for (int idx = tid; idx < 6 * 256; idx += NTHREADS) {
        const int u = idx >> 8, w = idx & 255; const int I = (u < 3) ? 0 : (u < 5 ? 1 : 2), J = (u < 3) ? u + 1 : (u < 5 ? u - 1 : 3);
        QKg[(16 * I + (w >> 4)) * 64 + perm32k(16 * J + (w & 15))] = 0;
    }
    for (int job = wave; job < 20; job += NWAVES) {
        const int kind = job / 10, p = job % 10; const int I = (p < 1) ? 0 : (p < 3 ? 1 : (p < 6 ? 2 : 3)); const int J = p - (I * (I + 1)) / 2;
        const int ra = 16 * I + (lane & 15), rb = 16 * J + (lane & 15), kg = lane >> 4;
        const unsigned char* Ab = (const unsigned char*)(kind ? qs : ks) + ra * 256; const unsigned char* Bb = (const unsigned char*)ks + rb * 256;
        bf16x8 ah[4], al[4], bh[4], bl[4];
#pragma unroll
        for (int s4 = 0; s4 < 4; ++s4) { const int ca = ((4 * s4 + kg) ^ (ra & 15)) * 16, cb = ((4 * s4 + kg) ^ (rb & 15)) * 16;
            ah[s4] = *(const bf16x8*)(Ab + ca); al[s4] = *(const bf16x8*)(Ab + 16384 + ca); bh[s4] = *(const bf16x8*)(Bb + cb); bl[s4] = *(const bf16x8*)(Bb + 16384 + cb); }
        f32x4 acc = {0.f, 0.f, 0.f, 0.f}, acc2 = {0.f, 0.f, 0.f, 0.f};
#pragma unroll
        for (int s4 = 0; s4 < 4; ++s4) {
            acc2 = __builtin_amdgcn_mfma_f32_16x16x32_bf16(ah[s4], bl[s4], acc2, 0, 0, 0);
            acc2 = __builtin_amdgcn_mfma_f32_16x16x32_bf16(al[s4], bh[s4], acc2, 0, 0, 0);
            acc = __builtin_amdgcn_mfma_f32_16x16x32_bf16(ah[s4], bh[s4], acc, 0, 0, 0); }
        acc = acc + acc2;
        const int j = 16 * J + (lane & 15), ib = 16 * I + 4 * (lane >> 4);
        const float sGj = sG[j]; const f32x4 sGi = *(const f32x4*)(sG + ib), sbi = *(const f32x4*)(sbeta + ib);
#pragma unroll
        for (int r = 0; r < 4; ++r) { const int i = ib + r;
            const float dec = __expf(fminf(sGi[r] - sGj, 0.f));
            if (kind == 0) Am[i * 68 + j] = (i > j) ? sbi[r] * acc[r] * dec : 0.f;
            else QKg[i * 64 + perm32k(j)] = (bf16_t)f2bf((i >= j) ? acc[r] * dec : 0.f); }
    }
    __syncthreads();
    if (wave < 4) {
        if (lane < 16) {
            const int i0_ = 16 * wave, c = lane; float Tc[16];
            const LAS float* AmL = (const LAS float*)Am + i0_ * 68 + i0_; asm volatile("" : "+v"(AmL));
            f32x4 Av[16][4];
#pragma unroll
            for (int i = 1; i < 16; ++i)
#pragma unroll
                for (int ch = 0; ch <= (i - 1) / 4; ++ch) Av[i][ch] = *(const LAS f32x4*)(AmL + i * 68 + 4 * ch);
#pragma unroll
            for (int i = 0; i < 16; ++i) { float a = (i == c) ? 1.f : 0.f;
#pragma unroll
                for (int j = 0; j < i; ++j) a -= Av[i][j >> 2][j & 3] * Tc[j];
                Tc[i] = a; asm volatile("" : "+v"(Tc[i])); }
#pragma unroll
            for (int i = 0; i < 16; ++i) Am[(i0_ + i) * 68 + i0_ + c] = Tc[i];
        }
    } else {
        const int t2 = tid - 256;
#pragma unroll
        for (int it = 0; it < 8; ++it) { const int idx = t2 + 256 * it, i = idx >> 5, d4 = (idx & 31) * 4;
            const unsigned char* qp = (const unsigned char*)qs + i * 256 + (((d4 >> 3) ^ (i & 15)) * 16) + ((d4 >> 2) & 1) * 8;
            const u32x2 qh = *(const u32x2*)qp, ql_ = *(const u32x2*)(qp + 16384); const float sg = seG[i];
            u32x2 o; o.x = pk2((bflo(qh.x) + bflo(ql_.x)) * sg, (bfhi(qh.x) + bfhi(ql_.x)) * sg); o.y = pk2((bflo(qh.y) + bflo(ql_.y)) * sg, (bfhi(qh.y) + bfhi(ql_.y)) * sg);
            *(u32x2*)(QDg + i * 128 + perm32k(d4)) = o; }
#pragma unroll
        for (int it = 0; it < 4; ++it) { const int idx = t2 + 256 * it, d2 = (idx & 63) * 2, c4 = (idx >> 6) * 4;
            const f32x4 sk = *(const f32x4*)(sekd + c4);
            float ka[4], kb_[4];
#pragma unroll
            for (int q = 0; q < 4; ++q) { const int rr = c4 + q; const unsigned char* kp = (const unsigned char*)ks + rr * 256 + (((d2 >> 3) ^ (rr & 15)) * 16) + (d2 & 7) * 2;
                const unsigned uh = *(const unsigned*)kp, ul = *(const unsigned*)(kp + 16384); ka[q] = bflo(uh) + bflo(ul); kb_[q] = bfhi(uh) + bfhi(ul); }
            u32x2 o; o.x = pk2(ka[0] * sk.x, ka[1] * sk.y); o.y = pk2(ka[2] * sk.z, ka[3] * sk.w);
            *(u32x2*)(KDTg + d2 * 64 + perm32k(c4)) = o;
            o.x = pk2(kb_[0] * sk.x, kb_[1] * sk.y); o.y = pk2(kb_[2] * sk.z, kb_[3] * sk.w);
            *(u32x2*)(KDTg + (d2 + 1) * 64 + perm32k(c4)) = o; }
    }
    __syncthreads();
#pragma unroll
    for (int it = 0; it < 4; ++it) { const int idx = tid + NTHREADS * it, i = idx >> 5, c4 = (idx & 31) * 4; const float bi = sbeta[i], bw = bi * seG[i];
        const unsigned char* kp = (const unsigned char*)ks + i * 256 + (((c4 >> 3) ^ (i & 15)) * 16) + ((c4 >> 2) & 1) * 8;
        const u32x2 kh = *(const u32x2*)kp, kl = *(const u32x2*)(kp + 16384);
        *(f32x4*)(qs + i * 132 + c4) = (f32x4){(bflo(kh.x) + bflo(kl.x)) * bw, (bfhi(kh.x) + bfhi(kl.x)) * bw, (bflo(kh.y) + bflo(kl.y)) * bw, (bfhi(kh.y) + bfhi(kl.y)) * bw}; }
    __syncthreads();
    {
        const int rl = lane & 15, kk = lane >> 4;
        float* arr0 = (wave < 4 ? vs : qs) + ((2 * wave) & 7) * 16; float* arr1 = arr0 + 16;
        unsigned char* xt0 = (unsigned char*)ks + (2 * wave) * 2048; unsigned char* xt1 = xt0 + 2048;
#pragma unroll
        for (int i = 0; i < 4; ++i) {
            f32x4 acc0, acc1;
#pragma unroll
            for (int r = 0; r < 4; ++r) { acc0[r] = arr0[(16 * i + 4 * kk + r) * 132 + rl]; acc1[r] = arr1[(16 * i + 4 * kk + r) * 132 + rl]; }
            if (wave < 4) { const f32x4 bt = *(const f32x4*)(sbeta + 16 * i + 4 * kk); acc0 = acc0 * bt; acc1 = acc1 * bt; }
            if (i > 0) {
#pragma unroll
                for (int s2 = 0; s2 < ((i == 3) ? 2 : 1); ++s2) { const int kb = 32 * s2 + 8 * kk, ch = ((4 * s2 + kk) ^ (rl & 7)) * 16;
                    bf16x8 af = {0, 0, 0, 0, 0, 0, 0, 0};
                    if (kb < 16 * i) { const float* ap = Am + (16 * i + rl) * 68 + kb; const f32x4 a0 = *(const f32x4*)ap, a1 = *(const f32x4*)(ap + 4);
                        af = pack8((f32x4){-a0.x, -a0.y, -a0.z, -a0.w}, (f32x4){-a1.x, -a1.y, -a1.z, -a1.w}); }
                    const bf16x8 b0 = *(const bf16x8*)(xt0 + rl * 128 + ch), b1 = *(const bf16x8*)(xt1 + rl * 128 + ch);
                    acc0 = __builtin_amdgcn_mfma_f32_16x16x32_bf16(af, b0, acc0, 0, 0, 0);
                    acc1 = __builtin_amdgcn_mfma_f32_16x16x32_bf16(af, b1, acc1, 0, 0, 0); } }
#pragma unroll
            for (int r = 0; r < 4; ++r) { arr0[(16 * i + 4 * kk + r) * 132 + rl] = acc0[r]; arr1[(16 * i + 4 * kk + r) * 132 + rl] = acc1[r]; }
            asm volatile("s_waitcnt lgkmcnt(0)" ::: "memory");
            f32x4 o0 = {0.f, 0.f, 0.f, 0.f}, o1 = {0.f, 0.f, 0.f, 0.f};
#pragma unroll
            for (int sx = 0; sx < 4; ++sx) { const float a = Am[(16 * i + rl) * 68 + 16 * i + 4 * sx + kk];
                o0 = __builtin_amdgcn_mfma_f32_16x16x4f32(a, arr0[(16 * i + 4 * sx + kk) * 132 + rl], o0, 0, 0, 0);
                o1 = __builtin_amdgcn_mfma_f32_16x16x4f32(a, arr1[(16 * i + 4 * sx + kk) * 132 + rl], o1, 0, 0, 0); }
#pragma unroll
            for (int r = 0; r < 4; ++r) { arr0[(16 * i + 4 * kk + r) * 132 + rl] = o0[r]; arr1[(16 * i + 4 * kk + r) * 132 + rl] = o1[r]; }
            if (i < 3) { const int xo = rl * 128 + (((2 * i + (kk >> 1)) ^ (rl & 7)) * 16) + (kk & 1) * 8;
                u32x2 p0, p1; p0.x = pk2(o0[0], o0[1]); p0.y = pk2(o0[2], o0[3]); p1.x = pk2(o1[0], o1[1]); p1.y = pk2(o1[2], o1[3]);
                *(u32x2*)(xt0 + xo) = p0; *(u32x2*)(xt1 + xo) = p1; }
            asm volatile("s_waitcnt lgkmcnt(0)" ::: "memory");
        }
    }
    __syncthreads();
#pragma unroll
    for (int it = 0; it < 4; ++it) { const int idx = tid + NTHREADS * it, e = idx & 15, g = (idx >> 4) & 3, m = (idx >> 6) & 3, w = idx >> 8; const float* src = vs + (16 * m + 4 * g) * 132 + 16 * w + e;
        u32x2 o; o.x = pk2(src[0], src[132]); o.y = pk2(src[2 * 132], src[3 * 132]); ((u32x2*)Ug)[idx] = o; }
#pragma unroll
    for (int it = 0; it < 4; ++it) { const int idx = tid + NTHREADS * it, i = idx >> 5, d4 = (idx & 31) * 4; const f32x4 v = *(const f32x4*)(qs + i * 132 + d4);
        u32x2 o; o.x = pk2(-v.x, -v.y); o.y = pk2(-v.z, -v.w); *(u32x2*)(Wg + i * 128 + perm32k(d4)) = o; }
}

__device__ __forceinline__ void gdn_scan(const Params& P, unsigned char* smem, int bh) {
    unsigned char* ws = P.ws;
    const int tid = opaque_tid(), wave = tid >> 6, lane = tid & 63, e = lane & 15, g = lane >> 4;
    const float* GT = (const float*)(ws + WS_GT);
    constexpr int BUF = 36864, OW = 0, OKD = 18432;
    f32x4 S[8];
#pragma unroll
    for (int t = 0; t < 8; ++t) S[t] = (f32x4){0.f, 0.f, 0.f, 0.f};
    u32x4 st[2][4]; u32x2 un[2][4]; float gtn[2];
#define SCAN_GLOAD(p, n) do { const unsigned char* gp_ = ws + WS_GP + (size_t)(bh * NCH + (n)) * GP_ITEM; \
        _Pragma("unroll") for (int k = 0; k < 2; ++k) st[p][k] = *(const u32x4*)(gp_ + GP_W + (size_t)(tid + 512 * k) * 16); \
        _Pragma("unroll") for (int k = 0; k < 2; ++k) st[p][2 + k] = *(const u32x4*)(gp_ + GP_KDT + (size_t)(tid + 512 * k) * 16); \
        const u32x2* ug_ = (const u32x2*)(gp_ + GP_U) + wave * 256 + lane; \
        _Pragma("unroll") for (int m = 0; m < 4; ++m) un[p][m] = ug_[m * 64]; \
        gtn[p] = GT[bh * NCH + (n)]; } while (0)
#define SCAN_LWRITE(p, buf) do { unsigned char* L_ = smem + (buf) * BUF; \
        _Pragma("unroll") for (int k = 0; k < 2; ++k) { const int c = tid + 512 * k; *(u32x4*)(L_ + OW + (c >> 4) * 288 + (c & 15) * 16) = st[p][k]; } \
        _Pragma("unroll") for (int k = 0; k < 2; ++k) { const int c = tid + 512 * k; *(u32x4*)(L_ + OKD + (c >> 3) * 144 + (c & 7) * 16) = st[p][2 + k]; } } while (0)
    __syncthreads();
    SCAN_GLOAD(0, 0); SCAN_LWRITE(0, 0); SCAN_GLOAD(1, 1);
    __syncthreads();
    for (int n2 = 0; n2 < NCH; n2 += 2) {
#pragma unroll
      for (int p = 0; p < 2; ++p) {
        const int n = n2 + p;
        f32x4 av[4];
#pragma unroll
        for (int m = 0; m < 4; ++m) av[m] = (f32x4){bflo(un[p][m].x), bfhi(un[p][m].x), bflo(un[p][m].y), bfhi(un[p][m].y)};
        const float gt = gtn[p];
        if (n + 2 < NCH) SCAN_GLOAD(p, n + 2);
        const unsigned char* L = smem + p * BUF;
        bf16x8 Sb[4];
#pragma unroll
        for (int s = 0; s < 4; ++s) Sb[s] = pack8(S[2 * s], S[2 * s + 1]);
        {
            bf16x8* sb = (bf16x8*)(ws + WS_SB) + ((size_t)(bh * NCH + n) * 8 + wave) * 256 + lane;
#pragma unroll
            for (int s = 0; s < 4; ++s) sb[s * 64] = Sb[s];
        }
#pragma unroll
        for (int s = 0; s < 4; ++s)
#pragma unroll
            for (int m = 0; m < 4; ++m) {
                const bf16x8 wf = *(const bf16x8*)(L + OW + (16 * m + e) * 288 + (32 * s + 8 * g) * 2);
                av[m] = __builtin_amdgcn_mfma_f32_16x16x32_bf16(wf, Sb[s], av[m], 0, 0, 0);
            }
        bf16x8 Vb[2];
#pragma unroll
        for (int s = 0; s < 2; ++s) Vb[s] = pack8(av[2 * s], av[2 * s + 1]);
#pragma unroll
        for (int t = 0; t < 8; ++t) { S[t] = S[t] * gt;
#pragma unroll
            for (int s = 0; s < 2; ++s) {
                const bf16x8 df = *(const bf16x8*)(L + OKD + (16 * t + e) * 144 + (32 * s + 8 * g) * 2);
                S[t] = __builtin_amdgcn_mfma_f32_16x16x32_bf16(df, Vb[s], S[t], 0, 0, 0);
            } }
        if (n + 1 < NCH) SCAN_LWRITE(p ^ 1, p ^ 1);
        __syncthreads();
      }
    }
#undef SCAN_GLOAD
#undef SCAN_LWRITE
}

struct GdnOutRegs { u32x4 st[5]; bf16x8 Sb[4]; u32x2 un[4]; };
__device__ __forceinline__ void gdn_out_load(const Params& P, int item, int tid, GdnOutRegs& R) {
    unsigned char* ws = P.ws; const int wave = tid >> 6, lane = tid & 63;
    const unsigned char* gp = ws + WS_GP + (size_t)item * GP_ITEM;
#pragma unroll
    for (int k = 0; k < 2; ++k) R.st[k] = *(const u32x4*)(gp + GP_W + (size_t)(tid + 512 * k) * 16);
#pragma unroll
    for (int k = 0; k < 2; ++k) R.st[2 + k] = *(const u32x4*)(gp + GP_QD + (size_t)(tid + 512 * k) * 16);
    R.st[4] = *(const u32x4*)(gp + GP_QK + (size_t)tid * 16);
    const bf16x8* sb = (const bf16x8*)(ws + WS_SB) + ((size_t)item * 8 + wave) * 256 + lane;
#pragma unroll
    for (int s = 0; s < 4; ++s) R.Sb[s] = sb[s * 64];
    const u32x2* ug = (const u32x2*)(gp + GP_U) + wave * 256 + lane;
#pragma unroll
    for (int m = 0; m < 4; ++m) R.un[m] = ug[m * 64];
}
__device__ __forceinline__ void gdn_out_item(const Params& P, unsigned char* smem, int item, int next_item, GdnOutRegs& R) {
    unsigned char* ws = P.ws;
    const int tid = opaque_tid(), wave = tid >> 6, lane = tid & 63, e = lane & 15, g = lane >> 4;
    const int n = item % NCH, hh = (item / NCH) % GH, b = item / (NCH * GH);
    constexpr int OW = 0, OQD = 18432, OQK = 36864, OSS = 46080, ORS = OSS + 2048, OT = 49152;
    float* ssq = (float*)(smem + OSS); float* rs = (float*)(smem + ORS);
    u32x4 st[5]; bf16x8 Sb[4]; u32x2 un[4];
#pragma unroll
    for (int k = 0; k < 5; ++k) st[k] = R.st[k];
#pragma unroll
    for (int k = 0; k < 4; ++k) { Sb[k] = R.Sb[k]; un[k] = R.un[k]; }
    __syncthreads();
#pragma unroll
    for (int k = 0; k < 2; ++k) { const int c = tid + 512 * k; *(u32x4*)(smem + OW + (c >> 4) * 288 + (c & 15) * 16) = st[k]; }
#pragma unroll
    for (int k = 0; k < 2; ++k) { const int c = tid + 512 * k; *(u32x4*)(smem + OQD + (c >> 4) * 288 + (c & 15) * 16) = st[2 + k]; }
    { const int c = tid; *(u32x4*)(smem + OQK + (c >> 3) * 144 + (c & 7) * 16) = st[4]; }
    __syncthreads();
    if (next_item >= 0) gdn_out_load(P, next_item, tid, R);
    f32x4 av[4], ao[4];
#pragma unroll
    for (int m = 0; m < 4; ++m) { av[m] = (f32x4){bflo(un[m].x), bfhi(un[m].x), bflo(un[m].y), bfhi(un[m].y)}; ao[m] = (f32x4){0.f, 0.f, 0.f, 0.f}; }
#pragma unroll
    for (int s = 0; s < 4; ++s)
#pragma unroll
        for (int m = 0; m < 4; ++m) {
            const bf16x8 wf = *(const bf16x8*)(smem + OW + (16 * m + e) * 288 + (32 * s + 8 * g) * 2);
            const bf16x8 qf = *(const bf16x8*)(smem + OQD + (16 * m + e) * 288 + (32 * s + 8 * g) * 2);
            av[m] = __builtin_amdgcn_mfma_f32_16x16x32_bf16(wf, Sb[s], av[m], 0, 0, 0);
            ao[m] = __builtin_amdgcn_mfma_f32_16x16x32_bf16(qf, Sb[s], ao[m], 0, 0, 0);
        }
    bf16x8 Vb[2];
#pragma unroll
    for (int s = 0; s < 2; ++s) Vb[s] = pack8(av[2 * s], av[2 * s + 1]);
#pragma unroll
    for (int m = 0; m < 4; ++m)
#pragma unroll
        for (int s = 0; s < 2; ++s) {
            const bf16x8 kf = *(const bf16x8*)(smem + OQK + (16 * m + e) * 144 + (32 * s + 8 * g) * 2);
            ao[m] = __builtin_amdgcn_mfma_f32_16x16x32_bf16(kf, Vb[s], ao[m], 0, 0, 0);
        }
#pragma unroll
    for (int m = 0; m < 4; ++m)
#pragma unroll
        for (int r = 0; r < 4; ++r) { float q = ao[m][r] * ao[m][r];
            q = row16_sum(q);
            if (e == 0) ssq[wave * 64 + 16 * m + 4 * g + r] = q;
            *(bf16_t*)(smem + OT + (16 * m + 4 * g + r) * 272 + (16 * wave + e) * 2) = (bf16_t)f2bf(ao[m][r]); }
    __syncthreads();
    if (tid < 64) { float q = 0.f;
#pragma unroll
        for (int w = 0; w < 8; ++w) q += ssq[w * 64 + tid];
        rs[tid] = rsqrtf(q * (1.f / 128.f) + EPS); }
    __syncthreads();
    {
        const int row = tid >> 3, seg = tid & 7; const size_t tok = (size_t)b * SEQ + 64 * n + row;
        const u32x4* tp = (const u32x4*)(smem + OT + row * 272 + seg * 32);
        const u32x4 o0 = tp[0], o1 = tp[1];
        const u32x4* zp = (const u32x4*)((const bf16_t*)(ws + WS_PROJ) + tok * DINP + C_Z + hh * 128 + seg * 16);
        const u32x4 z0 = zp[0], z1 = zp[1];
        const float r_ = rs[row]; const float* gwp = P.gdn_norm_w + seg * 16;
        unsigned ov[8]; const unsigned oo[8] = {o0.x, o0.y, o0.z, o0.w, o1.x, o1.y, o1.z, o1.w}, zz[8] = {z0.x, z0.y, z0.z, z0.w, z1.x, z1.y, z1.z, z1.w};
#pragma unroll
        for (int i = 0; i < 8; ++i) { const float za = bflo(zz[i]), zb = bfhi(zz[i]);
            ov[i] = pk2(bflo(oo[i]) * r_ * gwp[2 * i] * za * sigmoidf_(za), bfhi(oo[i]) * r_ * gwp[2 * i + 1] * zb * sigmoidf_(zb)); }
        u32x4* op = (u32x4*)((bf16_t*)(ws + WS_OCAT) + tok * D + hh * 128 + seg * 16);
        op[0] = (u32x4){ov[0], ov[1], ov[2], ov[3]}; op[1] = (u32x4){ov[4], ov[5], ov[6], ov[7]};
    }
}

__device__ __forceinline__ void attn_item(const Params& P, unsigned char* smem, int item) {
    unsigned char* ws = P.ws;
    const int tid = opaque_tid(), wave = tid >> 6, lane = tid & 63, ql = lane & 31, hf = lane >> 5;
    const int qt = 15 - (item >> 5), bh = item & 31;
    const bf16_t* Qg = (const bf16_t*)(ws + WS_Q) + (size_t)bh * SEQ * DQK;
    const unsigned char* Kg = (const unsigned char*)((const bf16_t*)(ws + WS_K) + (size_t)bh * SEQ * DQK);
    const bf16_t* VTg = (const bf16_t*)(ws + WS_VT) + (size_t)bh * 64 * SEQ;
    bf16_t* OB = (bf16_t*)(ws + WS_OB);
    const int q0 = qt * 256 + 32 * wave;
    const int nkt_w = (q0 >> 6) + 1, nkt_b = 2 * qt + 2;
    constexpr int KB_ = 26624, VB_ = 17408, OK0 = 0, OV0 = 2 * KB_;
    bf16x8 qf[6];
#pragma unroll
    for (int ks = 0; ks < 6; ++ks) qf[ks] = *(const bf16x8*)(Qg + (size_t)(q0 + ql) * DQK + 16 * ks + 8 * hf);
    f32x16 o0, o1;
#pragma unroll
    for (int i = 0; i < 16; ++i) { o0[i] = 0.f; o1[i] = 0.f; }
    float mrun = -1e30f, lsum = 0.f;
    u32x4 sk[3], sv[2];
    auto gload = [&](int kt) {
        const unsigned char* kp = Kg + (size_t)kt * 128 * DQK * 2;
#pragma unroll
        for (int k = 0; k < 3; ++k) sk[k] = *(const u32x4*)(kp + (size_t)(tid + 512 * k) * 16);
#pragma unroll
        for (int k = 0; k < 2; ++k) { const int c = tid + 512 * k; sv[k] = *(const u32x4*)(VTg + (size_t)(c >> 4) * SEQ + kt * 128 + (c & 15) * 8); }
    };
    auto lwrite = [&](int buf) {
#pragma unroll
        for (int k = 0; k < 3; ++k) { const int c = tid + 512 * k; *(u32x4*)(smem + OK0 + buf * KB_ + (c / 12) * 208 + (c % 12) * 16) = sk[k]; }
#pragma unroll
        for (int k = 0; k < 2; ++k) { const int c = tid + 512 * k; *(u32x4*)(smem + OV0 + buf * VB_ + (c >> 4) * 272 + (c & 15) * 16) = sv[k]; }
    };
    __syncthreads();
    gload(0); lwrite(0);
    __syncthreads();
    for (int kt = 0; kt < nkt_b; ++kt) {
        if (kt + 1 < nkt_b) gload(kt + 1);
#pragma unroll
        for (int u2 = 0; u2 < 2; ++u2) if (2 * kt + u2 < nkt_w) {
            const unsigned char* Kl = smem + OK0 + (kt & 1) * KB_ + u2 * (64 * 208); const unsigned char* Vl = smem + OV0 + (kt & 1) * VB_ + u2 * 128;
            f32x16 s0, s1;
#pragma unroll
            for (int i = 0; i < 16; ++i) { s0[i] = 0.f; s1[i] = 0.f; }
            bf16x8 kf[6][2], vf[2][2][2];
#pragma unroll
            for (int ks = 0; ks < 6; ++ks) { kf[ks][0] = *(const bf16x8*)(Kl + ql * 208 + (16 * ks + 8 * hf) * 2); kf[ks][1] = *(const bf16x8*)(Kl + (32 + ql) * 208 + (16 * ks + 8 * hf) * 2); }
            __builtin_amdgcn_sched_barrier(0);
#pragma unroll
            for (int ks = 0; ks < 6; ++ks) {
                s0 = __builtin_amdgcn_mfma_f32_32x32x16_bf16(kf[ks][0], qf[ks], s0, 0, 0, 0);
                s1 = __builtin_amdgcn_mfma_f32_32x32x16_bf16(kf[ks][1], qf[ks], s1, 0, 0, 0);
            }
#pragma unroll
            for (int u = 0; u < 2; ++u)
#pragma unroll
                for (int sp = 0; sp < 2; ++sp) { vf[u][sp][0] = *(const bf16x8*)(Vl + ql * 272 + (32 * u + 16 * sp + 8 * hf) * 2); vf[u][sp][1] = *(const bf16x8*)(Vl + (32 + ql) * 272 + (32 * u + 16 * sp + 8 * hf) * 2); }
            __builtin_amdgcn_sched_barrier(0);
            float mx = s0[0];
#pragma unroll
            for (int i = 1; i < 16; ++i) mx = fmaxf(mx, s0[i]);
#pragma unroll
            for (int i = 0; i < 16; ++i) mx = fmaxf(mx, s1[i]);
            mx = xor32_max(mx);
            const float mnew = fmaxf(mrun, mx), alpha = __builtin_amdgcn_exp2f(mrun - mnew);
            mrun = mnew;
            float ps = 0.f;
#pragma unroll
            for (int i = 0; i < 16; ++i) { s0[i] = __builtin_amdgcn_exp2f(s0[i] - mnew); s1[i] = __builtin_amdgcn_exp2f(s1[i] - mnew); ps += s0[i] + s1[i]; }
            lsum = lsum * alpha + ps;
#pragma unroll
            for (int i = 0; i < 16; ++i) { o0[i] *= alpha; o1[i] *= alpha; }
            bf16x8 pb[2][2];
#pragma unroll
            for (int sp = 0; sp < 2; ++sp) {
                pb[0][sp] = pack8((f32x4){s0[8 * sp], s0[8 * sp + 1], s0[8 * sp + 2], s0[8 * sp + 3]}, (f32x4){s0[8 * sp + 4], s0[8 * sp + 5], s0[8 * sp + 6], s0[8 * sp + 7]});
                pb[1][sp] = pack8((f32x4){s1[8 * sp], s1[8 * sp + 1], s1[8 * sp + 2], s1[8 * sp + 3]}, (f32x4){s1[8 * sp + 4], s1[8 * sp + 5], s1[8 * sp + 6], s1[8 * sp + 7]});
            }
#pragma unroll
            for (int u = 0; u < 2; ++u)
#pragma unroll
                for (int sp = 0; sp < 2; ++sp) {
                    o0 = __builtin_amdgcn_mfma_f32_32x32x16_bf16(vf[u][sp][0], pb[u][sp], o0, 0, 0, 0);
                    o1 = __builtin_amdgcn_mfma_f32_32x32x16_bf16(vf[u][sp][1], pb[u][sp], o1, 0, 0, 0);
                }
        }
        if (kt + 1 < nkt_b) lwrite((kt + 1) & 1);
        __syncthreads();
    }
    lsum = xor32_sum(lsum);
    const float inv = 1.f / lsum;
    const int b = bh >> 3, h = bh & 7;
    bf16_t* orow = OB + ((size_t)b * SEQ + q0 + ql) * 512 + h * 64;
#pragma unroll
    for (int k4 = 0; k4 < 4; ++k4) { const int dv = 8 * k4 + 4 * hf;
        u32x2 a, c; a.x = pk2(o0[4 * k4] * inv, o0[4 * k4 + 1] * inv); a.y = pk2(o0[4 * k4 + 2] * inv, o0[4 * k4 + 3] * inv);
        c.x = pk2(o1[4 * k4] * inv, o1[4 * k4 + 1] * inv); c.y = pk2(o1[4 * k4 + 2] * inv, o1[4 * k4 + 3] * inv);
        *(u32x2*)(orow + dv) = a; *(u32x2*)(orow + 32 + dv) = c; }
}

__device__ __forceinline__ void phase5(const Params& P) {
    unsigned char* ws = P.ws;
    const int tid_ = opaque_tid(), lane = tid_ & 63, gw = blockIdx.x * NWAVES + (tid_ >> 6), ngw = gridDim.x * NWAVES;
    const bf16_t* OB = (const bf16_t*)(ws + WS_OB); bf16_t* OCAT = (bf16_t*)(ws + WS_OCAT);
    const f32x4 wn0 = *(const f32x4*)(P.mla_out_norm_w + 8 * lane), wn1 = *(const f32x4*)(P.mla_out_norm_w + 8 * lane + 4);
    const float wn[8] = {wn0.x, wn0.y, wn0.z, wn0.w, wn1.x, wn1.y, wn1.z, wn1.w};
    for (int tq = gw; tq < T / 4; tq += ngw) {
        const int t0 = 4 * tq;
        u32x4 vr[4];
#pragma unroll
        for (int r = 0; r < 4; ++r) vr[r] = *((const u32x4*)(OB + ((size_t)t0 + r) * 512) + lane);
#pragma unroll
        for (int r = 0; r < 4; ++r) {
            const size_t row = (size_t)t0 + r;
            const u32x4 v = vr[r];
            float f[8] = {bflo(v.x), bfhi(v.x), bflo(v.y), bfhi(v.y), bflo(v.z), bfhi(v.z), bflo(v.w), bfhi(v.w)};
            float ss = 0.f;
#pragma unroll
            for (int i = 0; i < 8; ++i) ss += f[i] * f[i];
            const float rstd = rsqrtf(wave_sum(ss) * (1.f / 512.f) + EPS);
            u32x4 o; o.x = pk2(f[0] * rstd * wn[0], f[1] * rstd * wn[1]); o.y = pk2(f[2] * rstd * wn[2], f[3] * rstd * wn[3]); o.z = pk2(f[4] * rstd * wn[4], f[5] * rstd * wn[5]); o.w = pk2(f[6] * rstd * wn[6], f[7] * rstd * wn[7]);
            *((u32x4*)(OCAT + row * D + 512) + lane) = o;
        }
    }
}

__device__ __forceinline__ void phase7(const Params& P, unsigned char* smem) {
    unsigned char* ws = P.ws;
    const int tid = opaque_tid(), wave = tid >> 6, lane = tid & 63;
    unsigned char* bhi = smem; unsigned char* blo = smem + 65536;
    int* lctl = (int*)(smem + LDS_MISC + 256);
    float* lgs = (float*)(smem + LDS_MISC + 256 + 2560);
    { const int n = tid & 31, c0 = tid >> 5;
      float rv[8][8]; f32x4 nv[8][2];
#pragma unroll
      for (int i = 0; i < 8; ++i) { const int ch = c0 + 16 * i;
#pragma unroll
          for (int q = 0; q < 8; ++q) rv[i][q] = P.router_w[(size_t)(8 * ch + q) * 32 + n];
          nv[i][0] = *(const f32x4*)(P.norm_ffn_w + 8 * ch); nv[i][1] = *(const f32x4*)(P.norm_ffn_w + 8 * ch + 4); }
      __builtin_amdgcn_sched_barrier(0);
#pragma unroll
      for (int i = 0; i < 8; ++i) { const int ch = c0 + 16 * i;
          float v[8];
#pragma unroll
          for (int q = 0; q < 8; ++q) v[q] = rv[i][q] * nv[i][q >> 2][q & 3];
          unsigned h[4], l[4];
#pragma unroll
          for (int q = 0; q < 4; ++q) { h[q] = pk2(v[2 * q], v[2 * q + 1]); l[q] = pk2(v[2 * q] - bflo(h[q]), v[2 * q + 1] - bfhi(h[q])); }
          const int off = n * 2048 + ((ch ^ (n & 15)) * 16);
          *(u32x4*)(bhi + off) = (u32x4){h[0], h[1], h[2], h[3]}; *(u32x4*)(blo + off) = (u32x4){l[0], l[1], l[2], l[3]}; } }
    const bf16_t* X1 = (const bf16_t*)(ws + WS_X1); unsigned char* H2 = ws + WS_H;
    int* tok_e = (int*)(ws + WS_TOKE); int* tok_r = (int*)(ws + WS_TOKR); float* gate = (float*)(ws + WS_GATE); int* list = (int*)(ws + WS_LIST);
    unsigned* cnt = (unsigned*)(ws + WS_CTL) + CW_CNT;
    for (int tg = blockIdx.x; tg < T / 64; tg += gridDim.x) {
    __syncthreads();
    if (tid < 64) lctl[tid] = 0;
    __syncthreads();
    if (wave < 4) {
        const int ti = lane & 15, kk = lane >> 4; const int row = tg * 64 + wave * 16 + ti;
        const u32x4* xr = (const u32x4*)(X1 + (size_t)row * D) + kk;
        u32x4 av[32];
#pragma unroll
        for (int s_ = 0; s_ < 32; ++s_) av[s_] = xr[4 * s_];
        f32x4 a0 = {0.f, 0.f, 0.f, 0.f}, a1 = {0.f, 0.f, 0.f, 0.f}; float ss = 0.f;
        const unsigned char* b0p = bhi + ti * 2048; const unsigned char* b1p = bhi + (ti + 16) * 2048;
        bf16x8 bc[4], bn[4];
        { const int co = ((kk ^ ti) * 16); bc[0] = *(const bf16x8*)(b0p + co); bc[1] = *(const bf16x8*)(b0p + 65536 + co); bc[2] = *(const bf16x8*)(b1p + co); bc[3] = *(const bf16x8*)(b1p + 65536 + co); }
#pragma unroll
        for (int s_ = 0; s_ < 32; ++s_) {
            if (s_ + 1 < 32) { const int co = (((4 * (s_ + 1) + kk) ^ ti) * 16);
                bn[0] = *(const bf16x8*)(b0p + co); bn[1] = *(const bf16x8*)(b0p + 65536 + co); bn[2] = *(const bf16x8*)(b1p + co); bn[3] = *(const bf16x8*)(b1p + 65536 + co); }
            __builtin_amdgcn_sched_barrier(0);
            const u32x4 xa = av[s_]; const bf16x8 af = __builtin_bit_cast(bf16x8, xa);
            a0 = __builtin_amdgcn_mfma_f32_16x16x32_bf16(af, bc[0], a0, 0, 0, 0);
            a1 = __builtin_amdgcn_mfma_f32_16x16x32_bf16(af, bc[2], a1, 0, 0, 0);
            a0 = __builtin_amdgcn_mfma_f32_16x16x32_bf16(af, bc[1], a0, 0, 0, 0);
            a1 = __builtin_amdgcn_mfma_f32_16x16x32_bf16(af, bc[3], a1, 0, 0, 0);
            ss += bflo(xa.x) * bflo(xa.x) + bfhi(xa.x) * bfhi(xa.x) + bflo(xa.y) * bflo(xa.y) + bfhi(xa.y) * bfhi(xa.y)
                + bflo(xa.z) * bflo(xa.z) + bfhi(xa.z) * bfhi(xa.z) + bflo(xa.w) * bflo(xa.w) + bfhi(xa.w) * bfhi(xa.w);
#pragma unroll
            for (int q = 0; q < 4; ++q) bc[q] = bn[q];
        }
        ss = xor32_sum(xor16_sum(ss));
        const float rstd = rsqrtf(ss * (1.f / D) + EPS);
        float* lg = lgs + wave * (16 * 33);
#pragma unroll
        for (int r = 0; r < 4; ++r) { const int t = 4 * kk + r; const float rs = __shfl(rstd, t);
            lg[t * 33 + (lane & 15)] = a0[r] * rs + P.router_b[lane & 15]; lg[t * 33 + 16 + (lane & 15)] = a1[r] * rs + P.router_b[16 + (lane & 15)]; }
        asm volatile("s_waitcnt lgkmcnt(0)" ::: "memory");
        if (lane < 16) {
            const float* l = lg + lane * 33; const int trow = tg * 64 + wave * 16 + lane;
            int ei[4]; float ev[4];
#pragma unroll
            for (int k = 0; k < 4; ++k) { float best = -3.0e38f; int bi = 0;
                for (int j = 0; j < 32; ++j) { const float v = l[j]; const bool taken = (k > 0 && ei[0] == j) || (k > 1 && ei[1] == j) || (k > 2 && ei[2] == j); if (!taken && v > best) { best = v; bi = j; } }
                ei[k] = bi; ev[k] = best; }
            float gs = 0.f, gv[4];
#pragma unroll
            for (int k = 0; k < 4; ++k) { gv[k] = __expf(ev[k] - ev[0]); gs += gv[k]; }
            const float ig = 1.f / gs;
#pragma unroll
            for (int k = 0; k < 4; ++k) { const int lr = atomicAdd(&lctl[ei[k]], 1);
                lctl[64 + ((wave * 16 + lane) * 4 + k) * 2] = ei[k]; lctl[64 + ((wave * 16 + lane) * 4 + k) * 2 + 1] = lr; }
            *(f32x4*)(gate + (size_t)trow * 4) = (f32x4){gv[0] * ig, gv[1] * ig, gv[2] * ig, gv[3] * ig};
        }
    } else {
        const int row0 = tg * 64 + (wave - 4) * 16;
        f32x4 nw[4];
#pragma unroll
        for (int j = 0; j < 4; ++j) nw[j] = *((const f32x4*)P.norm_ffn_w + lane + 64 * j);
        u32x2 rr[4][4];
#pragma unroll
        for (int q = 0; q < 3; ++q)
#pragma unroll
            for (int j = 0; j < 4; ++j) rr[q][j] = *((const u32x2*)(X1 + (size_t)(row0 + q) * D) + lane + 64 * j);
#pragma unroll
        for (int ti = 0; ti < 16; ++ti) { const int row = row0 + ti;
            if (ti + 3 < 16) {
#pragma unroll
                for (int j = 0; j < 4; ++j) rr[(ti + 3) & 3][j] = *((const u32x2*)(X1 + (size_t)(row + 3) * D) + lane + 64 * j); }
            f32x4 v[4]; float ss = 0.f;
#pragma unroll
            for (int j = 0; j < 4; ++j) { const u32x2 t_ = rr[ti & 3][j]; v[j] = (f32x4){bflo(t_.x), bfhi(t_.x), bflo(t_.y), bfhi(t_.y)}; ss += v[j].x * v[j].x + v[j].y * v[j].y + v[j].z * v[j].z + v[j].w * v[j].w; }
            const float rstd = rsqrtf(wave_sum(ss) * (1.f / D) + EPS);
#pragma unroll
            for (int j = 0; j < 4; ++j) { const f32x4 h = v[j] * rstd * nw[j];
                *((unsigned*)(H2 + (size_t)row * D) + lane + 64 * j) = pk4_fp8(h.x, h.y, h.z, h.w); }
        }
    }
    __syncthreads();
    if (tid < 32) lctl[32 + tid] = (int)atomicAdd(&cnt[tid], (unsigned)lctl[tid]);
    __syncthreads();
    if (tid < 256) { const int e = lctl[64 + tid * 2], lr = lctl[64 + tid * 2 + 1]; const int row = tg * 64 + (tid >> 2); const int rank = lctl[32 + e] + lr;
        tok_e[(size_t)row * 4 + (tid & 3)] = e; tok_r[(size_t)row * 4 + (tid & 3)] = rank; list[e * T + rank] = row; }
    }
}

__device__ __forceinline__ void moe_tiles(const Params& P, unsigned char* smem) {
    int* tstart = (int*)(smem + LDS_MISC + 256); int* cntl = tstart + 64;
    const unsigned* cnt = (const unsigned*)(P.ws + WS_CTL) + CW_CNT;
    __syncthreads();
    if (threadIdx.x < 64) {
        const int e = threadIdx.x; const int c = (e < NE) ? (int)__hip_atomic_load(&cnt[e < NE ? e : 0], __ATOMIC_RELAXED, __HIP_MEMORY_SCOPE_AGENT) : 0;
        const int nt_ = (c + 255) >> 8; const int incl = (int)wave_scan((float)nt_);
        if (e < NE) { cntl[e] = c; tstart[e] = incl - nt_; }
        if (e == NE - 1) tstart[NE] = incl;
    }
    __syncthreads();
    if (threadIdx.x == 0) { int* xs = tstart + 100; const int x = blockIdx.x & 7; int a2 = 0; for (int j = 0; j < 4; ++j) { xs[j] = a2; a2 += (cntl[x + 8 * j] + 255) >> 8; } xs[4] = a2; }
    __syncthreads();
}

__device__ __forceinline__ void phase8(const Params& P, unsigned char* smem) {
    unsigned char* ws = P.ws;
    const int tid_ = opaque_tid(), lane = tid_ & 63, gw = blockIdx.x * NWAVES + (tid_ >> 6), ngw = gridDim.x * NWAVES;
    const int* tstart = (const int*)(smem + LDS_MISC + 256);
    const int* tok_e = (const int*)(ws + WS_TOKE); const int* tok_r = (const int*)(ws + WS_TOKR);
    const unsigned char* H2 = ws + WS_H; unsigned char* XG = ws + WS_XG;
    for (int row = gw; row < T; row += ngw) {
        const u32x4 v = *((const u32x4*)(H2 + (size_t)row * D) + lane);
#pragma unroll
        for (int k = 0; k < 4; ++k) { const int e = tok_e[(size_t)row * 4 + k], rk = tok_r[(size_t)row * 4 + k];
            *((u32x4*)(XG + (size_t)(tstart[e] * 256 + rk) * D) + lane) = v; }
    }
}

__device__ __forceinline__ void phase11(const Params& P, unsigned char* smem) {
    unsigned char* ws = P.ws;
    const int tid_ = opaque_tid(), lane = tid_ & 63, gw = blockIdx.x * NWAVES + (tid_ >> 6), ngw = gridDim.x * NWAVES;
    const bf16_t* X1 = (const bf16_t*)(ws + WS_X1);
    const int* tstart = (const int*)(smem + LDS_MISC + 256);
    const int* tok_e = (const int*)(ws + WS_TOKE); const int* tok_r = (const int*)(ws + WS_TOKR); const float* gate = (const float*)(ws + WS_GATE); const unsigned char* Y = ws + WS_Y;
    struct Rec { int e[4], rk[4]; float g[4]; };
    auto ldrec = [&](int row, Rec& r) {
#pragma unroll
        for (int k = 0; k < 4; ++k) { r.e[k] = tok_e[(size_t)row * 4 + k]; r.rk[k] = tok_r[(size_t)row * 4 + k]; r.g[k] = gate[(size_t)row * 4 + k]; } };
    Rec rc, rn; f32x4 v[4], vn[4], nfw[4]; unsigned y[4][4], yn[4][4];
#pragma unroll
    for (int j = 0; j < 4; ++j) nfw[j] = *((const f32x4*)P.norm_final_w + lane + 64 * j);
    const int nrows = (T - gw + ngw - 1) / ngw;
    rn.e[0] = 0;
    if (nrows > 0) { ldrec(gw, rc);
#pragma unroll
        for (int j = 0; j < 4; ++j) { const u32x2 t_ = *((const u32x2*)(X1 + (size_t)gw * D) + lane + 64 * j); v[j] = (f32x4){bflo(t_.x), bfhi(t_.x), bflo(t_.y), bfhi(t_.y)}; }
        if (nrows > 1) ldrec(gw + ngw, rn);
#pragma unroll
        for (int k = 0; k < 4; ++k) { const unsigned char* yr = Y + (size_t)(tstart[rc.e[k]] * 256 + rc.rk[k]) * D;
#pragma unroll
            for (int j = 0; j < 4; ++j) y[k][j] = *((const unsigned*)yr + lane + 64 * j); } }
    for (int i = 0; i < nrows; ++i) {
        const int row = gw + i * ngw;
        Rec rnn = rn;
        if (i + 1 < nrows) {
#pragma unroll
            for (int j = 0; j < 4; ++j) { const u32x2 t_ = *((const u32x2*)(X1 + (size_t)(row + ngw) * D) + lane + 64 * j); vn[j] = (f32x4){bflo(t_.x), bfhi(t_.x), bflo(t_.y), bfhi(t_.y)}; }
#pragma unroll
            for (int k = 0; k < 4; ++k) { const unsigned char* yr = Y + (size_t)(tstart[rn.e[k]] * 256 + rn.rk[k]) * D;
#pragma unroll
                for (int j = 0; j < 4; ++j) yn[k][j] = *((const unsigned*)yr + lane + 64 * j); }
            if (i + 2 < nrows) ldrec(row + 2 * ngw, rnn);
        }
#pragma unroll
        for (int k = 0; k < 4; ++k) { const float gg = rc.g[k];
#pragma unroll
            for (int j = 0; j < 4; ++j) { const unsigned yy = y[k][j]; const f32x2v lo_ = __builtin_amdgcn_cvt_pk_f32_fp8(yy, false), hi_ = __builtin_amdgcn_cvt_pk_f32_fp8(yy, true);
                v[j].x += gg * lo_.x; v[j].y += gg * lo_.y; v[j].z += gg * hi_.x; v[j].w += gg * hi_.y; } }
        float ss = 0.f;
#pragma unroll
        for (int j = 0; j < 4; ++j) ss += v[j].x * v[j].x + v[j].y * v[j].y + v[j].z * v[j].z + v[j].w * v[j].w;
        const float rstd = rsqrtf(wave_sum(ss) * (1.f / D) + EPS);
#pragma unroll
        for (int j = 0; j < 4; ++j) *((f32x4*)(P.out + (size_t)row * D) + lane + 64 * j) = v[j] * rstd * nfw[j];
        rc = rn; rn = rnn;
#pragma unroll
        for (int j = 0; j < 4; ++j) { v[j] = vn[j];
#pragma unroll
            for (int k = 0; k < 4; ++k) y[k][j] = yn[k][j]; }
    }
}

extern "C" __global__ void __launch_bounds__(NTHREADS) fwd_megakernel(Params P) {
    extern __shared__ __attribute__((aligned(16))) unsigned char smem[];
    LAS unsigned char* lds = (LAS unsigned char*)smem;
    unsigned char* ws = P.ws;
    const int tid = threadIdx.x;
    const int G = gridDim.x, bid = blockIdx.x;
    volatile LAS unsigned* misc = (volatile LAS unsigned*)(lds + LDS_MISC);
    if (tid < 64) misc[tid] = 0u;
    __syncthreads();
    XcdBarrier bar = xcd_barrier_post((unsigned*)(ws + WS_CTL) + CW_BAR, misc);
#if TSA >= 0
    unsigned long long* tsw = (unsigned long long*)((unsigned*)(ws + WS_CTL) + CW_TS); int tsi = 0;
#define STAMP() do { if (bid == 0 && tid == 0) tsw[tsi] = __builtin_amdgcn_s_memrealtime(); ++tsi; } while (0)
#else
#define STAMP() do { } while (0)
#endif
    unsigned long long pc0_; asm volatile("s_getpc_b64 %0" : "=s"(pc0_));
    const unsigned long long tbase_ = pc0_ & ~0xFFFull;
#define WARM_CODE() do { const int wv_ = __builtin_amdgcn_readfirstlane(tid >> 6); if (wv_ < 2) { const int ch_ = (bid >> 3) + 32 * wv_; if (ch_ < 37) { \
        const auto rsw_ = __builtin_amdgcn_make_buffer_rsrc((void*)tbase_, 0, 0x7fffffff, 0x00020000); \
        __builtin_amdgcn_raw_ptr_buffer_load_lds(rsw_, (LAS void*)(lds + LDS_MISC + 14336 + wv_ * 256), 4, (int)(ch_ * 4096 + (tid & 63) * 64), 0, 0, 0); } } } while (0)
#define GRID_BAR() do { xcd_barrier(bar); STAMP(); WARM_CODE(); } while (0)
    STAMP();
    WARM_CODE();

    REP(0) phase0(P, smem);
    GRID_BAR();
#if LEVEL >= 2
    REP(1) {
        pg8::DenseOrder S{(const char*)(ws + WS_H), (const char*)(ws + WS_WIN), T / 256, DINP / 256, D, G, bid};
        EpiProj E{(bf16_t*)(ws + WS_PROJ)};
        pg8::gemm_phase<EpiProj, pg8::DenseOrder>(lds, D, S, E);
    }
    GRID_BAR();
    REP(2) phase2a(P);
#if LEVEL >= 3
    REP(12) { u32x4 raw[2][7]; const int tidp = opaque_tid();
        if (bid < NB * GH * NCH) prep_conv_load(P, bid, tidp, raw);
        for (int item = bid; item < NB * GH * NCH; item += G) gdn_prep_item(P, smem, item, (item + G < NB * GH * NCH) ? item + G : -1, raw); }
#endif
    GRID_BAR();
    REP(3) {
        pg8::DenseOrder S{(const char*)(ws + WS_CQN), (const char*)(ws + WS_WUQ), T / 256, 768 / 256, QL, G, bid};
        EpiQ E{(bf16_t*)(ws + WS_Q), (const float*)(ws + WS_TAB)};
        pg8::gemm_phase<EpiQ, pg8::DenseOrder>(lds, QL, S, E);
        pg8::DenseOrder S2{(const char*)(ws + WS_CKVN), (const char*)(ws + WS_WUKV), T / 256, 1024 / 256, KVL, G, (bid + 64) % G};
        EpiKV E2{(bf16_t*)(ws + WS_K), (bf16_t*)(ws + WS_VT)};
        pg8::gemm_phase<EpiKV, pg8::DenseOrder>(lds, KVL, S2, E2);
    }
    GRID_BAR();
    {
        { const int xl = bid & 7, sidx = (bid >> 3) * 3 + (xl - 5);
          REP(14) if (xl >= 5 && sidx < NB * GH) gdn_scan(P, smem, sidx); }
#if TSA >= 0
        if (bid == 0 && tid == 0) { tsw[20] = tsw[tsi - 1]; tsw[21] = __builtin_amdgcn_s_memrealtime(); }
#endif
        const int tidq = opaque_tid();
        const bool tfirst = ((bid & 7) >= 5);
        for (int rep_ = 0; rep_ < ((DUP == 4 || DUP == 15) ? 2 : 1); ++rep_)
#pragma unroll 1
        for (int pass = 0; pass < 2; ++pass) {
            unsigned* aq = (unsigned*)(ws + WS_CTL) + CW_AQ + 128 * rep_;
            const bool do_t = (pass == 0) == tfirst;
            unsigned* qh = aq + (do_t ? 64 : 0);
            const int qn = do_t ? 0 : ((rep_ == 1 && DUP == 15) ? 0 : 512);
            if (do_t) { if (!(rep_ == 1 && DUP == 4)) late_transposes(P, smem, qh, misc, tidq); continue; }
            for (;;) {
                __syncthreads();
                if (tidq == 0) misc[8] = atomicAdd(qh, 1u);
                __syncthreads();
                const int item = (int)misc[8];
                if (item >= qn) break;
                attn_item(P, smem, item);
            }
        }
    }
    GRID_BAR();
    REP(5) { phase5(P);
        GdnOutRegs R; const int tido = opaque_tid();
        if (bid < NB * GH * NCH) gdn_out_load(P, bid, tido, R);
        for (int item = bid; item < NB * GH * NCH; item += G) gdn_out_item(P, smem, item, (item + G < NB * GH * NCH) ? item + G : -1, R); }
    GRID_BAR();
    REP(6) {
        pg8::DenseOrder S{(const char*)(ws + WS_OCAT), (const char*)(ws + WS_WOUT), T / 256, D / 256, D, G, bid};
        EpiX1 E{P.x, (bf16_t*)(ws + WS_X1)};
        pg8::gemm_phase<EpiX1, pg8::DenseOrder>(lds, D, S, E);
    }
    GRID_BAR();
#endif
#if LEVEL >= 4
    phase7(P, smem);
    GRID_BAR();
    moe_tiles(P, smem);
    REP(9) {
        const LAS int* ts = (const LAS int*)(lds + LDS_MISC + 256);
        MoeOrder1 S{(const char*)(ws + WS_H), (const char*)(ws + WS_W1), (const int*)(ws + WS_LIST), ts, ts + 64, ts + 100, G, bid};
        EpiAct E{ws + WS_ACT, P.b1};
        pg8::gemm_phase<EpiAct, MoeOrder1, true>(lds, D, S, E);
    }
    GRID_BAR();
    REP(10) {
        const LAS int* ts = (const LAS int*)(lds + LDS_MISC + 256);
        MoeOrder2 S{(const char*)(ws + WS_ACT), (const char*)(ws + WS_W2), ts, ts + 100, G, bid};
        EpiY E{ws + WS_Y, P.b2};
        pg8::gemm_phase<EpiY, MoeOrder2, true>(lds, DFF, S, E);
    }
    GRID_BAR();
#endif
    REP(11) phase11(P, smem);
#if TSA >= 0
    if (bid == 0) {
        __syncthreads();
        if (tid == 0) { const unsigned long long dt = tsw[TSA + 1] - tsw[TSA], t0 = __builtin_amdgcn_s_memrealtime();
            while (__builtin_amdgcn_s_memrealtime() - t0 < dt) __builtin_amdgcn_s_sleep(8); }
        __syncthreads();
    }
#endif
}

extern "C" void kernel_launch(void* const* d_in, const int* in_sizes, int n_in, void* d_out, int out_size, void* d_ws, size_t ws_size, hipStream_t stream) {
    static int grid = 0;
    if (grid == 0) {
        if (n_in != 22 || in_sizes[0] != T * D || out_size != T * D || ws_size < WS_END) {
            fprintf(stderr, "kernel_launch: unexpected shapes (n_in %d, in0 %d, out %d, ws %zu < %zu)\n", n_in, n_in > 0 ? in_sizes[0] : -1, out_size, ws_size, (size_t)WS_END); grid = -1; return; }
        int dev = 0, cus = 0, per_cu = 0;
        if (hipGetDevice(&dev) != hipSuccess || hipDeviceGetAttribute(&cus, hipDeviceAttributeMultiprocessorCount, dev) != hipSuccess) { grid = -1; return; }
        if (hipFuncSetAttribute((const void*)fwd_megakernel, hipFuncAttributeMaxDynamicSharedMemorySize, LDS_BYTES) != hipSuccess) { fprintf(stderr, "kernel_launch: hipFuncSetAttribute failed\n"); grid = -1; return; }
        if (hipOccupancyMaxActiveBlocksPerMultiprocessor(&per_cu, (const void*)fwd_megakernel, NTHREADS, LDS_BYTES) != hipSuccess || per_cu < 1) { fprintf(stderr, "kernel_launch: occupancy query says %d\n", per_cu); (void)hipGetLastError(); grid = -1; return; }
        grid = cus;
        if (grid != 256) fprintf(stderr, "kernel_launch: note: %d CUs\n", grid);
    }
    if (grid < 0) return;
    (void)hipMemsetAsync((char*)d_ws + WS_CTL, 0, CTL_BYTES, stream);
    Params p{};
    p.x = (const float*)d_in[0]; p.pos = (const int*)d_in[1]; p.norm_mix_w = (const float*)d_in[2]; p.w_in = (const float*)d_in[3]; p.conv_w = (const float*)d_in[4];
    p.a_log = (const float*)d_in[5]; p.dt_bias = (const float*)d_in[6]; p.gdn_norm_w = (const float*)d_in[7]; p.q_norm_w = (const float*)d_in[8]; p.w_uq = (const float*)d_in[9];
    p.kv_norm_w = (const float*)d_in[10]; p.w_ukv = (const float*)d_in[11]; p.mla_out_norm_w = (const float*)d_in[12]; p.w_out = (const float*)d_in[13]; p.norm_ffn_w = (const float*)d_in[14];
    p.router_w = (const float*)d_in[15]; p.router_b = (const float*)d_in[16]; p.w1 = (const float*)d_in[17]; p.b1 = (const float*)d_in[18]; p.w2 = (const float*)d_in[19];
    p.b2 = (const float*)d_in[20]; p.norm_final_w = (const float*)d_in[21]; p.out = (float*)d_out; p.ws = (unsigned char*)d_ws;
    void* args[] = {&p};
    hipError_t e = hipLaunchCooperativeKernel((const void*)fwd_megakernel, dim3(grid), dim3(NTHREADS), args, LDS_BYTES, stream);
    if (e != hipSuccess) fprintf(stderr, "kernel_launch: cooperative launch failed: %s (grid %d)\n", hipGetErrorString(e), grid);
}
```
